# Optimizing an MI355X kernel written in HIP

```python
import jax
import jax.numpy as jnp
from jax import lax
import numpy as np

D_MODEL = 2048
BATCH = 4
SEQ = 4096
DEPTH = 1

CHUNK = 64
Q_BLOCK = 128
NORM_EPS = 1e-6
NEG_INF = -1e30

FOX_HEADS = 8
FOX_HEAD_DIM = D_MODEL // (2 * FOX_HEADS)
FOX_WIDTH = FOX_HEADS * FOX_HEAD_DIM

MLSTM_HEADS = 8
MLSTM_V_DIM = D_MODEL // (2 * MLSTM_HEADS)
MLSTM_QK_DIM = MLSTM_V_DIM // 2
MLSTM_V_WIDTH = MLSTM_HEADS * MLSTM_V_DIM
MLSTM_QK_WIDTH = MLSTM_HEADS * MLSTM_QK_DIM
CONV_WIDTH = 4

MIX_WIDTH = FOX_WIDTH + MLSTM_V_WIDTH

IN_SIZES = (FOX_WIDTH, FOX_WIDTH, FOX_WIDTH, FOX_WIDTH, FOX_HEADS,
            MLSTM_QK_WIDTH, MLSTM_QK_WIDTH, MLSTM_V_WIDTH, MLSTM_V_WIDTH, MLSTM_V_WIDTH,
            MLSTM_HEADS, MLSTM_HEADS)
IN_COLS = sum(IN_SIZES)

kernel_name = 'fox_mlstm_parallel_heads_block'


def rms_norm(x, g):
    xf = x.astype(jnp.float32)
    y = xf * lax.rsqrt(jnp.mean(xf * xf, axis=-1, keepdims=True) + NORM_EPS)
    return (y * g.astype(jnp.float32)).astype(x.dtype)


def head_rms_norm(y, g):
    h, d = y.shape[1], y.shape[3]
    yf = y.astype(jnp.float32)
    yf = yf * lax.rsqrt(jnp.mean(yf * yf, axis=-1, keepdims=True) + NORM_EPS)
    return (yf * g.reshape(h, d)[None, :, None, :].astype(jnp.float32)).astype(y.dtype)


def to_heads(t, n_heads):
    b, s, w = t.shape
    return t.reshape(b, s, n_heads, w // n_heads).transpose(0, 2, 1, 3)


def from_heads(t):
    b, h, s, d = t.shape
    return t.transpose(0, 2, 1, 3).reshape(b, s, h * d)


def causal_dwconv(u, w, bias):
    s = u.shape[1]
    up = jnp.pad(u, ((0, 0), (CONV_WIDTH - 1, 0), (0, 0)))
    y = up[:, 0:s] * w[0]
    for j in range(1, CONV_WIDTH):
        y = y + up[:, j:j + s] * w[j]
    return y + bias


def fox_attention(q, k, v, f_pre):
    b, h, s, d = q.shape
    cum_logf = jnp.cumsum(jax.nn.log_sigmoid(f_pre), axis=-1)
    scale = d ** -0.5
    kpos = jnp.arange(s)

    def block(i):
        start = i * Q_BLOCK
        qb = lax.dynamic_slice_in_dim(q, start, Q_BLOCK, axis=2)
        fq = lax.dynamic_slice_in_dim(cum_logf, start, Q_BLOCK, axis=2)
        logits = jnp.einsum('bhqd,bhkd->bhqk', qb, k).astype(jnp.float32) * scale
        logits = logits + fq[..., :, None] - cum_logf[..., None, :]
        qpos = start + jnp.arange(Q_BLOCK)
        mask = kpos[None, :] <= qpos[:, None]
        p = jax.nn.softmax(jnp.where(mask, logits, NEG_INF), axis=-1)
        return jnp.einsum('bhqk,bhkd->bhqd', p.astype(v.dtype), v)

    out = lax.map(block, jnp.arange(s // Q_BLOCK))
    return out.transpose(1, 2, 0, 3, 4).reshape(b, h, s, d)


def mlstm_chunkwise(q, k, v, i_pre, log_f):
    b, h, s, dk = q.shape
    dv = v.shape[-1]
    nc = s // CHUNK

    def chunks(t):
        return jnp.moveaxis(t.reshape(b, h, nc, CHUNK, *t.shape[3:]), 2, 0)

    causal = jnp.tril(jnp.ones((CHUNK, CHUNK), dtype=bool))

    def body(carry, inp):
        c_prev, n_prev, m_prev = carry
        qc, kc, vc, ic, fc = inp
        bcum = jnp.cumsum(fc, axis=-1)
        dmat = bcum[..., :, None] - bcum[..., None, :] + ic[..., None, :]
        dmat = jnp.where(causal, dmat, NEG_INF)
        inter = bcum + m_prev[..., None]
        m_t = jnp.maximum(inter, jnp.max(dmat, axis=-1))
        w_intra = jnp.exp(dmat - m_t[..., None])
        w_inter = jnp.exp(inter - m_t)
        sc = jnp.einsum('bhtd,bhsd->bhts', qc, kc) * w_intra
        num = (jnp.einsum('bhts,bhsv->bhtv', sc, vc)
               + w_inter[..., None] * jnp.einsum('bhtd,bhvd->bhtv', qc, c_prev))
        den = jnp.sum(sc, axis=-1) + w_inter * jnp.einsum('bhtd,bhd->bht', qc, n_prev)
        h_t = num / jnp.maximum(jnp.abs(den), jnp.exp(-m_t))[..., None]
        b_last = bcum[..., -1]
        w_s = b_last[..., None] - bcum + ic
        m_new = jnp.maximum(b_last + m_prev, jnp.max(w_s, axis=-1))
        decay = jnp.exp(b_last + m_prev - m_new)
        w_s = jnp.exp(w_s - m_new[..., None])
        c_new = decay[..., None, None] * c_prev + jnp.einsum('bhs,bhsv,bhsd->bhvd', w_s, vc, kc)
        n_new = decay[..., None] * n_prev + jnp.einsum('bhs,bhsd->bhd', w_s, kc)
        return (c_new, n_new, m_new), h_t

    init = (jnp.zeros((b, h, dv, dk), jnp.float32),
            jnp.zeros((b, h, dk), jnp.float32),
            jnp.zeros((b, h), jnp.float32))
    _, hs = lax.scan(body, init, (chunks(q), chunks(k), chunks(v), chunks(i_pre), chunks(log_f)))
    return jnp.moveaxis(hs, 0, 2).reshape(b, h, s, dv)


def setup_inputs(seed: int = 0) -> dict:
    key = jax.random.key(seed)
    ks = jax.random.split(key, 13)
    f32 = jnp.float32
    nrm = jax.random.normal
    x = nrm(ks[0], (BATCH, SEQ, D_MODEL), f32)
    norm_w = 1.0 + 0.02 * nrm(ks[1], (DEPTH, D_MODEL), f32)
    w_in = nrm(ks[2], (DEPTH, D_MODEL, IN_COLS), f32) * D_MODEL ** -0.5
    fox_f_bias = jnp.linspace(2.0, 5.0, FOX_HEADS, dtype=f32)[None, :] + 0.1 * nrm(ks[3], (DEPTH, FOX_HEADS), f32)
    conv_w = nrm(ks[4], (DEPTH, CONV_WIDTH, 2 * MLSTM_QK_WIDTH), f32) * CONV_WIDTH ** -0.5
    conv_b = 0.01 * nrm(ks[5], (DEPTH, 2 * MLSTM_QK_WIDTH), f32)
    mlstm_i_bias = -3.0 + 0.1 * nrm(ks[6], (DEPTH, MLSTM_HEADS), f32)
    mlstm_f_bias = jnp.linspace(3.0, 6.0, MLSTM_HEADS, dtype=f32)[None, :] + 0.1 * nrm(ks[7], (DEPTH, MLSTM_HEADS), f32)
    fox_out_norm_w = 1.0 + 0.02 * nrm(ks[8], (DEPTH, FOX_WIDTH), f32)
    mlstm_out_norm_w = 1.0 + 0.02 * nrm(ks[9], (DEPTH, MLSTM_V_WIDTH), f32)
    w_out = nrm(ks[10], (DEPTH, MIX_WIDTH, D_MODEL), f32) * MIX_WIDTH ** -0.5
    final_norm_w = 1.0 + 0.02 * nrm(ks[11], (D_MODEL,), f32)
    return {'x': x, 'norm_w': norm_w, 'w_in': w_in, 'fox_f_bias': fox_f_bias,
            'conv_w': conv_w, 'conv_b': conv_b, 'mlstm_i_bias': mlstm_i_bias,
            'mlstm_f_bias': mlstm_f_bias, 'fox_out_norm_w': fox_out_norm_w,
            'mlstm_out_norm_w': mlstm_out_norm_w, 'w_out': w_out, 'final_norm_w': final_norm_w}


def reference(x, norm_w, w_in, fox_f_bias, conv_w, conv_b, mlstm_i_bias, mlstm_f_bias,
              fox_out_norm_w, mlstm_out_norm_w, w_out, final_norm_w):
    f32 = jnp.float32
    split_idx = [int(v) for v in np.cumsum(IN_SIZES)[:-1]]
    for l in range(DEPTH):
        h = rms_norm(x, norm_w[l])
        proj = jnp.einsum('bsd,de->bse', h, w_in[l])
        (fq, fk, fv, fz, ff, mq, mk, mv, mo, mz, mi, mf) = jnp.split(proj, split_idx, axis=-1)

        f_pre = (ff + fox_f_bias[l]).astype(f32).transpose(0, 2, 1)
        ya = fox_attention(to_heads(fq, FOX_HEADS), to_heads(fk, FOX_HEADS),
                           to_heads(fv, FOX_HEADS), f_pre)
        ya = from_heads(head_rms_norm(ya, fox_out_norm_w[l])) * jax.nn.silu(fz)

        qk = jax.nn.silu(causal_dwconv(jnp.concatenate([mq, mk], axis=-1), conv_w[l], conv_b[l]))
        q_m = to_heads(qk[..., :MLSTM_QK_WIDTH], MLSTM_HEADS).astype(f32)
        k_m = to_heads(qk[..., MLSTM_QK_WIDTH:], MLSTM_HEADS).astype(f32) * MLSTM_QK_DIM ** -0.5
        v_m = to_heads(mv, MLSTM_HEADS).astype(f32)
        i_pre = (mi + mlstm_i_bias[l]).astype(f32).transpose(0, 2, 1)
        log_f = jax.nn.log_sigmoid((mf + mlstm_f_bias[l]).astype(f32)).transpose(0, 2, 1)
        hb = mlstm_chunkwise(q_m, k_m, v_m, i_pre, log_f)
        hb = (hb * jax.nn.sigmoid(to_heads(mo, MLSTM_HEADS).astype(f32))).astype(x.dtype)
        yb = from_heads(head_rms_norm(hb, mlstm_out_norm_w[l])) * jax.nn.silu(mz)

        y = jnp.concatenate([ya, yb], axis=-1)
        x = x + jnp.einsum('bse,ed->bsd', y, w_out[l])
    return rms_norm(x, final_norm_w)
```

```cpp
#include <hip/hip_runtime.h>
#include <hip/hip_cooperative_groups.h>
#include <cstdio>
#include <cstdint>
namespace cg = cooperative_groups;

constexpr int BATCH = 4, SEQ = 4096, DM = 2048, M_TOK = BATCH * SEQ;
constexpr int NH = 8, HD = 128, DK = 64, CHUNK = 64, NCHUNK = SEQ / CHUNK;
constexpr int IN_COLS = 8216, NMAIN = 8192, NGATE = 32;
constexpr float NORM_EPS = 1e-6f;
constexpr float LOG2E = 1.4426950408889634f;
constexpr float QSCALE = 0.08838834764831845f * 1.4426950408889634f;

constexpr size_t MiB = 1u << 20;
constexpr size_t WS_CTL = 0;
constexpr size_t WS_GATE = 2 * MiB;
constexpr size_t WS_ROWSS = 4 * MiB;
constexpr size_t WS_WGT = 6 * MiB;
constexpr size_t WS_KBIAS = 7 * MiB;
constexpr size_t WS_MST = 9 * MiB;
constexpr size_t WS_NLOC = 10 * MiB;
constexpr size_t WS_WOUT = 16 * MiB;
constexpr size_t WS_WIN = 32 * MiB;
constexpr size_t WS_QC = 32 * MiB;
constexpr size_t WS_KC = 48 * MiB;
constexpr size_t WS_XN = 64 * MiB;
constexpr size_t WS_Y = 64 * MiB;
constexpr size_t WS_SEC = 128 * MiB;
constexpr size_t SEC_BYTES = 32 * MiB;
constexpr size_t WS_KLOC = 384 * MiB;
constexpr size_t WS_CPREV = 448 * MiB;
constexpr size_t WS_END = 480 * MiB;
enum { SEC_FQ = 0, SEC_FK, SEC_FV, SEC_FZ, SEC_MQK, SEC_MV, SEC_MO, SEC_MZ };

typedef unsigned short bf16;
typedef unsigned v4u __attribute__((ext_vector_type(4)));
typedef unsigned v2u __attribute__((ext_vector_type(2)));
typedef float f32x16 __attribute__((ext_vector_type(16)));
#define LAS __attribute__((address_space(3)))
#define LDS_WAIT() asm volatile("s_waitcnt lgkmcnt(0)" ::: "memory")

__device__ __forceinline__ unsigned f2bf(float f) { unsigned u = __builtin_bit_cast(unsigned, f); return (u + 0x7fffu + ((u >> 16) & 1u)) >> 16; }
__device__ __forceinline__ unsigned pk2(float lo, float hi) { return f2bf(lo) | (f2bf(hi) << 16); }
__device__ __forceinline__ float bf2f(unsigned h) { return __builtin_bit_cast(float, (h & 0xffffu) << 16); }
__device__ __forceinline__ float bflo(unsigned w) { return __builtin_bit_cast(float, w << 16); }
__device__ __forceinline__ float bfhi(unsigned w) { return __builtin_bit_cast(float, w & 0xffff0000u); }
__device__ __forceinline__ float wave_sum(float v) {
#pragma unroll
    for (int o = 1; o < 64; o <<= 1) v += __shfl_xor(v, o);
    return v;
}
__device__ __forceinline__ float wave_max(float v) {
#pragma unroll
    for (int o = 1; o < 64; o <<= 1) v = fmaxf(v, __shfl_xor(v, o));
    return v;
}
__device__ __forceinline__ float logsigmoidf(float x) { return fminf(x, 0.f) - log1pf(expf(-fabsf(x))); }
__device__ __forceinline__ float siluf(float x) { return x / (1.f + expf(-x)); }
__device__ __forceinline__ float sigmoidf_(float x) { return 1.f / (1.f + expf(-x)); }

namespace pg8 {
#define PG8_LAS __attribute__((address_space(3)))
typedef unsigned short bf16_t;
typedef short bf16x8 __attribute__((ext_vector_type(8)));
typedef float f32x4 __attribute__((ext_vector_type(4)));
typedef unsigned u32x4 __attribute__((ext_vector_type(4)));
constexpr int BM = 256, BK = 64, HALF = 128, HTB = HALF * BK * 2  , STAGE_BYTES = 8 * HTB, NXCD = 8, WGM = 8;

__host__ __device__ __forceinline__ int lds_byte(int r, int c) { const int st = (r >> 4) * 2 + (c >> 5), rr = r & 15, cc = c & 31, ob = rr * 64 + cc * 2; return st * 1024 + (ob ^ (((ob >> 9) & 1) << 5)); }
__host__ __device__ __forceinline__ void stage_rc(int b, int& R, int& C) { const int st = b / 1024, sb = b % 1024, swz = sb ^ (((sb >> 9) & 1) << 5); R = (st >> 1) * 16 + swz / 64; C = (st & 1) * 32 + (swz % 64) / 2; }
__host__ __device__ __forceinline__ int perm32(int rho) { const int n = rho >> 4, i = rho & 15; return 8 * (i >> 2) + 4 * n + (i & 3); }

struct Unit { int pm, pn; };
struct Gemm { const bf16_t* A; const bf16_t* Bt; int M, N, K; };

struct StaticOrder {
    int nM, nN, nwg, G, c;
    __host__ __device__ void init(int M, int N, int G_, int c_) { nM = M / BM; nN = N / BM; nwg = nM * nN; G = G_; c = c_; }
    __host__ __device__ bool next(int i, Unit& u) const {
        const long L = (long)i * G + c; if (L >= nwg) return false;
        int wgid = (int)L; { const int q = nwg / NXCD, r = nwg % NXCD, xcd = wgid % NXCD, off = wgid / NXCD; wgid = (xcd < r ? xcd * (q + 1) : r * (q + 1) + (xcd - r) * q) + off; }
        const int nig = WGM * nN, gid = wgid / nig, fm = gid * WGM, gsz = (nM - fm) < WGM ? (nM - fm) : WGM;
        u.pm = fm + ((wgid % nig) % gsz); u.pn = (wgid % nig) / gsz; return true;
    }
    __device__ __forceinline__ void a_ready(const Unit&) const {}
    __device__ __forceinline__ void done(const Unit&) const {}
};

__device__ __forceinline__ unsigned cvt_pk_bf16(float lo, float hi) { unsigned r; asm volatile("v_cvt_pk_bf16_f32 %0, %1, %2" : "=v"(r) : "v"(lo), "v"(hi)); return r; }

struct EpiProj {
    static constexpr bool PERM = true, AFTER_DRAIN = false;
    unsigned char* secbase; float qscale;
    __device__ __forceinline__ void operator()(const f32x4 (&acc)[2][2][4][2], const Unit& u, int wr, int wc, int fr, int fq) const {
        const int sec = u.pn >> 2, t4 = u.pn & 3;
        const int row0 = u.pm * BM + wr * 64 + fr;
        bf16_t* base = (bf16_t*)(secbase + (size_t)sec * (32u << 20));
        const float sc = sec == 0 ? qscale : 1.f;
        size_t rstride, bjstride, off0;
        if (sec < 3) {
            const int b = row0 >> 12, s0 = row0 & 4095;
            rstride = 128; bjstride = (size_t)4096 * 128; off0 = ((size_t)(b * 8 + t4 * 2) * 4096 + s0) * 128 + wc * 32 + 8 * fq;
        } else {
            rstride = 1024; bjstride = 128; off0 = (size_t)row0 * 1024 + t4 * 256 + wc * 32 + 8 * fq;
        }
#pragma unroll
        for (int ai = 0; ai < 2; ++ai)
#pragma unroll
            for (int m = 0; m < 4; ++m) { bf16_t* rowp = base + off0 + (size_t)(ai * HALF + m * 16) * rstride;
#pragma unroll
                for (int bj = 0; bj < 2; ++bj) { f32x4 v0 = acc[ai][bj][m][0] * sc, v1 = acc[ai][bj][m][1] * sc;
                    u32x4 w; w.x = cvt_pk_bf16(v0[0], v0[1]); w.y = cvt_pk_bf16(v0[2], v0[3]); w.z = cvt_pk_bf16(v1[0], v1[1]); w.w = cvt_pk_bf16(v1[2], v1[3]);
                    *(u32x4*)(rowp + bj * bjstride) = w; } }
    }
};
struct EpiOut {
    static constexpr bool PERM = false, AFTER_DRAIN = false;
    const float* x; float* out; float* rowss;
    __device__ __forceinline__ void operator()(const f32x4 (&acc)[2][2][4][2], const Unit& u, int wr, int wc, int fr, int fq) const {
        const int row0 = u.pm * BM + wr * 64 + fr, col0 = u.pn * BM + wc * 32 + 4 * fq;
#pragma unroll
        for (int ai = 0; ai < 2; ++ai)
#pragma unroll
            for (int m = 0; m < 4; ++m) { const int row = row0 + ai * HALF + m * 16; const size_t off = (size_t)row * 2048 + col0; float ss = 0.f;
#pragma unroll
                for (int bj = 0; bj < 2; ++bj)
#pragma unroll
                    for (int n = 0; n < 2; ++n) { const f32x4 xv = *(const f32x4*)(x + off + bj * HALF + n * 16); const f32x4 o = xv + acc[ai][bj][m][n];
                        ss += (o[0] * o[0] + o[1] * o[1]) + (o[2] * o[2] + o[3] * o[3]); *(f32x4*)(out + off + bj * HALF + n * 16) = o; }
                ss += __shfl_xor(ss, 16); ss += __shfl_xor(ss, 32);
                if (fq == 0) rowss[(size_t)row * 32 + u.pn * 4 + wc] = ss; }
    }
};

template <class Epi, class Sched, bool ALIGN_EPI = false, bool SP2 = false>
__device__ __forceinline__ void gemm_phase(PG8_LAS unsigned char* lds, const Gemm g, const Sched& S, const Epi& E) {
    const int tid = threadIdx.x, wid = __builtin_amdgcn_readfirstlane(tid >> 6), lane = tid & 63, wr = wid >> 2, wc = wid & 3, fr = lane & 15, fq = lane >> 4;
    const int K = g.K, nt = K / BK;
    unsigned voffA[2], voffB[2];
#pragma unroll
    for (int i = 0; i < 2; ++i) { int R, C; stage_rc(tid * 16 + i * 8192, R, C); const int Rb = Epi::PERM ? ((R & ~31) + perm32(R & 31)) : R;
        voffA[i] = (unsigned)(R * K + C) * 2u; voffB[i] = (unsigned)(Rb * K + C) * 2u; }
    const size_t kstep = (size_t)(BK * 2);
    const size_t hstep = (size_t)HALF * K * 2;
    const size_t tstep = 2 * hstep;
    const unsigned ldsw = (unsigned)wid * 1024u;
    const int aoff = lds_byte(wr * 64 + fr, fq * 8), boff = lds_byte(wc * 32 + fr, fq * 8);
#define PG8_SA(b, h) (((b) * 2 + (h)) * HTB)
#define PG8_SB(b, h) ((4 + (b) * 2 + (h)) * HTB)
#define PG8_STAGE(bufoff, gbase, voff) do { _Pragma("unroll") for (int _i = 0; _i < 2; ++_i) \
        __builtin_amdgcn_global_load_lds((const unsigned*)((const char*)(gbase) + (voff)[_i]), (PG8_LAS unsigned*)(lds + (bufoff) + ldsw + _i * 8192), 16, 0, 0); } while (0)
#define PG8_LDA(dst, b, h) do { _Pragma("unroll") for (int m = 0; m < 4; ++m) _Pragma("unroll") for (int k = 0; k < 2; ++k) dst[m][k] = *(const PG8_LAS bf16x8*)(lds + PG8_SA(b, h) + aoff + m * 2048 + k * 1024); } while (0)
#define PG8_LDB(dst, b, h) do { _Pragma("unroll") for (int n = 0; n < 2; ++n) _Pragma("unroll") for (int k = 0; k < 2; ++k) dst[n][k] = *(const PG8_LAS bf16x8*)(lds + PG8_SB(b, h) + boff + n * 2048 + k * 1024); } while (0)
#define PG8_MMA(ai, bj, At, Bt) do { __builtin_amdgcn_s_setprio(1); _Pragma("unroll") for (int m = 0; m < 4; ++m) _Pragma("unroll") for (int n = 0; n < 2; ++n) _Pragma("unroll") for (int k = 0; k < 2; ++k) \
        acc[ai][bj][m][n] = __builtin_amdgcn_mfma_f32_16x16x32_bf16(Bt[n][k], At[m][k], acc[ai][bj][m][n], 0, 0, 0); __builtin_amdgcn_s_setprio(0); } while (0)
#define PG8_WAIT_V(n) asm volatile("s_waitcnt vmcnt(" #n ")" ::: "memory")
#define PG8_WAIT_L(n) asm volatile("s_waitcnt lgkmcnt(" #n ")" ::: "memory")
#define PG8_BAR __builtin_amdgcn_s_barrier()
#define PG8_SCHED __builtin_amdgcn_sched_barrier(0)
    Unit cur, nxt; int ui = 0;
    if (!S.next(0, cur)) return;
    f32x4 acc[2][2][4][2];
#pragma unroll
    for (int a = 0; a < 2; ++a)
#pragma unroll
        for (int b = 0; b < 2; ++b)
#pragma unroll
            for (int m = 0; m < 4; ++m)
#pragma unroll
                for (int n = 0; n < 2; ++n) acc[a][b][m][n] = (f32x4){0.f, 0.f, 0.f, 0.f};
    bf16x8 At[4][2], B0[2][2], B1[2][2];
    const char* cA = (const char*)g.A + (size_t)cur.pm * tstep; const char* cB = (const char*)g.Bt + (size_t)cur.pn * tstep;
    S.a_ready(cur);
    if constexpr (SP2) {
        PG8_STAGE(PG8_SB(0, 0), cB, voffB); PG8_STAGE(PG8_SB(0, 1), cB + hstep, voffB); PG8_STAGE(PG8_SA(0, 0), cA, voffA); PG8_STAGE(PG8_SA(0, 1), cA + hstep, voffA);
        if (wr == 1) PG8_BAR;
        PG8_WAIT_V(2); PG8_BAR;
        PG8_STAGE(PG8_SB(1, 0), cB + kstep, voffB); PG8_STAGE(PG8_SA(1, 0), cA + kstep, voffA); PG8_STAGE(PG8_SB(1, 1), cB + hstep + kstep, voffB);
        PG8_WAIT_V(6); PG8_BAR;
    } else {
        PG8_STAGE(PG8_SB(0, 0), cB, voffB); PG8_STAGE(PG8_SA(0, 0), cA, voffA); PG8_STAGE(PG8_SB(0, 1), cB + hstep, voffB); PG8_STAGE(PG8_SA(0, 1), cA + hstep, voffA);
        if (wr == 1) PG8_BAR;
        PG8_WAIT_V(4); PG8_BAR;
        PG8_STAGE(PG8_SB(1, 0), cB + kstep, voffB); PG8_STAGE(PG8_SA(1, 0), cA + kstep, voffA); PG8_STAGE(PG8_SB(1, 1), cB + hstep + kstep, voffB);
        PG8_WAIT_V(6); PG8_BAR;
    }
    for (;;) {
        const bool has_next = S.next(ui + 1, nxt);
        const char* nA = has_next ? (const char*)g.A + (size_t)nxt.pm * tstep : cA; const char* nB = has_next ? (const char*)g.Bt + (size_t)nxt.pn * tstep : cB;
        for (int t = 0; t < nt; t += 2) {
            const bool last = (t == nt - 2);
            const char* a1 = cA + (size_t)(t + 1) * kstep;
            const char* a2 = last ? nA : cA + (size_t)(t + 2) * kstep; const char* b2 = last ? nB : cB + (size_t)(t + 2) * kstep;
            const char* a3 = a2 + kstep; const char* b3 = b2 + kstep;
            if (last && has_next) S.a_ready(nxt);
            if constexpr (SP2) {
            PG8_LDB(B0, 0, 0); PG8_LDB(B1, 0, 1); PG8_SCHED; PG8_LDA(At, 0, 0); PG8_STAGE(PG8_SA(1, 1), a1 + hstep, voffA);
            PG8_WAIT_V(8); PG8_WAIT_L(0); PG8_BAR; PG8_MMA(0, 0, At, B0); PG8_MMA(0, 1, At, B1); PG8_BAR; PG8_SCHED;
            PG8_LDA(At, 0, 1); PG8_STAGE(PG8_SB(0, 0), b2, voffB); PG8_STAGE(PG8_SB(0, 1), b2 + hstep, voffB); PG8_STAGE(PG8_SA(0, 0), a2, voffA);
            PG8_WAIT_V(8); PG8_WAIT_L(0); PG8_BAR; PG8_MMA(1, 0, At, B0); PG8_MMA(1, 1, At, B1); PG8_BAR; PG8_SCHED;
            PG8_LDB(B0, 1, 0); PG8_LDB(B1, 1, 1); PG8_SCHED; PG8_LDA(At, 1, 0); PG8_STAGE(PG8_SA(0, 1), a2 + hstep, voffA);
            PG8_WAIT_V(8); PG8_WAIT_L(0); PG8_BAR; PG8_MMA(0, 0, At, B0); PG8_MMA(0, 1, At, B1); PG8_BAR; PG8_SCHED;
            PG8_LDA(At, 1, 1); PG8_STAGE(PG8_SB(1, 0), b3, voffB); PG8_STAGE(PG8_SB(1, 1), b3 + hstep, voffB); PG8_STAGE(PG8_SA(1, 0), a3, voffA);
            PG8_WAIT_V(8); PG8_WAIT_L(0); PG8_BAR; PG8_MMA(1, 0, At, B0); PG8_MMA(1, 1, At, B1); PG8_BAR; PG8_SCHED;
            } else {
            PG8_LDB(B0, 0, 0); PG8_SCHED; PG8_LDA(At, 0, 0); PG8_STAGE(PG8_SA(1, 1), a1 + hstep, voffA);
            PG8_WAIT_L(8); PG8_BAR; PG8_WAIT_L(0); PG8_MMA(0, 0, At, B0); PG8_BAR; PG8_SCHED;
            PG8_LDB(B1, 0, 1); PG8_STAGE(PG8_SB(0, 0), b2, voffB);
            PG8_BAR; PG8_WAIT_L(0); PG8_MMA(0, 1, At, B1); PG8_BAR;
            PG8_LDA(At, 0, 1); PG8_STAGE(PG8_SA(0, 0), a2, voffA);
            PG8_BAR; PG8_WAIT_L(0); PG8_MMA(1, 0, At, B0); PG8_BAR; PG8_SCHED;
            PG8_STAGE(PG8_SB(0, 1), b2 + hstep, voffB);
            PG8_WAIT_V(6); PG8_BAR; PG8_MMA(1, 1, At, B1); PG8_BAR;
            PG8_LDB(B0, 1, 0); PG8_SCHED; PG8_LDA(At, 1, 0); PG8_STAGE(PG8_SA(0, 1), a2 + hstep, voffA);
            PG8_WAIT_L(8); PG8_BAR; PG8_WAIT_L(0); PG8_MMA(0, 0, At, B0); PG8_BAR; PG8_SCHED;
            PG8_LDB(B1, 1, 1); PG8_STAGE(PG8_SB(1, 0), b3, voffB);
            PG8_BAR; PG8_WAIT_L(0); PG8_MMA(0, 1, At, B1); PG8_BAR;
            PG8_LDA(At, 1, 1); PG8_STAGE(PG8_SA(1, 0), a3, voffA);
            PG8_BAR; PG8_WAIT_L(0); PG8_MMA(1, 0, At, B0); PG8_BAR; PG8_SCHED;
            PG8_STAGE(PG8_SB(1, 1), b3 + hstep, voffB);
            PG8_WAIT_V(6); PG8_BAR; PG8_MMA(1, 1, At, B1); PG8_BAR;
            }
        }
        if constexpr (ALIGN_EPI) { if (wr == 0) PG8_BAR; }
        if constexpr (!Epi::AFTER_DRAIN) { E(acc, cur, wr, wc, fr, fq); S.done(cur); }
        if (!has_next) break;
#pragma unroll
        for (int a = 0; a < 2; ++a)
#pragma unroll
            for (int b = 0; b < 2; ++b)
#pragma unroll
                for (int m = 0; m < 4; ++m)
#pragma unroll
                    for (int n = 0; n < 2; ++n) acc[a][b][m][n] = (f32x4){0.f, 0.f, 0.f, 0.f};
        cur = nxt; cA = nA; cB = nB; ++ui;
        if constexpr (ALIGN_EPI) { if (wr == 1) PG8_BAR; }
    }
    PG8_WAIT_V(0);
    if constexpr (!ALIGN_EPI) { if (wr == 0) PG8_BAR; }
    PG8_BAR;
    if constexpr (Epi::AFTER_DRAIN) { E.fused(acc, cur, wr, wc, fr, fq, lds, wid, lane); S.done(cur); }
#undef PG8_SA
#undef PG8_SB
#undef PG8_STAGE
#undef PG8_LDA
#undef PG8_LDB
#undef PG8_MMA
#undef PG8_WAIT_V
#undef PG8_WAIT_L
#undef PG8_BAR
#undef PG8_SCHED
}
}
struct Args { const float* in[12]; float* out; unsigned char* ws; int ph_lo, ph_hi; };
enum { IN_X = 0, IN_NORMW, IN_WIN, IN_FOXFB, IN_CONVW, IN_CONVB, IN_MIB, IN_MFB, IN_FOXNW, IN_MNW, IN_WOUT, IN_FINW };
constexpr int NWAVES = 8, NTHREADS = 512;
constexpr int LDS_BYTES = 147456;

template <class ColMap>
__device__ __forceinline__ void p0_transpose_item(const float* W, int ldw, int k0, ColMap cm, bf16* WT  , int K, LAS float* scr, int lane) {
    const int sc = cm(lane & 31);
#pragma unroll 8
    for (int i = 0; i < 32; ++i) { const int kk = 2 * i + (lane >> 5); scr[kk * 33 + (lane & 31)] = sc >= 0 ? W[(size_t)(k0 + kk) * ldw + sc] : 0.f; }
    LDS_WAIT(); asm volatile("" ::: "memory");
    const int c = lane & 7;
#pragma unroll
    for (int j = 0; j < 4; ++j) { const int n = (lane >> 3) + 8 * j; const LAS float* s = scr + (8 * c) * 33 + n;
        v4u o; o.x = pk2(s[0 * 33], s[1 * 33]); o.y = pk2(s[2 * 33], s[3 * 33]); o.z = pk2(s[4 * 33], s[5 * 33]); o.w = pk2(s[6 * 33], s[7 * 33]);
        *(v4u*)(WT + (size_t)n * K + k0 + 8 * c) = o; }
    LDS_WAIT(); asm volatile("" ::: "memory");
}
struct MapMain { int n0; __device__ int operator()(int n) const { const int c = n0 + n; return c < 4096 ? c : c + 8; } };
struct MapGate { __device__ int operator()(int n) const { return n < 8 ? 4096 + n : n < 16 ? 8200 + (n - 8) : n < 24 ? 8208 + (n - 16) : -1; } };
struct MapPlain { int n0; __device__ int operator()(int n) const { return n0 + n; } };

__device__ __forceinline__ void phase_prep(const Args& a, LAS unsigned char* lds, int nblk, int blk) {
    const int tid = threadIdx.x, lane = tid & 63, wave = tid >> 6;
    LAS float* scr = (LAS float*)(lds + wave * 16384);
    const int gw = blk * NWAVES + wave, NGW = nblk * NWAVES;
    const float* win = a.in[IN_WIN]; const float* wout = a.in[IN_WOUT];
    bf16* WIN_T = (bf16*)(a.ws + WS_WIN); bf16* WG_T = (bf16*)(a.ws + WS_WGT); bf16* WOUT_T = (bf16*)(a.ws + WS_WOUT);
    constexpr int I_MAIN = 32 * 256, I_GATE = 32, I_OUT = 32 * 64, NITEMS = I_MAIN + I_GATE + I_OUT;
    for (int it = gw; it < NITEMS; it += NGW) {
        int r = it;
        if (r < I_MAIN) { const int kb = r >> 8, nb = r & 255; p0_transpose_item(win, IN_COLS, 64 * kb, MapMain{32 * nb}, WIN_T + (size_t)(32 * nb) * DM, DM, scr, lane); continue; } r -= I_MAIN;
        if (r < I_GATE) { p0_transpose_item(win, IN_COLS, 64 * r, MapGate{}, WG_T, DM, scr, lane); continue; } r -= I_GATE;
        { const int kb = r >> 6, nb = r & 63; p0_transpose_item(wout, DM, 64 * kb, MapPlain{32 * nb}, WOUT_T + (size_t)(32 * nb) * DM, DM, scr, lane); }
    }
    const float* x = a.in[IN_X]; const float* nw = a.in[IN_NORMW]; bf16* XN = (bf16*)(a.ws + WS_XN);
    for (int m = gw; m < M_TOK; m += NGW) {
        const pg8::f32x4* xr = (const pg8::f32x4*)(x + (size_t)m * DM) + lane; const pg8::f32x4* wr = (const pg8::f32x4*)nw + lane;
        pg8::f32x4 v[8]; float s = 0.f;
#pragma unroll
        for (int j = 0; j < 8; ++j) { v[j] = xr[64 * j]; s += (v[j][0] * v[j][0] + v[j][1] * v[j][1]) + (v[j][2] * v[j][2] + v[j][3] * v[j][3]); }
        const float rstd = 1.0f / sqrtf(wave_sum(s) * (1.f / DM) + NORM_EPS);
        unsigned long long* o8 = (unsigned long long*)(XN + (size_t)m * DM) + lane;
#pragma unroll
        for (int j = 0; j < 8; ++j) { const pg8::f32x4 g = wr[64 * j];
            o8[64 * j] = (unsigned long long)pk2(v[j][0] * rstd * g[0], v[j][1] * rstd * g[1]) | ((unsigned long long)pk2(v[j][2] * rstd * g[2], v[j][3] * rstd * g[3]) << 32); }
    }
}

__device__ __forceinline__ void gate_unit(const Args& a, LAS unsigned char* lds, int c) {
    const int tid = threadIdx.x, lane = tid & 63, wave = tid >> 6, r32 = lane & 31, hi = lane >> 5;
    const bf16* XN = (const bf16*)(a.ws + WS_XN); const bf16* WG_T = (const bf16*)(a.ws + WS_WGT);
    f32x16 acc0 = {}, acc1 = {};
    const bf16* a0 = XN + (size_t)(64 * c + r32) * DM + 256 * wave + 8 * hi; const bf16* a1 = a0 + (size_t)32 * DM;
    const bf16* bp = WG_T + (size_t)r32 * DM + 256 * wave + 8 * hi;
#pragma unroll 4
    for (int ks = 0; ks < 16; ++ks) {
        const pg8::bf16x8 A0 = *(const pg8::bf16x8*)(a0 + 16 * ks), A1 = *(const pg8::bf16x8*)(a1 + 16 * ks), Bf = *(const pg8::bf16x8*)(bp + 16 * ks);
        acc0 = __builtin_amdgcn_mfma_f32_32x32x16_bf16(A0, Bf, acc0, 0, 0, 0);
        acc1 = __builtin_amdgcn_mfma_f32_32x32x16_bf16(A1, Bf, acc1, 0, 0, 0);
    }
    LAS float* part = (LAS float*)lds;
#pragma unroll
    for (int r = 0; r < 16; ++r) { const int row = (r & 3) + 8 * (r >> 2) + 4 * hi;
        part[(wave * 64 + row) * 32 + r32] = acc0[r]; part[(wave * 64 + 32 + row) * 32 + r32] = acc1[r]; }
    __syncthreads();
    float* G = (float*)(a.ws + WS_GATE);
    for (int e = tid; e < 64 * 32; e += NTHREADS) { const int row = e >> 5, j = e & 31; float s = 0.f;
#pragma unroll
        for (int w = 0; w < 8; ++w) s += part[(w * 64 + row) * 32 + j];
        float v;
        if (j < 8) v = logsigmoidf(s + a.in[IN_FOXFB][j]); else if (j < 16) v = s + a.in[IN_MIB][j - 8]; else if (j < 24) v = logsigmoidf(s + a.in[IN_MFB][j - 16]); else v = 0.f;
        G[(size_t)(64 * c + row) * 32 + j] = v; }
    __syncthreads();
}

__device__ __forceinline__ void fox_cumsum_item(const Args& a, LAS unsigned char* lds, int bh) {
    const int tid = threadIdx.x, lane = tid & 63, wave = tid >> 6; const int b = bh >> 3, h = bh & 7;
    const float* G = (const float*)(a.ws + WS_GATE); bf16* KB = (bf16*)(a.ws + WS_KBIAS);
    LAS float* wtot = (LAS float*)lds;
    float v[8]; float run = 0.f;
#pragma unroll
    for (int j = 0; j < 8; ++j) { run += G[(size_t)(b * SEQ + 8 * tid + j) * 32 + h]; v[j] = run; }
    float incl = run;
#pragma unroll
    for (int o = 1; o < 64; o <<= 1) { const float t = __shfl_up(incl, o); if (lane >= o) incl += t; }
    if (lane == 63) wtot[wave] = incl;
    __syncthreads();
    float base = incl - run;
    for (int w = 0; w < wave; ++w) base += wtot[w];
#pragma unroll
    for (int j = 0; j < 8; ++j) { const float kb2 = -(base + v[j]) * LOG2E;
        const unsigned h1 = f2bf(kb2); const float r1 = kb2 - bf2f(h1); const unsigned h2 = f2bf(r1); const float r2 = r1 - bf2f(h2); const unsigned h3 = f2bf(r2);
        v4u o; o.x = h1 | (h2 << 16); o.y = h3; o.z = 0u; o.w = 0u;
        *(v4u*)(KB + ((size_t)bh * SEQ + 8 * tid + j) * 8) = o; }
    __syncthreads();
}

__device__ __forceinline__ void conv_item(const Args& a, int item) {
    const int tid = threadIdx.x; const int cg8 = tid & 127, tq = tid >> 7;
    const int c0 = cg8 * 8; const int tok0 = item * 64 + tq * 16;
    const bf16* MQK = (const bf16*)(a.ws + WS_SEC + SEC_MQK * SEC_BYTES);
    const float* cw = a.in[IN_CONVW]; const float* cb = a.in[IN_CONVB];
    float w[4][8], bias[8];
#pragma unroll
    for (int j = 0; j < 4; ++j)
#pragma unroll
        for (int e = 0; e < 8; ++e) w[j][e] = cw[j * 1024 + c0 + e];
#pragma unroll
    for (int e = 0; e < 8; ++e) bias[e] = cb[c0 + e];
    const bool isk = c0 >= 512; const int hh = (c0 & 511) >> 6, d0 = c0 & 63;
    bf16* dst = (bf16*)(a.ws + (isk ? WS_KC : WS_QC));
    const float osc = isk ? 0.125f : 1.f;
    float u[4][8];
    const int s0 = tok0 & (SEQ - 1);
#pragma unroll
    for (int j = 0; j < 3; ++j) { const int s = s0 - 3 + j;
        if (s >= 0) { const v4u r = *(const v4u*)(MQK + (size_t)(tok0 - 3 + j) * 1024 + c0);
            u[j][0] = bflo(r.x); u[j][1] = bfhi(r.x); u[j][2] = bflo(r.y); u[j][3] = bfhi(r.y); u[j][4] = bflo(r.z); u[j][5] = bfhi(r.z); u[j][6] = bflo(r.w); u[j][7] = bfhi(r.w); }
        else {
#pragma unroll
            for (int e = 0; e < 8; ++e) u[j][e] = 0.f; } }
    const int bb = tok0 >> 12;
#pragma unroll
    for (int t = 0; t < 16; ++t) {
        const v4u r = *(const v4u*)(MQK + (size_t)(tok0 + t) * 1024 + c0);
        u[3][0] = bflo(r.x); u[3][1] = bfhi(r.x); u[3][2] = bflo(r.y); u[3][3] = bfhi(r.y); u[3][4] = bflo(r.z); u[3][5] = bfhi(r.z); u[3][6] = bflo(r.w); u[3][7] = bfhi(r.w);
        float y[8];
#pragma unroll
        for (int e = 0; e < 8; ++e) { float s = u[0][e] * w[0][e]; s += u[1][e] * w[1][e]; s += u[2][e] * w[2][e]; s += u[3][e] * w[3][e]; s += bias[e]; y[e] = siluf(s) * osc; }
        v4u o; o.x = pk2(y[0], y[1]); o.y = pk2(y[2], y[3]); o.z = pk2(y[4], y[5]); o.w = pk2(y[6], y[7]);
        *(v4u*)(dst + ((size_t)(bb * 8 + hh) * SEQ + (s0 + t)) * 64 + d0) = o;
#pragma unroll
        for (int e = 0; e < 8; ++e) { u[0][e] = u[1][e]; u[1][e] = u[2][e]; u[2][e] = u[3][e]; }
    }
}

__device__ __forceinline__ void phase_final(const Args& a, int nblk, int blk) {
    const int tid = threadIdx.x, lane = tid & 63, wave = tid >> 6; const int gw = blk * NWAVES + wave, NGW = nblk * NWAVES;
    const float* rowss = (const float*)(a.ws + WS_ROWSS); const float* fw = a.in[IN_FINW];
    for (int m = gw; m < M_TOK; m += NGW) {
        float s = lane < 32 ? rowss[(size_t)m * 32 + lane] : 0.f;
        s = wave_sum(s);
        const float rstd = 1.0f / sqrtf(s * (1.f / DM) + NORM_EPS);
        pg8::f32x4* o = (pg8::f32x4*)(a.out + (size_t)m * DM) + lane; const pg8::f32x4* g = (const pg8::f32x4*)fw + lane;
#pragma unroll
        for (int j = 0; j < 8; ++j) { pg8::f32x4 v = o[64 * j]; const pg8::f32x4 gg = g[64 * j]; v = v * rstd * gg; o[64 * j] = v; }
    }
}

__global__ void __launch_bounds__(NTHREADS, 2) k_prep(Args a) {
    extern __shared__ __attribute__((aligned(16))) unsigned char lds[];
    phase_prep(a, (LAS unsigned char*)lds, gridDim.x, blockIdx.x);
}
__global__ void __launch_bounds__(NTHREADS, 2) k_gemm1(Args a) {
    extern __shared__ __attribute__((aligned(16))) unsigned char lds[];
    for (int c = blockIdx.x; c < M_TOK / 64; c += gridDim.x) gate_unit(a, (LAS unsigned char*)lds, c);
    pg8::Gemm g{(const pg8::bf16_t*)(a.ws + WS_XN), (const pg8::bf16_t*)(a.ws + WS_WIN), M_TOK, NMAIN, DM};
    pg8::StaticOrder S; S.init(M_TOK, NMAIN, gridDim.x, blockIdx.x);
    pg8::EpiProj E{a.ws + WS_SEC, QSCALE};
    pg8::gemm_phase<pg8::EpiProj, pg8::StaticOrder, true, true>((LAS unsigned char*)lds, g, S, E);
}
__global__ void __launch_bounds__(NTHREADS, 2) k_gemm2(Args a) {
    extern __shared__ __attribute__((aligned(16))) unsigned char lds[];
    pg8::Gemm g{(const pg8::bf16_t*)(a.ws + WS_Y), (const pg8::bf16_t*)(a.ws + WS_WOUT), M_TOK, DM, DM};
    pg8::StaticOrder S; S.init(M_TOK, DM, gridDim.x, blockIdx.x);
    pg8::EpiOut E{a.in[IN_X], a.out, (float*)(a.ws + WS_ROWSS)};
    pg8::gemm_phase<pg8::EpiOut, pg8::StaticOrder, true, true>((LAS unsigned char*)lds, g, S, E);
}
__global__ void __launch_bounds__(NTHREADS, 2) k_scan(Args a) {
    extern __shared__ __attribute__((aligned(16))) unsigned char lds[];
    for (int it = blockIdx.x; it < BATCH * NH; it += gridDim.x) fox_cumsum_item(a, (LAS unsigned char*)lds, it);
}
__global__ void __launch_bounds__(NTHREADS, 2) k_conv(Args a) {
    for (int it = blockIdx.x; it < M_TOK / 64; it += gridDim.x) conv_item(a, it);
}
__global__ void __launch_bounds__(NTHREADS, 2) k_final(Args a) { phase_final(a, gridDim.x, blockIdx.x); }

__global__ void __launch_bounds__(NTHREADS, 2) k_naive_attn(Args a) {
    __shared__ float qs[NWAVES][128];
    const int tid = threadIdx.x, lane = tid & 63, wave = tid >> 6;
    const int gw = blockIdx.x * NWAVES + wave; const int bh = gw >> 12, t = gw & 4095, b = bh >> 3, h = bh & 7;
    const bf16* FQ = (const bf16*)(a.ws + WS_SEC + SEC_FQ * SEC_BYTES); const bf16* FK = (const bf16*)(a.ws + WS_SEC + SEC_FK * SEC_BYTES);
    const bf16* FV = (const bf16*)(a.ws + WS_SEC + SEC_FV * SEC_BYTES); const bf16* FZ = (const bf16*)(a.ws + WS_SEC + SEC_FZ * SEC_BYTES);
    const bf16* KB = (const bf16*)(a.ws + WS_KBIAS); bf16* Y = (bf16*)(a.ws + WS_Y);
    { const unsigned w = *(const unsigned*)(FQ + ((size_t)bh * SEQ + t) * 128 + 2 * lane); qs[wave][2 * lane] = bflo(w); qs[wave][2 * lane + 1] = bfhi(w); }
    __syncthreads();
    float m = -1e30f, l = 0.f, o0 = 0.f, o1 = 0.f;
    for (int s0 = 0; s0 <= t; s0 += 64) {
        const int s = s0 + lane; const bool valid = s <= t;
        float sc = -__builtin_inff();
        if (valid) { float dot = 0.f; const v4u* kr = (const v4u*)(FK + ((size_t)bh * SEQ + s) * 128);
            for (int c = 0; c < 16; ++c) { const v4u r = kr[c]; const float* q = &qs[wave][8 * c];
                dot += q[0] * bflo(r.x) + q[1] * bfhi(r.x) + q[2] * bflo(r.y) + q[3] * bfhi(r.y) + q[4] * bflo(r.z) + q[5] * bfhi(r.z) + q[6] * bflo(r.w) + q[7] * bfhi(r.w); }
            const v2u kb = *(const v2u*)(KB + ((size_t)bh * SEQ + s) * 8);
            sc = dot + ((bflo(kb.x) + bfhi(kb.x)) + bflo(kb.y)); }
        const float mx = wave_max(sc), mn = fmaxf(m, mx), alpha = exp2f(m - mn);
        const float p = valid ? exp2f(sc - mn) : 0.f;
        l = l * alpha + wave_sum(p); o0 *= alpha; o1 *= alpha; m = mn;
        const int nk = (t - s0 + 1) < 64 ? (t - s0 + 1) : 64;
        for (int k = 0; k < nk; ++k) { const float pk = __shfl(p, k); const unsigned w = *(const unsigned*)(FV + ((size_t)bh * SEQ + s0 + k) * 128 + 2 * lane);
            o0 += pk * bflo(w); o1 += pk * bfhi(w); }
    }
    o0 /= l; o1 /= l;
    const float ss = wave_sum(o0 * o0 + o1 * o1); const float r = 1.0f / sqrtf(ss * (1.f / 128.f) + NORM_EPS);
    const size_t tok = (size_t)b * SEQ + t; const float* g = a.in[IN_FOXNW] + h * 128 + 2 * lane;
    const unsigned zw = *(const unsigned*)(FZ + tok * 1024 + h * 128 + 2 * lane);
    const float y0 = o0 * r * g[0] * siluf(bflo(zw)), y1 = o1 * r * g[1] * siluf(bfhi(zw));
    *(unsigned*)(Y + tok * 2048 + h * 128 + 2 * lane) = pk2(y0, y1);
}

__global__ void __launch_bounds__(NTHREADS, 2) k_naive_mlstm(Args a) {
    const int tid = threadIdx.x, v = tid >> 2, dq = tid & 3; const int bh = blockIdx.x, b = bh >> 3, h = bh & 7;
    const bf16* QC = (const bf16*)(a.ws + WS_QC); const bf16* KC = (const bf16*)(a.ws + WS_KC);
    const bf16* MV = (const bf16*)(a.ws + WS_SEC + SEC_MV * SEC_BYTES); const bf16* MO = (const bf16*)(a.ws + WS_SEC + SEC_MO * SEC_BYTES);
    const float* G = (const float*)(a.ws + WS_GATE); float* HB = (float*)(a.ws + WS_KLOC);
    float C[16], n[16]; float m = 0.f;
#pragma unroll
    for (int j = 0; j < 16; ++j) { C[j] = 0.f; n[j] = 0.f; }
    for (int t = 0; t < SEQ; ++t) {
        const size_t tok = (size_t)b * SEQ + t;
        const v4u q0 = *(const v4u*)(QC + ((size_t)bh * SEQ + t) * 64 + 16 * dq), q1 = *(const v4u*)(QC + ((size_t)bh * SEQ + t) * 64 + 16 * dq + 8);
        const v4u k0 = *(const v4u*)(KC + ((size_t)bh * SEQ + t) * 64 + 16 * dq), k1 = *(const v4u*)(KC + ((size_t)bh * SEQ + t) * 64 + 16 * dq + 8);
        const float vv = bf2f(MV[tok * 1024 + h * 128 + v]);
        const float ig = G[tok * 32 + 8 + h], lf = G[tok * 32 + 16 + h];
        float q[16], k[16];
        q[0] = bflo(q0.x); q[1] = bfhi(q0.x); q[2] = bflo(q0.y); q[3] = bfhi(q0.y); q[4] = bflo(q0.z); q[5] = bfhi(q0.z); q[6] = bflo(q0.w); q[7] = bfhi(q0.w);
        q[8] = bflo(q1.x); q[9] = bfhi(q1.x); q[10] = bflo(q1.y); q[11] = bfhi(q1.y); q[12] = bflo(q1.z); q[13] = bfhi(q1.z); q[14] = bflo(q1.w); q[15] = bfhi(q1.w);
        k[0] = bflo(k0.x); k[1] = bfhi(k0.x); k[2] = bflo(k0.y); k[3] = bfhi(k0.y); k[4] = bflo(k0.z); k[5] = bfhi(k0.z); k[6] = bflo(k0.w); k[7] = bfhi(k0.w);
        k[8] = bflo(k1.x); k[9] = bfhi(k1.x); k[10] = bflo(k1.y); k[11] = bfhi(k1.y); k[12] = bflo(k1.z); k[13] = bfhi(k1.z); k[14] = bflo(k1.w); k[15] = bfhi(k1.w);
        const float mn = fmaxf(lf + m, ig), fd = expf(lf + m - mn), iw = expf(ig - mn); m = mn;
        float num = 0.f, den = 0.f;
#pragma unroll
        for (int j = 0; j < 16; ++j) { C[j] = fd * C[j] + iw * vv * k[j]; n[j] = fd * n[j] + iw * k[j]; num += C[j] * q[j]; den += n[j] * q[j]; }
        num += __shfl_xor(num, 1); num += __shfl_xor(num, 2); den += __shfl_xor(den, 1); den += __shfl_xor(den, 2);
        const float hv = num / fmaxf(fabsf(den), expf(-m));
        const float og = bf2f(MO[tok * 1024 + h * 128 + v]);
        if (dq == 0) HB[tok * 1024 + h * 128 + v] = hv * sigmoidf_(og);
    }
}
__global__ void __launch_bounds__(NTHREADS, 2) k_mlstm_post(Args a) {
    const int tid = threadIdx.x, lane = tid & 63, wave = tid >> 6; const int gw = blockIdx.x * NWAVES + wave;
    const int tok = gw >> 3, h = gw & 7;
    const float* HB = (const float*)(a.ws + WS_KLOC); const bf16* MZ = (const bf16*)(a.ws + WS_SEC + SEC_MZ * SEC_BYTES); bf16* Y = (bf16*)(a.ws + WS_Y);
    const float h0 = HB[(size_t)tok * 1024 + h * 128 + 2 * lane], h1 = HB[(size_t)tok * 1024 + h * 128 + 2 * lane + 1];
    const float ss = wave_sum(h0 * h0 + h1 * h1); const float r = 1.0f / sqrtf(ss * (1.f / 128.f) + NORM_EPS);
    const float* g = a.in[IN_MNW] + h * 128 + 2 * lane;
    const unsigned zw = *(const unsigned*)(MZ + (size_t)tok * 1024 + h * 128 + 2 * lane);
    *(unsigned*)(Y + (size_t)tok * 2048 + 1024 + h * 128 + 2 * lane) = pk2(h0 * r * g[0] * siluf(bflo(zw)), h1 * r * g[1] * siluf(bfhi(zw)));
}

extern "C" void kernel_launch(void* const* d_in, const int* in_sizes, int n_in, void* d_out, int out_size, void* d_ws, size_t ws_size, hipStream_t stream) {
    static int ok = 0;
    if (ok == 0) {
        if (n_in != 12 || in_sizes[0] != M_TOK * DM || in_sizes[2] != DM * IN_COLS || out_size != M_TOK * DM || ws_size < WS_END) {
            fprintf(stderr, "kernel_launch: shape mismatch n_in %d in0 %d in2 %d out %d ws %zu\n", n_in, n_in > 0 ? in_sizes[0] : -1, n_in > 2 ? in_sizes[2] : -1, out_size, ws_size); ok = -1; return; }
        hipFuncSetAttribute((const void*)k_prep, hipFuncAttributeMaxDynamicSharedMemorySize, LDS_BYTES);
        hipFuncSetAttribute((const void*)k_gemm1, hipFuncAttributeMaxDynamicSharedMemorySize, LDS_BYTES);
        hipFuncSetAttribute((const void*)k_gemm2, hipFuncAttributeMaxDynamicSharedMemorySize, LDS_BYTES);
        hipFuncSetAttribute((const void*)k_scan, hipFuncAttributeMaxDynamicSharedMemorySize, LDS_BYTES);
        ok = 1;
    }
    if (ok < 0) return;
    Args a{};
    for (int i = 0; i < 12; ++i) a.in[i] = (const float*)d_in[i];
    a.out = (float*)d_out; a.ws = (unsigned char*)d_ws; a.ph_lo = 0; a.ph_hi = 0;
    hipLaunchKernelGGL(k_prep, dim3(256), dim3(NTHREADS), LDS_BYTES, stream, a);
    hipLaunchKernelGGL(k_gemm1, dim3(256), dim3(NTHREADS), LDS_BYTES, stream, a);
    hipLaunchKernelGGL(k_scan, dim3(32), dim3(NTHREADS), LDS_BYTES, stream, a);
    hipLaunchKernelGGL(k_conv, dim3(256), dim3(NTHREADS), 0, stream, a);
    hipLaunchKernelGGL(k_naive_attn, dim3(BATCH * NH * SEQ / NWAVES), dim3(NTHREADS), 0, stream, a);
    hipLaunchKernelGGL(k_naive_mlstm, dim3(BATCH * NH), dim3(NTHREADS), 0, stream, a);
    hipLaunchKernelGGL(k_mlstm_post, dim3(M_TOK * NH / NWAVES), dim3(NTHREADS), 0, stream, a);
    hipLaunchKernelGGL(k_gemm2, dim3(256), dim3(NTHREADS), LDS_BYTES, stream, a);
    hipLaunchKernelGGL(k_final, dim3(256), dim3(NTHREADS), 0, stream, a);
}
```

```cpp
#include <hip/hip_runtime.h>
#include <hip/hip_cooperative_groups.h>
#include <cstdio>
#include <cstdint>
namespace cg = cooperative_groups;

constexpr int BATCH = 4, SEQ = 4096, DM = 2048, M_TOK = BATCH * SEQ;
constexpr int NH = 8, HD = 128, DK = 64, CHUNK = 64, NCHUNK = SEQ / CHUNK;
constexpr int IN_COLS = 8216, NMAIN = 8192, NGATE = 32;
constexpr float NORM_EPS = 1e-6f;
constexpr float LOG2E = 1.4426950408889634f;
constexpr float QSCALE = 0.08838834764831845f * 1.4426950408889634f;

constexpr size_t MiB = 1u << 20;
constexpr size_t WS_CTL = 0;
constexpr size_t WS_GATE = 2 * MiB;
constexpr size_t WS_ROWSS = 4 * MiB;
constexpr size_t WS_WGT = 6 * MiB;
constexpr size_t WS_KBIAS = 7 * MiB;
constexpr size_t WS_MST = 9 * MiB;
constexpr size_t WS_NLOC = 10 * MiB;
constexpr size_t WS_WOUT = 16 * MiB;
constexpr size_t WS_WIN = 32 * MiB;
constexpr size_t WS_QC = 32 * MiB;
constexpr size_t WS_KC = 48 * MiB;
constexpr size_t WS_XN = 64 * MiB;
constexpr size_t WS_Y = 64 * MiB;
constexpr size_t WS_SEC = 128 * MiB;
constexpr size_t SEC_BYTES = 32 * MiB;
constexpr size_t WS_KLOC = 384 * MiB;
constexpr size_t WS_CPREV = 448 * MiB;
constexpr size_t WS_END = 480 * MiB;
enum { SEC_FQ = 0, SEC_FK, SEC_FV, SEC_FZ, SEC_MQK, SEC_MV, SEC_MO, SEC_MZ };

typedef unsigned short bf16;
typedef unsigned v4u __attribute__((ext_vector_type(4)));
typedef unsigned v2u __attribute__((ext_vector_type(2)));
typedef float f32x16 __attribute__((ext_vector_type(16)));
#define LAS __attribute__((address_space(3)))
#define LDS_WAIT() asm volatile("s_waitcnt lgkmcnt(0)" ::: "memory")

__device__ __forceinline__ unsigned f2bf(float f) { unsigned u = __builtin_bit_cast(unsigned, f); return (u + 0x7fffu + ((u >> 16) & 1u)) >> 16; }
__device__ __forceinline__ unsigned pk2(float lo, float hi) { return f2bf(lo) | (f2bf(hi) << 16); }
__device__ __forceinline__ float bf2f(unsigned h) { return __builtin_bit_cast(float, (h & 0xffffu) << 16); }
__device__ __forceinline__ float bflo(unsigned w) { return __builtin_bit_cast(float, w << 16); }
__device__ __forceinline__ float bfhi(unsigned w) { return __builtin_bit_cast(float, w & 0xffff0000u); }
__device__ __forceinline__ float wave_sum(float v) {
#pragma unroll
    for (int o = 1; o < 64; o <<= 1) v += __shfl_xor(v, o);
    return v;
}
__device__ __forceinline__ float wave_max(float v) {
#pragma unroll
    for (int o = 1; o < 64; o <<= 1) v = fmaxf(v, __shfl_xor(v, o));
    return v;
}
__device__ __forceinline__ float logsigmoidf(float x) { return fminf(x, 0.f) - log1pf(expf(-fabsf(x))); }
__device__ __forceinline__ float siluf(float x) { return x / (1.f + expf(-x)); }
__device__ __forceinline__ float sigmoidf_(float x) { return 1.f / (1.f + expf(-x)); }

namespace pg8 {
#define PG8_LAS __attribute__((address_space(3)))
typedef unsigned short bf16_t;
typedef short bf16x8 __attribute__((ext_vector_type(8)));
typedef float f32x4 __attribute__((ext_vector_type(4)));
typedef unsigned u32x4 __attribute__((ext_vector_type(4)));
constexpr int BM = 256, BK = 64, HALF = 128, HTB = HALF * BK * 2  , STAGE_BYTES = 8 * HTB, NXCD = 8, WGM = 8;

__host__ __device__ __forceinline__ int lds_byte(int r, int c) { const int st = (r >> 4) * 2 + (c >> 5), rr = r & 15, cc = c & 31, ob = rr * 64 + cc * 2; return st * 1024 + (ob ^ (((ob >> 9) & 1) << 5)); }
__host__ __device__ __forceinline__ void stage_rc(int b, int& R, int& C) { const int st = b / 1024, sb = b % 1024, swz = sb ^ (((sb >> 9) & 1) << 5); R = (st >> 1) * 16 + swz / 64; C = (st & 1) * 32 + (swz % 64) / 2; }
__host__ __device__ __forceinline__ int perm32(int rho) { const int n = rho >> 4, i = rho & 15; return 8 * (i >> 2) + 4 * n + (i & 3); }

struct Unit { int pm, pn; };
struct Gemm { const bf16_t* A; const bf16_t* Bt; int M, N, K; };

struct StaticOrder {
    int nM, nN, nwg, G, c;
    __host__ __device__ void init(int M, int N, int G_, int c_) { nM = M / BM; nN = N / BM; nwg = nM * nN; G = G_; c = c_; }
    __host__ __device__ bool next(int i, Unit& u) const {
        const long L = (long)i * G + c; if (L >= nwg) return false;
        int wgid = (int)L; { const int q = nwg / NXCD, r = nwg % NXCD, xcd = wgid % NXCD, off = wgid / NXCD; wgid = (xcd < r ? xcd * (q + 1) : r * (q + 1) + (xcd - r) * q) + off; }
        const int nig = WGM * nN, gid = wgid / nig, fm = gid * WGM, gsz = (nM - fm) < WGM ? (nM - fm) : WGM;
        u.pm = fm + ((wgid % nig) % gsz); u.pn = (wgid % nig) / gsz; return true;
    }
    __device__ __forceinline__ void a_ready(const Unit&) const {}
    __device__ __forceinline__ void done(const Unit&) const {}
};

__device__ __forceinline__ unsigned cvt_pk_bf16(float lo, float hi) { unsigned r; asm volatile("v_cvt_pk_bf16_f32 %0, %1, %2" : "=v"(r) : "v"(lo), "v"(hi)); return r; }

struct EpiProj {
    static constexpr bool PERM = true, AFTER_DRAIN = false;
    unsigned char* secbase; float qscale;
    __device__ __forceinline__ void operator()(const f32x4 (&acc)[2][2][4][2], const Unit& u, int wr, int wc, int fr, int fq) const {
        const int sec = u.pn >> 2, t4 = u.pn & 3;
        const int row0 = u.pm * BM + wr * 64 + fr;
        bf16_t* base = (bf16_t*)(secbase + (size_t)sec * (32u << 20));
        const float sc = sec == 0 ? qscale : 1.f;
        size_t rstride, bjstride, off0;
        if (sec < 3) {
            const int b = row0 >> 12, s0 = row0 & 4095;
            rstride = 128; bjstride = (size_t)4096 * 128; off0 = ((size_t)(b * 8 + t4 * 2) * 4096 + s0) * 128 + wc * 32 + 8 * fq;
        } else {
            rstride = 1024; bjstride = 128; off0 = (size_t)row0 * 1024 + t4 * 256 + wc * 32 + 8 * fq;
        }
#pragma unroll
        for (int ai = 0; ai < 2; ++ai)
#pragma unroll
            for (int m = 0; m < 4; ++m) { bf16_t* rowp = base + off0 + (size_t)(ai * HALF + m * 16) * rstride;
#pragma unroll
                for (int bj = 0; bj < 2; ++bj) { f32x4 v0 = acc[ai][bj][m][0] * sc, v1 = acc[ai][bj][m][1] * sc;
                    u32x4 w; w.x = cvt_pk_bf16(v0[0], v0[1]); w.y = cvt_pk_bf16(v0[2], v0[3]); w.z = cvt_pk_bf16(v1[0], v1[1]); w.w = cvt_pk_bf16(v1[2], v1[3]);
                    *(u32x4*)(rowp + bj * bjstride) = w; } }
    }
};
struct EpiOut {
    static constexpr bool PERM = false, AFTER_DRAIN = false;
    const float* x; float* out; float* rowss;
    __device__ __forceinline__ void operator()(const f32x4 (&acc)[2][2][4][2], const Unit& u, int wr, int wc, int fr, int fq) const {
        const int row0 = u.pm * BM + wr * 64 + fr, col0 = u.pn * BM + wc * 32 + 4 * fq;
#pragma unroll
        for (int ai = 0; ai < 2; ++ai)
#pragma unroll
            for (int m = 0; m < 4; ++m) { const int row = row0 + ai * HALF + m * 16; const size_t off = (size_t)row * 2048 + col0; float ss = 0.f;
#pragma unroll
                for (int bj = 0; bj < 2; ++bj)
#pragma unroll
                    for (int n = 0; n < 2; ++n) { const f32x4 xv = *(const f32x4*)(x + off + bj * HALF + n * 16); const f32x4 o = xv + acc[ai][bj][m][n];
                        ss += (o[0] * o[0] + o[1] * o[1]) + (o[2] * o[2] + o[3] * o[3]); *(f32x4*)(out + off + bj * HALF + n * 16) = o; }
                ss += __shfl_xor(ss, 16); ss += __shfl_xor(ss, 32);
                if (fq == 0) rowss[(size_t)row * 32 + u.pn * 4 + wc] = ss; }
    }
};

template <class Epi, class Sched, bool ALIGN_EPI = false, bool SP2 = false>
__device__ __forceinline__ void gemm_phase(PG8_LAS unsigned char* lds, const Gemm g, const Sched& S, const Epi& E) {
    const int tid = threadIdx.x, wid = __builtin_amdgcn_readfirstlane(tid >> 6), lane = tid & 63, wr = wid >> 2, wc = wid & 3, fr = lane & 15, fq = lane >> 4;
    const int K = g.K, nt = K / BK;
    unsigned voffA[2], voffB[2];
#pragma unroll
    for (int i = 0; i < 2; ++i) { int R, C; stage_rc(tid * 16 + i * 8192, R, C); const int Rb = Epi::PERM ? ((R & ~31) + perm32(R & 31)) : R;
        voffA[i] = (unsigned)(R * K + C) * 2u; voffB[i] = (unsigned)(Rb * K + C) * 2u; }
    const size_t kstep = (size_t)(BK * 2);
    const size_t hstep = (size_t)HALF * K * 2;
    const size_t tstep = 2 * hstep;
    const unsigned ldsw = (unsigned)wid * 1024u;
    const int aoff = lds_byte(wr * 64 + fr, fq * 8), boff = lds_byte(wc * 32 + fr, fq * 8);
#define PG8_SA(b, h) (((b) * 2 + (h)) * HTB)
#define PG8_SB(b, h) ((4 + (b) * 2 + (h)) * HTB)
#define PG8_STAGE(bufoff, gbase, voff) do { _Pragma("unroll") for (int _i = 0; _i < 2; ++_i) \
        __builtin_amdgcn_global_load_lds((const unsigned*)((const char*)(gbase) + (voff)[_i]), (PG8_LAS unsigned*)(lds + (bufoff) + ldsw + _i * 8192), 16, 0, 0); } while (0)
#define PG8_LDA(dst, b, h) do { _Pragma("unroll") for (int m = 0; m < 4; ++m) _Pragma("unroll") for (int k = 0; k < 2; ++k) dst[m][k] = *(const PG8_LAS bf16x8*)(lds + PG8_SA(b, h) + aoff + m * 2048 + k * 1024); } while (0)
#define PG8_LDB(dst, b, h) do { _Pragma("unroll") for (int n = 0; n < 2; ++n) _Pragma("unroll") for (int k = 0; k < 2; ++k) dst[n][k] = *(const PG8_LAS bf16x8*)(lds + PG8_SB(b, h) + boff + n * 2048 + k * 1024); } while (0)
#define PG8_MMA(ai, bj, At, Bt) do { __builtin_amdgcn_s_setprio(1); _Pragma("unroll") for (int m = 0; m < 4; ++m) _Pragma("unroll") for (int n = 0; n < 2; ++n) _Pragma("unroll") for (int k = 0; k < 2; ++k) \
        acc[ai][bj][m][n] = __builtin_amdgcn_mfma_f32_16x16x32_bf16(Bt[n][k], At[m][k], acc[ai][bj][m][n], 0, 0, 0); __builtin_amdgcn_s_setprio(0); } while (0)
#define PG8_WAIT_V(n) asm volatile("s_waitcnt vmcnt(" #n ")" ::: "memory")
#define PG8_WAIT_L(n) asm volatile("s_waitcnt lgkmcnt(" #n ")" ::: "memory")
#define PG8_BAR __builtin_amdgcn_s_barrier()
#define PG8_SCHED __builtin_amdgcn_sched_barrier(0)
    Unit cur, nxt; int ui = 0;
    if (!S.next(0, cur)) return;
    f32x4 acc[2][2][4][2];
#pragma unroll
    for (int a = 0; a < 2; ++a)
#pragma unroll
        for (int b = 0; b < 2; ++b)
#pragma unroll
            for (int m = 0; m < 4; ++m)
#pragma unroll
                for (int n = 0; n < 2; ++n) acc[a][b][m][n] = (f32x4){0.f, 0.f, 0.f, 0.f};
    bf16x8 At[4][2], B0[2][2], B1[2][2];
    const char* cA = (const char*)g.A + (size_t)cur.pm * tstep; const char* cB = (const char*)g.Bt + (size_t)cur.pn * tstep;
    S.a_ready(cur);
    if constexpr (SP2) {
        PG8_STAGE(PG8_SB(0, 0), cB, voffB); PG8_STAGE(PG8_SB(0, 1), cB + hstep, voffB); PG8_STAGE(PG8_SA(0, 0), cA, voffA); PG8_STAGE(PG8_SA(0, 1), cA + hstep, voffA);
        if (wr == 1) PG8_BAR;
        PG8_WAIT_V(2); PG8_BAR;
        PG8_STAGE(PG8_SB(1, 0), cB + kstep, voffB); PG8_STAGE(PG8_SA(1, 0), cA + kstep, voffA); PG8_STAGE(PG8_SB(1, 1), cB + hstep + kstep, voffB);
        PG8_WAIT_V(6); PG8_BAR;
    } else {
        PG8_STAGE(PG8_SB(0, 0), cB, voffB); PG8_STAGE(PG8_SA(0, 0), cA, voffA); PG8_STAGE(PG8_SB(0, 1), cB + hstep, voffB); PG8_STAGE(PG8_SA(0, 1), cA + hstep, voffA);
        if (wr == 1) PG8_BAR;
        PG8_WAIT_V(4); PG8_BAR;
        PG8_STAGE(PG8_SB(1, 0), cB + kstep, voffB); PG8_STAGE(PG8_SA(1, 0), cA + kstep, voffA); PG8_STAGE(PG8_SB(1, 1), cB + hstep + kstep, voffB);
        PG8_WAIT_V(6); PG8_BAR;
    }
    for (;;) {
        const bool has_next = S.next(ui + 1, nxt);
        const char* nA = has_next ? (const char*)g.A + (size_t)nxt.pm * tstep : cA; const char* nB = has_next ? (const char*)g.Bt + (size_t)nxt.pn * tstep : cB;
        for (int t = 0; t < nt; t += 2) {
            const bool last = (t == nt - 2);
            const char* a1 = cA + (size_t)(t + 1) * kstep;
            const char* a2 = last ? nA : cA + (size_t)(t + 2) * kstep; const char* b2 = last ? nB : cB + (size_t)(t + 2) * kstep;
            const char* a3 = a2 + kstep; const char* b3 = b2 + kstep;
            if (last && has_next) S.a_ready(nxt);
            if constexpr (SP2) {
            PG8_LDB(B0, 0, 0); PG8_LDB(B1, 0, 1); PG8_SCHED; PG8_LDA(At, 0, 0); PG8_STAGE(PG8_SA(1, 1), a1 + hstep, voffA);
            PG8_WAIT_V(8); PG8_WAIT_L(0); PG8_BAR; PG8_MMA(0, 0, At, B0); PG8_MMA(0, 1, At, B1); PG8_BAR; PG8_SCHED;
            PG8_LDA(At, 0, 1); PG8_STAGE(PG8_SB(0, 0), b2, voffB); PG8_STAGE(PG8_SB(0, 1), b2 + hstep, voffB); PG8_STAGE(PG8_SA(0, 0), a2, voffA);
            PG8_WAIT_V(8); PG8_WAIT_L(0); PG8_BAR; PG8_MMA(1, 0, At, B0); PG8_MMA(1, 1, At, B1); PG8_BAR; PG8_SCHED;
            PG8_LDB(B0, 1, 0); PG8_LDB(B1, 1, 1); PG8_SCHED; PG8_LDA(At, 1, 0); PG8_STAGE(PG8_SA(0, 1), a2 + hstep, voffA);
            PG8_WAIT_V(8); PG8_WAIT_L(0); PG8_BAR; PG8_MMA(0, 0, At, B0); PG8_MMA(0, 1, At, B1); PG8_BAR; PG8_SCHED;
            PG8_LDA(At, 1, 1); PG8_STAGE(PG8_SB(1, 0), b3, voffB); PG8_STAGE(PG8_SB(1, 1), b3 + hstep, voffB); PG8_STAGE(PG8_SA(1, 0), a3, voffA);
            PG8_WAIT_V(8); PG8_WAIT_L(0); PG8_BAR; PG8_MMA(1, 0, At, B0); PG8_MMA(1, 1, At, B1); PG8_BAR; PG8_SCHED;
            } else {
            PG8_LDB(B0, 0, 0); PG8_SCHED; PG8_LDA(At, 0, 0); PG8_STAGE(PG8_SA(1, 1), a1 + hstep, voffA);
            PG8_WAIT_L(8); PG8_BAR; PG8_WAIT_L(0); PG8_MMA(0, 0, At, B0); PG8_BAR; PG8_SCHED;
            PG8_LDB(B1, 0, 1); PG8_STAGE(PG8_SB(0, 0), b2, voffB);
            PG8_BAR; PG8_WAIT_L(0); PG8_MMA(0, 1, At, B1); PG8_BAR;
            PG8_LDA(At, 0, 1); PG8_STAGE(PG8_SA(0, 0), a2, voffA);
            PG8_BAR; PG8_WAIT_L(0); PG8_MMA(1, 0, At, B0); PG8_BAR; PG8_SCHED;
            PG8_STAGE(PG8_SB(0, 1), b2 + hstep, voffB);
            PG8_WAIT_V(6); PG8_BAR; PG8_MMA(1, 1, At, B1); PG8_BAR;
            PG8_LDB(B0, 1, 0); PG8_SCHED; PG8_LDA(At, 1, 0); PG8_STAGE(PG8_SA(0, 1), a2 + hstep, voffA);
            PG8_WAIT_L(8); PG8_BAR; PG8_WAIT_L(0); PG8_MMA(0, 0, At, B0); PG8_BAR; PG8_SCHED;
            PG8_LDB(B1, 1, 1); PG8_STAGE(PG8_SB(1, 0), b3, voffB);
            PG8_BAR; PG8_WAIT_L(0); PG8_MMA(0, 1, At, B1); PG8_BAR;
            PG8_LDA(At, 1, 1); PG8_STAGE(PG8_SA(1, 0), a3, voffA);
            PG8_BAR; PG8_WAIT_L(0); PG8_MMA(1, 0, At, B0); PG8_BAR; PG8_SCHED;
            PG8_STAGE(PG8_SB(1, 1), b3 + hstep, voffB);
            PG8_WAIT_V(6); PG8_BAR; PG8_MMA(1, 1, At, B1); PG8_BAR;
            }
        }
        if constexpr (ALIGN_EPI) { if (wr == 0) PG8_BAR; }
        if constexpr (!Epi::AFTER_DRAIN) { E(acc, cur, wr, wc, fr, fq); S.done(cur); }
        if (!has_next) break;
#pragma unroll
        for (int a = 0; a < 2; ++a)
#pragma unroll
            for (int b = 0; b < 2; ++b)
#pragma unroll
                for (int m = 0; m < 4; ++m)
#pragma unroll
                    for (int n = 0; n < 2; ++n) acc[a][b][m][n] = (f32x4){0.f, 0.f, 0.f, 0.f};
        cur = nxt; cA = nA; cB = nB; ++ui;
        if constexpr (ALIGN_EPI) { if (wr == 1) PG8_BAR; }
    }
    PG8_WAIT_V(0);
    if constexpr (!ALIGN_EPI) { if (wr == 0) PG8_BAR; }
    PG8_BAR;
    if constexpr (Epi::AFTER_DRAIN) { E.fused(acc, cur, wr, wc, fr, fq, lds, wid, lane); S.done(cur); }
#undef PG8_SA
#undef PG8_SB
#undef PG8_STAGE
#undef PG8_LDA
#undef PG8_LDB
#undef PG8_MMA
#undef PG8_WAIT_V
#undef PG8_WAIT_L
#undef PG8_BAR
#undef PG8_SCHED
}
}
struct Args { const float* in[12]; float* out; unsigned char* ws; int ph_lo, ph_hi; };
enum { IN_X = 0, IN_NORMW, IN_WIN, IN_FOXFB, IN_CONVW, IN_CONVB, IN_MIB, IN_MFB, IN_FOXNW, IN_MNW, IN_WOUT, IN_FINW };
constexpr int NWAVES = 8, NTHREADS = 512;
constexpr int LDS_BYTES = 147456;

template <class ColMap>
__device__ __forceinline__ void p0_transpose_item(const float* W, int ldw, int k0, ColMap cm, bf16* WT  , int K, LAS float* scr, int lane) {
    const int sc = cm(lane & 31);
#pragma unroll 8
    for (int i = 0; i < 32; ++i) { const int kk = 2 * i + (lane >> 5); scr[kk * 33 + (lane & 31)] = sc >= 0 ? W[(size_t)(k0 + kk) * ldw + sc] : 0.f; }
    LDS_WAIT(); asm volatile("" ::: "memory");
    const int c = lane & 7;
#pragma unroll
    for (int j = 0; j < 4; ++j) { const int n = (lane >> 3) + 8 * j; const LAS float* s = scr + (8 * c) * 33 + n;
        v4u o; o.x = pk2(s[0 * 33], s[1 * 33]); o.y = pk2(s[2 * 33], s[3 * 33]); o.z = pk2(s[4 * 33], s[5 * 33]); o.w = pk2(s[6 * 33], s[7 * 33]);
        *(v4u*)(WT + (size_t)n * K + k0 + 8 * c) = o; }
    LDS_WAIT(); asm volatile("" ::: "memory");
}
struct MapMain { int n0; __device__ int operator()(int n) const { const int c = n0 + n; return c < 4096 ? c : c + 8; } };
struct MapGate { __device__ int operator()(int n) const { return n < 8 ? 4096 + n : n < 16 ? 8200 + (n - 8) : n < 24 ? 8208 + (n - 16) : -1; } };
struct MapPlain { int n0; __device__ int operator()(int n) const { return n0 + n; } };

__device__ __forceinline__ void phase_prep(const Args& a, LAS unsigned char* lds, int nblk, int blk) {
    const int tid = threadIdx.x, lane = tid & 63, wave = tid >> 6;
    LAS float* scr = (LAS float*)(lds + wave * 16384);
    const int gw = blk * NWAVES + wave, NGW = nblk * NWAVES;
    const float* win = a.in[IN_WIN]; const float* wout = a.in[IN_WOUT];
    bf16* WIN_T = (bf16*)(a.ws + WS_WIN); bf16* WG_T = (bf16*)(a.ws + WS_WGT); bf16* WOUT_T = (bf16*)(a.ws + WS_WOUT);
    constexpr int I_MAIN = 32 * 256, I_GATE = 32, I_OUT = 32 * 64, NITEMS = I_MAIN + I_GATE + I_OUT;
    for (int it = gw; it < NITEMS; it += NGW) {
        int r = it;
        if (r < I_MAIN) { const int kb = r >> 8, nb = r & 255; p0_transpose_item(win, IN_COLS, 64 * kb, MapMain{32 * nb}, WIN_T + (size_t)(32 * nb) * DM, DM, scr, lane); continue; } r -= I_MAIN;
        if (r < I_GATE) { p0_transpose_item(win, IN_COLS, 64 * r, MapGate{}, WG_T, DM, scr, lane); continue; } r -= I_GATE;
        { const int kb = r >> 6, nb = r & 63; p0_transpose_item(wout, DM, 64 * kb, MapPlain{32 * nb}, WOUT_T + (size_t)(32 * nb) * DM, DM, scr, lane); }
    }
    const float* x = a.in[IN_X]; const float* nw = a.in[IN_NORMW]; bf16* XN = (bf16*)(a.ws + WS_XN);
    for (int m = gw; m < M_TOK; m += NGW) {
        const pg8::f32x4* xr = (const pg8::f32x4*)(x + (size_t)m * DM) + lane; const pg8::f32x4* wr = (const pg8::f32x4*)nw + lane;
        pg8::f32x4 v[8]; float s = 0.f;
#pragma unroll
        for (int j = 0; j < 8; ++j) { v[j] = xr[64 * j]; s += (v[j][0] * v[j][0] + v[j][1] * v[j][1]) + (v[j][2] * v[j][2] + v[j][3] * v[j][3]); }
        const float rstd = 1.0f / sqrtf(wave_sum(s) * (1.f / DM) + NORM_EPS);
        unsigned long long* o8 = (unsigned long long*)(XN + (size_t)m * DM) + lane;
#pragma unroll
        for (int j = 0; j < 8; ++j) { const pg8::f32x4 g = wr[64 * j];
            o8[64 * j] = (unsigned long long)pk2(v[j][0] * rstd * g[0], v[j][1] * rstd * g[1]) | ((unsigned long long)pk2(v[j][2] * rstd * g[2], v[j][3] * rstd * g[3]) << 32); }
    }
}

__device__ __forceinline__ void gate_unit(const Args& a, LAS unsigned char* lds, int c) {
    const int tid = threadIdx.x, lane = tid & 63, wave = tid >> 6, r32 = lane & 31, hi = lane >> 5;
    const bf16* XN = (const bf16*)(a.ws + WS_XN); const bf16* WG_T = (const bf16*)(a.ws + WS_WGT);
    f32x16 acc0 = {}, acc1 = {};
    const bf16* a0 = XN + (size_t)(64 * c + r32) * DM + 256 * wave + 8 * hi; const bf16* a1 = a0 + (size_t)32 * DM;
    const bf16* bp = WG_T + (size_t)r32 * DM + 256 * wave + 8 * hi;
#pragma unroll 4
    for (int ks = 0; ks < 16; ++ks) {
        const pg8::bf16x8 A0 = *(const pg8::bf16x8*)(a0 + 16 * ks), A1 = *(const pg8::bf16x8*)(a1 + 16 * ks), Bf = *(const pg8::bf16x8*)(bp + 16 * ks);
        acc0 = __builtin_amdgcn_mfma_f32_32x32x16_bf16(A0, Bf, acc0, 0, 0, 0);
        acc1 = __builtin_amdgcn_mfma_f32_32x32x16_bf16(A1, Bf, acc1, 0, 0, 0);
    }
    LAS float* part = (LAS float*)lds;
#pragma unroll
    for (int r = 0; r < 16; ++r) { const int row = (r & 3) + 8 * (r >> 2) + 4 * hi;
        part[(wave * 64 + row) * 32 + r32] = acc0[r]; part[(wave * 64 + 32 + row) * 32 + r32] = acc1[r]; }
    __syncthreads();
    float* G = (float*)(a.ws + WS_GATE);
    for (int e = tid; e < 64 * 32; e += NTHREADS) { const int row = e >> 5, j = e & 31; float s = 0.f;
#pragma unroll
        for (int w = 0; w < 8; ++w) s += part[(w * 64 + row) * 32 + j];
        float v;
        if (j < 8) v = logsigmoidf(s + a.in[IN_FOXFB][j]); else if (j < 16) v = s + a.in[IN_MIB][j - 8]; else if (j < 24) v = logsigmoidf(s + a.in[IN_MFB][j - 16]); else v = 0.f;
        G[(size_t)(64 * c + row) * 32 + j] = v; }
    __syncthreads();
}

__device__ __forceinline__ void fox_cumsum_item(const Args& a, LAS unsigned char* lds, int bh) {
    const int tid = threadIdx.x, lane = tid & 63, wave = tid >> 6; const int b = bh >> 3, h = bh & 7;
    const float* G = (const float*)(a.ws + WS_GATE); bf16* KB = (bf16*)(a.ws + WS_KBIAS);
    LAS float* wtot = (LAS float*)lds;
    float v[8]; float run = 0.f;
#pragma unroll
    for (int j = 0; j < 8; ++j) { run += G[(size_t)(b * SEQ + 8 * tid + j) * 32 + h]; v[j] = run; }
    float incl = run;
#pragma unroll
    for (int o = 1; o < 64; o <<= 1) { const float t = __shfl_up(incl, o); if (lane >= o) incl += t; }
    if (lane == 63) wtot[wave] = incl;
    __syncthreads();
    float base = incl - run;
    for (int w = 0; w < wave; ++w) base += wtot[w];
#pragma unroll
    for (int j = 0; j < 8; ++j) { const float kb2 = -(base + v[j]) * LOG2E;
        const unsigned h1 = f2bf(kb2); const float r1 = kb2 - bf2f(h1); const unsigned h2 = f2bf(r1); const float r2 = r1 - bf2f(h2); const unsigned h3 = f2bf(r2);
        v4u o; o.x = h1 | (h2 << 16); o.y = h3; o.z = 0u; o.w = 0u;
        *(v4u*)(KB + ((size_t)bh * SEQ + 8 * tid + j) * 8) = o; }
    __syncthreads();
}

__device__ __forceinline__ void conv_item(const Args& a, int item) {
    const int tid = threadIdx.x; const int cg8 = tid & 127, tq = tid >> 7;
    const int c0 = cg8 * 8; const int tok0 = item * 64 + tq * 16;
    const bf16* MQK = (const bf16*)(a.ws + WS_SEC + SEC_MQK * SEC_BYTES);
    const float* cw = a.in[IN_CONVW]; const float* cb = a.in[IN_CONVB];
    float w[4][8], bias[8];
#pragma unroll
    for (int j = 0; j < 4; ++j)
#pragma unroll
        for (int e = 0; e < 8; ++e) w[j][e] = cw[j * 1024 + c0 + e];
#pragma unroll
    for (int e = 0; e < 8; ++e) bias[e] = cb[c0 + e];
    const bool isk = c0 >= 512; const int hh = (c0 & 511) >> 6, d0 = c0 & 63;
    bf16* dst = (bf16*)(a.ws + (isk ? WS_KC : WS_QC));
    const float osc = isk ? 0.125f : 1.f;
    float u[4][8];
    const int s0 = tok0 & (SEQ - 1);
#pragma unroll
    for (int j = 0; j < 3; ++j) { const int s = s0 - 3 + j;
        if (s >= 0) { const v4u r = *(const v4u*)(MQK + (size_t)(tok0 - 3 + j) * 1024 + c0);
            u[j][0] = bflo(r.x); u[j][1] = bfhi(r.x); u[j][2] = bflo(r.y); u[j][3] = bfhi(r.y); u[j][4] = bflo(r.z); u[j][5] = bfhi(r.z); u[j][6] = bflo(r.w); u[j][7] = bfhi(r.w); }
        else {
#pragma unroll
            for (int e = 0; e < 8; ++e) u[j][e] = 0.f; } }
    const int bb = tok0 >> 12;
#pragma unroll
    for (int t = 0; t < 16; ++t) {
        const v4u r = *(const v4u*)(MQK + (size_t)(tok0 + t) * 1024 + c0);
        u[3][0] = bflo(r.x); u[3][1] = bfhi(r.x); u[3][2] = bflo(r.y); u[3][3] = bfhi(r.y); u[3][4] = bflo(r.z); u[3][5] = bfhi(r.z); u[3][6] = bflo(r.w); u[3][7] = bfhi(r.w);
        float y[8];
#pragma unroll
        for (int e = 0; e < 8; ++e) { float s = u[0][e] * w[0][e]; s += u[1][e] * w[1][e]; s += u[2][e] * w[2][e]; s += u[3][e] * w[3][e]; s += bias[e]; y[e] = siluf(s) * osc; }
        v4u o; o.x = pk2(y[0], y[1]); o.y = pk2(y[2], y[3]); o.z = pk2(y[4], y[5]); o.w = pk2(y[6], y[7]);
        *(v4u*)(dst + ((size_t)(bb * 8 + hh) * SEQ + (s0 + t)) * 64 + d0) = o;
#pragma unroll
        for (int e = 0; e < 8; ++e) { u[0][e] = u[1][e]; u[1][e] = u[2][e]; u[2][e] = u[3][e]; }
    }
}

__device__ __forceinline__ void phase_final(const Args& a, int nblk, int blk) {
    const int tid = threadIdx.x, lane = tid & 63, wave = tid >> 6; const int gw = blk * NWAVES + wave, NGW = nblk * NWAVES;
    const float* rowss = (const float*)(a.ws + WS_ROWSS); const float* fw = a.in[IN_FINW];
    for (int m = gw; m < M_TOK; m += NGW) {
        float s = lane < 32 ? rowss[(size_t)m * 32 + lane] : 0.f;
        s = wave_sum(s);
        const float rstd = 1.0f / sqrtf(s * (1.f / DM) + NORM_EPS);
        pg8::f32x4* o = (pg8::f32x4*)(a.out + (size_t)m * DM) + lane; const pg8::f32x4* g = (const pg8::f32x4*)fw + lane;
#pragma unroll
        for (int j = 0; j < 8; ++j) { pg8::f32x4 v = o[64 * j]; const pg8::f32x4 gg = g[64 * j]; v = v * rstd * gg; o[64 * j] = v; }
    }
}

namespace fox {
typedef short bf16x8 __attribute__((ext_vector_type(8)));
typedef short s16x4 __attribute__((ext_vector_type(4)));
typedef float f32x16 __attribute__((ext_vector_type(16)));
typedef unsigned u32x4 __attribute__((ext_vector_type(4)));
typedef LAS char* lptr;
constexpr int D = 128, NW = 8, QBLK = 32, KVBLK = 64, QB = NW * QBLK;
constexpr int SHM_V = KVBLK * D * 2, SHM_K = KVBLK * D * 2;
constexpr int OFF_V = 0, OFF_K = 2 * SHM_V, OFF_WS = 2 * SHM_V + 2 * SHM_K, OFF_KB = OFF_WS + NW * 64 * 4, LDS_NEED = OFF_KB + 2 * 1024;
constexpr float THR2 = 11.5f;
#define KSWZ(row, colB) ((row) * 256 + ((colB) ^ (((row) & 7) << 4)))
#define SBAR() __builtin_amdgcn_sched_barrier(0)
__device__ __forceinline__ int v_st(int k, int c) { const int kk = (k & ~0xC) | ((k & 4) << 1) | ((k & 8) >> 1); return ((kk >> 3) * 4 + (c >> 5)) * 512 + ((kk & 7) * 32 + (c & 31)) * 2; }
__device__ __forceinline__ int v_rd_base(int lane) { return ((lane & 3) << 3) | (((lane >> 2) & 3) << 6) | (((lane >> 4) & 1) << 5) | (((lane >> 5) & 1) << 8); }
constexpr int v_rd_off(int d0, int ks, int half) { return d0 * 512 + ks * 4096 + half * 2048; }
__device__ __forceinline__ int crow(int r, int hi) { return (r & 3) + 8 * (r >> 2) + 4 * hi; }
__device__ __forceinline__ unsigned cvtpk(float lo, float hi) { unsigned r; asm volatile("v_cvt_pk_bf16_f32 %0, %1, %2" : "=v"(r) : "v"(lo), "v"(hi)); return r; }
__device__ __forceinline__ void mask_tile(f32x16& p0, f32x16& p1, int dq) {
    const float NEG = -__builtin_inff();
#pragma unroll
    for (int r = 0; r < 16; ++r) { const int c = (r & 3) + 8 * (r >> 2);
        if (dq - c < 0) p0[r] = NEG;
        if (dq - c - 32 < 0) p1[r] = NEG; }
}
__device__ __forceinline__ void partialSM(f32x16& p0, f32x16& p1, float& m_reg, float& mn, float& alpha) {
    float pmax = p0[0];
#pragma unroll
    for (int r = 1; r < 16; ++r) pmax = fmaxf(pmax, p0[r]);
#pragma unroll
    for (int r = 0; r < 16; ++r) pmax = fmaxf(pmax, p1[r]);
    { auto rr = __builtin_amdgcn_permlane32_swap(__float_as_uint(pmax), __float_as_uint(pmax), false, false);
      pmax = fmaxf(__uint_as_float(rr[0]), __uint_as_float(rr[1])); }
    if (__builtin_expect(__all((pmax - m_reg) <= THR2), 1)) { mn = m_reg; alpha = 1.f; }
    else { mn = fmaxf(m_reg, pmax); alpha = __builtin_amdgcn_exp2f(m_reg - mn); m_reg = mn; }
#pragma unroll
    for (int r = 0; r < 16; ++r) p0[r] = p0[r] - mn;
#pragma unroll
    for (int r = 0; r < 16; ++r) p1[r] = p1[r] - mn;
#pragma unroll
    for (int r = 0; r < 16; ++r) p0[r] = __builtin_amdgcn_exp2f(p0[r]);
}
__device__ __forceinline__ void finishSM(f32x16& p0, f32x16& p1, float alpha, float& l_reg, bf16x8& pa0, bf16x8& pa1, bf16x8& pa2, bf16x8& pa3) {
#pragma unroll
    for (int r = 0; r < 16; ++r) p1[r] = __builtin_amdgcn_exp2f(p1[r]);
    float ps = 0;
#pragma unroll
    for (int r = 0; r < 16; ++r) ps += p0[r];
#pragma unroll
    for (int r = 0; r < 16; ++r) ps += p1[r];
    { auto rr = __builtin_amdgcn_permlane32_swap(__float_as_uint(ps), __float_as_uint(ps), false, false);
      ps = __uint_as_float(rr[0]) + __uint_as_float(rr[1]); }
    l_reg = l_reg * alpha + ps;
#define PK4(P, B_, OUT) do { unsigned a0 = cvtpk(P[B_+0], P[B_+1]), a1 = cvtpk(P[B_+2], P[B_+3]);                          \
        unsigned b0 = cvtpk(P[B_+4], P[B_+5]), b1 = cvtpk(P[B_+6], P[B_+7]);                                             \
        auto r0 = __builtin_amdgcn_permlane32_swap(a0, b0, false, false); auto r1 = __builtin_amdgcn_permlane32_swap(a1, b1, false, false); \
        u32x4 w = {r0[0], r1[0], r0[1], r1[1]}; OUT = __builtin_bit_cast(bf16x8, w); } while (0)
    PK4(p0, 0, pa0); PK4(p0, 8, pa1); PK4(p1, 0, pa2); PK4(p1, 8, pa3);
#undef PK4
}
template <int KB>
__device__ __forceinline__ void qkt(f32x16& p0, f32x16& p1, lptr lds, int r32, int hi, const bf16x8* qr, bf16x8 qone) {
    p0 = f32x16{}; p1 = f32x16{};
    lptr kb[4];
#pragma unroll
    for (int dd = 0; dd < 4; ++dd) kb[dd] = lds + OFF_K + KB * SHM_K + KSWZ(r32, (dd * 16 + hi * 8) * 2);
#pragma unroll
    for (int d0 = 0; d0 < 8; ++d0) { lptr a = kb[d0 & 3] + (d0 >> 2) * 128;
        bf16x8 b0 = *(const LAS bf16x8*)(a);
        bf16x8 b1 = *(const LAS bf16x8*)(a + 32 * 256);
        p0 = __builtin_amdgcn_mfma_f32_32x32x16_bf16(b0, qr[d0], p0, 0, 0, 0);
        p1 = __builtin_amdgcn_mfma_f32_32x32x16_bf16(b1, qr[d0], p1, 0, 0, 0); }
    { lptr a = lds + OFF_KB + KB * 1024 + r32 * 16;
        bf16x8 b0 = *(const LAS bf16x8*)(a);
        bf16x8 b1 = *(const LAS bf16x8*)(a + 512);
        p0 = __builtin_amdgcn_mfma_f32_32x32x16_bf16(b0, qone, p0, 0, 0, 0);
        p1 = __builtin_amdgcn_mfma_f32_32x32x16_bf16(b1, qone, p1, 0, 0, 0); }
}
template <int VB>
__device__ __forceinline__ void pv_tile(f32x16* o, int vb0, bf16x8 pa0, bf16x8 pa1, bf16x8 pa2, bf16x8 pa3) {
#define TRRD(dst, off) asm volatile("ds_read_b64_tr_b16 %0, %1 offset:%2" : "=&v"(dst) : "v"(vb0), "i"(off) : "memory")
#define PV_D0(d0) do { s16x4 l0, l1, l2, l3, h0, h1, h2, h3; constexpr int b_ = OFF_V + VB * SHM_V + v_rd_off(d0, 0, 0); \
        TRRD(l0, b_); TRRD(h0, b_ + 2048); TRRD(l1, b_ + 4096); TRRD(h1, b_ + 6144); TRRD(l2, b_ + 8192); TRRD(h2, b_ + 10240); TRRD(l3, b_ + 12288); TRRD(h3, b_ + 14336); \
        asm volatile("s_waitcnt lgkmcnt(0)" ::: "memory"); SBAR();   \
        o[d0] = __builtin_amdgcn_mfma_f32_32x32x16_bf16(pa0, (bf16x8){l0[0], l0[1], l0[2], l0[3], h0[0], h0[1], h0[2], h0[3]}, o[d0], 0, 0, 0);   \
        o[d0] = __builtin_amdgcn_mfma_f32_32x32x16_bf16(pa1, (bf16x8){l1[0], l1[1], l1[2], l1[3], h1[0], h1[1], h1[2], h1[3]}, o[d0], 0, 0, 0);   \
        o[d0] = __builtin_amdgcn_mfma_f32_32x32x16_bf16(pa2, (bf16x8){l2[0], l2[1], l2[2], l2[3], h2[0], h2[1], h2[2], h2[3]}, o[d0], 0, 0, 0);   \
        o[d0] = __builtin_amdgcn_mfma_f32_32x32x16_bf16(pa3, (bf16x8){l3[0], l3[1], l3[2], l3[3], h3[0], h3[1], h3[2], h3[3]}, o[d0], 0, 0, 0); } while (0)
    PV_D0(0); PV_D0(1); PV_D0(2); PV_D0(3);
#undef PV_D0
#undef TRRD
}
struct BlockRef { const bf16* Q; const bf16* K; const bf16* V; const bf16* KB; int P0; int tok0; int h; };
struct Seam { bf16x8 qr[8]; bf16x8 st_v0, st_v1, st_k0, st_k1; u32x4 st_kb; };
#define VMW() asm volatile("s_waitcnt vmcnt(0)" ::: "memory")
#define BL128(rs, vo, so) __builtin_bit_cast(bf16x8, __builtin_amdgcn_raw_buffer_load_b128(rs, (int)(vo), (int)(so), 0))
#define SLOAD_H(k0) do { const int so_ = (k0) * 256; S.st_v0 = BL128(rsV, voffKV, so_); S.st_v1 = BL128(rsV, voffKV, so_ + 8192);              \
                         S.st_k0 = BL128(rsK, voffKV, so_); S.st_k1 = BL128(rsK, voffKV, so_ + 8192); \
                         S.st_kb = __builtin_amdgcn_raw_buffer_load_b128(rsB, lane * 16, (k0) * 16, 0); } while (0)
#define SWRITE_HK(bf) do { *(LAS bf16x8*)(lds + OFF_K + (bf) * SHM_K + kws) = S.st_k0; *(LAS bf16x8*)(lds + OFF_K + (bf) * SHM_K + kws + 32 * 256) = S.st_k1; \
                         if (wid == 0) *(LAS u32x4*)(lds + OFF_KB + (bf) * 1024 + lane * 16) = S.st_kb; } while (0)
#define SWRITE_HV(bf) do { *(LAS bf16x8*)(lds + OFF_V + (bf) * SHM_V + vst0) = S.st_v0; *(LAS bf16x8*)(lds + OFF_V + (bf) * SHM_V + vst1) = S.st_v1; } while (0)
#define SWRITE_H(bf) do { SWRITE_HV(bf); SWRITE_HK(bf); } while (0)
__device__ __forceinline__ __amdgpu_buffer_rsrc_t mk_rsrc(const void* p, unsigned bytes) {
    const unsigned long long v = (unsigned long long)p; const unsigned lo = __builtin_amdgcn_readfirstlane((unsigned)v), hi = __builtin_amdgcn_readfirstlane((unsigned)(v >> 32));
    return __builtin_amdgcn_make_buffer_rsrc((void*)(((unsigned long long)hi << 32) | lo), 0, bytes, 0x00020000);
}
struct EpiParams { const float* g; const bf16* FZ; bf16* Y; };
__device__ __forceinline__ void block(const BlockRef& cur, lptr lds, const EpiParams& E) {
    Seam S;
    const int tid = threadIdx.x, wid = __builtin_amdgcn_readfirstlane(tid >> 6), lane = tid & 63, r32 = lane & 31, hi = lane >> 5;
    const int NT = (cur.P0 + QB) / KVBLK;
    const int qlo = cur.P0 + wid * QBLK, qm = qlo + r32 - 4 * hi;
    LAS float* ws = (LAS float*)(lds + OFF_WS) + wid * 64; LAS float* li_l = ws; LAS float* al_l = ws + 32;
    float m_reg = -1e30f, l_reg = 0; f32x16 o[4] = {};
    const int sr = tid >> 4, sc = (tid & 15) * 8, vst0 = v_st(sr, sc), vst1 = v_st(32 + sr, sc), kws = KSWZ(sr, sc * 2);
    const int vb0 = (int)(uintptr_t)(lds) + v_rd_base(lane);
    const __amdgpu_buffer_rsrc_t rsK = mk_rsrc(cur.K, SEQ * 256), rsV = mk_rsrc(cur.V, SEQ * 256), rsB = mk_rsrc(cur.KB, SEQ * 16), rsQ = mk_rsrc(cur.Q, QB * 256);
    const int voffKV = (sr * D + sc) * 2;
    bf16x8 qone; { u32x4 w = {hi ? 0u : 0x3F803F80u, hi ? 0u : 0x00003F80u, 0u, 0u}; qone = __builtin_bit_cast(bf16x8, w); }
#define RESC(a) do { if (__any((a) < 1.f)) { if (hi == 0) al_l[r32] = (a); asm volatile("s_waitcnt lgkmcnt(0)" ::: "memory");              \
                     _Pragma("unroll") for (int d_ = 0; d_ < 4; ++d_) _Pragma("unroll") for (int r = 0; r < 16; ++r) o[d_][r] *= al_l[crow(r, hi)]; } } while (0)
#define KBASE(t) ((t) * KVBLK)
#define MASKT(P0_, P1_, t) do { const int kb_ = KBASE(t); if (kb_ + KVBLK - 1 > qlo) mask_tile(P0_, P1_, qm - kb_); } while (0)
    f32x16 pA0, pA1, pB0, pB1; float mnA, mnB, alA, alB; bf16x8 pa0, pa1, pa2, pa3;
    { const int voffQ = ((wid * QBLK + r32) * D + hi * 8) * 2;
#pragma unroll
      for (int d0 = 0; d0 < 8; ++d0) S.qr[d0] = BL128(rsQ, voffQ, d0 * 32); }
    SLOAD_H(0); VMW(); SWRITE_HK(0);
    __syncthreads();
    SWRITE_HV(0); SBAR();
    SLOAD_H(KBASE(1));
    SBAR(); qkt<0>(pA0, pA1, lds, r32, hi, S.qr, qone);
    MASKT(pA0, pA1, 0); partialSM(pA0, pA1, m_reg, mnA, alA);
    VMW(); SWRITE_H(1);
    __syncthreads();
#define HALF_STEP(PX0, PX1, mnX, alX, PY0, PY1, alY, t, KB, VB, SB) do {                                                      \
        SBAR(); qkt<KB>(PX0, PX1, lds, r32, hi, S.qr, qone);                                             \
        finishSM(PY0, PY1, alY, l_reg, pa0, pa1, pa2, pa3); SBAR();                                                           \
        if ((t) + 1 < NT) { SLOAD_H(KBASE((t) + 1)); SBAR(); }                                               \
        pv_tile<VB>(o, vb0, pa0, pa1, pa2, pa3); MASKT(PX0, PX1, (t)); partialSM(PX0, PX1, m_reg, mnX, alX);                                        \
        __syncthreads();                                                                                                      \
        if ((t) + 1 < NT) { VMW(); SWRITE_H(SB); }                                                                          \
        RESC(alX); __syncthreads(); } while (0)
    for (int t = 1; t + 1 < NT; t += 2) {
        HALF_STEP(pB0, pB1, mnB, alB, pA0, pA1, alA, t, 1, 0, 0);
        HALF_STEP(pA0, pA1, mnA, alA, pB0, pB1, alB, t + 1, 0, 1, 1);
    }
    SBAR(); qkt<1>(pB0, pB1, lds, r32, hi, S.qr, qone); SBAR();
    finishSM(pA0, pA1, alA, l_reg, pa0, pa1, pa2, pa3); SBAR();
    pv_tile<0>(o, vb0, pa0, pa1, pa2, pa3);
    MASKT(pB0, pB1, NT - 1); partialSM(pB0, pB1, m_reg, mnB, alB); __syncthreads(); RESC(alB);
    finishSM(pB0, pB1, alB, l_reg, pa0, pa1, pa2, pa3); SBAR(); pv_tile<1>(o, vb0, pa0, pa1, pa2, pa3);
    SBAR();
    if (hi == 0) li_l[r32] = l_reg; asm volatile("s_waitcnt lgkmcnt(0)" ::: "memory");
    int r32o = r32; asm volatile("" : "+v"(r32o));
    const float* gp = E.g + cur.h * 128 + r32o; const float g0 = gp[0], g1 = gp[32], g2 = gp[64], g3 = gp[96];
    const unsigned trow = (unsigned)(cur.tok0 + wid * QBLK);
    const unsigned zoff0 = trow * 1024u + (unsigned)(cur.h * 128 + r32o), yoff0 = trow * 2048u + (unsigned)(cur.h * 128 + r32o);
#pragma unroll
    for (int r = 0; r < 16; ++r) { const int orow = crow(r, hi); const float rl = __builtin_amdgcn_rcpf(li_l[orow]);
        const bf16* zp = E.FZ + (zoff0 + (unsigned)orow * 1024u);
        const float z0 = bf2f(zp[0]), z1 = bf2f(zp[32]), z2 = bf2f(zp[64]), z3 = bf2f(zp[96]);
        const float v0 = o[0][r] * rl, v1 = o[1][r] * rl, v2 = o[2][r] * rl, v3 = o[3][r] * rl;
        float ss = (v0 * v0 + v1 * v1) + (v2 * v2 + v3 * v3);
        ss += __shfl_xor(ss, 1); ss += __shfl_xor(ss, 2); ss += __shfl_xor(ss, 4); ss += __shfl_xor(ss, 8); ss += __shfl_xor(ss, 16);
        const float rs = 1.0f / sqrtf(ss * (1.f / 128.f) + NORM_EPS);
        const float y0 = v0 * rs * g0 * siluf(z0), y1 = v1 * rs * g1 * siluf(z1), y2 = v2 * rs * g2 * siluf(z2), y3 = v3 * rs * g3 * siluf(z3);
        bf16* yp = E.Y + (yoff0 + (unsigned)orow * 2048u);
        const float n0 = __shfl_xor(y0, 1), n1 = __shfl_xor(y1, 1), n2 = __shfl_xor(y2, 1), n3 = __shfl_xor(y3, 1);
        if ((r32 & 1) == 0) { *(unsigned*)(yp) = cvtpk(y0, n0); *(unsigned*)(yp + 32) = cvtpk(y1, n1); *(unsigned*)(yp + 64) = cvtpk(y2, n2); *(unsigned*)(yp + 96) = cvtpk(y3, n3); } }
    __syncthreads();
#undef RESC
#undef KBASE
#undef MASKT
#undef HALF_STEP
}
#undef VMW
#undef BL128
#undef SLOAD_H
#undef SWRITE_HK
#undef SWRITE_HV
#undef SWRITE_H
#undef KSWZ
#undef SBAR
__device__ __forceinline__ BlockRef make_ref(const Args& a, int bh, int qb) {
    BlockRef r; const size_t hb = (size_t)bh * SEQ * 128;
    r.Q = (const bf16*)(a.ws + WS_SEC + SEC_FQ * SEC_BYTES) + hb + (size_t)qb * QB * 128;
    r.K = (const bf16*)(a.ws + WS_SEC + SEC_FK * SEC_BYTES) + hb; r.V = (const bf16*)(a.ws + WS_SEC + SEC_FV * SEC_BYTES) + hb;
    r.KB = (const bf16*)(a.ws + WS_KBIAS) + (size_t)bh * SEQ * 8;
    r.P0 = qb * QB; r.tok0 = (bh >> 3) * SEQ + qb * QB; r.h = bh & 7; return r;
}
__device__ __forceinline__ void phase(const Args& a, lptr lds, int nblk, int blk) {
    const EpiParams E{a.in[IN_FOXNW], (const bf16*)(a.ws + WS_SEC + SEC_FZ * SEC_BYTES), (bf16*)(a.ws + WS_Y)};
#define DEC(L_, p_) make_ref(a, ((L_) & 7) * 4 + ((L_) >> 6), (p_) ? 15 - (((L_) >> 3) & 7) : (((L_) >> 3) & 7))
    for (int L = blk; L < 256; L += nblk)
        for (int pass = 0; pass < 2; ++pass) { const BlockRef cur = DEC(L, pass); block(cur, lds, E); }
#undef DEC
}
}

namespace ml {
typedef short bf16x8 __attribute__((ext_vector_type(8)));
typedef short s16x4 __attribute__((ext_vector_type(4)));
typedef float f32x16 __attribute__((ext_vector_type(16)));
typedef unsigned u32x4 __attribute__((ext_vector_type(4)));
typedef LAS char* lptr;
constexpr int ROWP = 144;
__device__ __forceinline__ int crow(int r, int hi) { return (r & 3) + 8 * (r >> 2) + 4 * hi; }
__device__ __forceinline__ int t_st(int k, int c) { const int kk = (k & ~0xC) | ((k & 4) << 1) | ((k & 8) >> 1); return ((kk >> 3) * 4 + (c >> 5)) * 512 + ((kk & 7) * 32 + (c & 31)) * 2; }
__device__ __forceinline__ int t_rd_base(int lane) { return ((lane & 3) << 3) | (((lane >> 2) & 3) << 6) | (((lane >> 4) & 1) << 5) | (((lane >> 5) & 1) << 8); }
#define TRFRAG(dst, addr, ks) do { s16x4 l_, h_; asm volatile("ds_read_b64_tr_b16 %0, %1 offset:%2" : "=&v"(l_) : "v"(addr), "i"((ks) * 4096) : "memory"); \
        asm volatile("ds_read_b64_tr_b16 %0, %1 offset:%2" : "=&v"(h_) : "v"(addr), "i"((ks) * 4096 + 2048) : "memory"); \
        asm volatile("s_waitcnt lgkmcnt(0)" ::: "memory"); __builtin_amdgcn_sched_barrier(0); \
        dst = (bf16x8){l_[0], l_[1], l_[2], l_[3], h_[0], h_[1], h_[2], h_[3]}; } while (0)
__device__ __forceinline__ void unpack8(const u32x4 r, float* f) { f[0] = bflo(r.x); f[1] = bfhi(r.x); f[2] = bflo(r.y); f[3] = bfhi(r.y); f[4] = bflo(r.z); f[5] = bfhi(r.z); f[6] = bflo(r.w); f[7] = bfhi(r.w); }

__device__ __forceinline__ void m1_item(const Args& a, lptr lds, int g) {
    const int tid = threadIdx.x, lane = tid & 63, wid = __builtin_amdgcn_readfirstlane(tid >> 6), r32 = lane & 31, hi = lane >> 5;
    const int bh = g >> 6, c = g & 63, b = bh >> 3, h = bh & 7; const int s0 = c * 64, tok0 = b * SEQ + s0;
    const float* G = (const float*)(a.ws + WS_GATE); float* MST = (float*)(a.ws + WS_MST);
    LAS float* wgt = (LAS float*)(lds + 32768);
    if (wid == 0) {
        const float lf = G[(size_t)(tok0 + lane) * 32 + 16 + h], ig = G[(size_t)(tok0 + lane) * 32 + 8 + h];
        float bc = lf;
#pragma unroll
        for (int o = 1; o < 64; o <<= 1) { const float t = __shfl_up(bc, o); if (lane >= o) bc += t; }
        const float bl = __shfl(bc, 63), w = bl - bc + ig, amax = wave_max(w);
        wgt[lane] = expf(w - amax);
        if (lane == 0) { MST[(size_t)g * 4 + 0] = amax; MST[(size_t)g * 4 + 1] = bl; }
    }
    {
        const int cgp = tid & 15, trow = tid >> 4, tA = 2 * trow; const bool isk = cgp >= 8; const int d0 = (cgp & 7) * 8;
        const int ch = (isk ? 512 : 0) + h * 64 + d0;
        const bf16* MQK = (const bf16*)(a.ws + WS_SEC + SEC_MQK * SEC_BYTES);
        const float* cw = a.in[IN_CONVW] + ch; const float* cb = a.in[IN_CONVB] + ch;
        float u[5][8];
#pragma unroll
        for (int j = 0; j < 5; ++j) { const int s = s0 + tA - 3 + j;
            if (s >= 0) { const u32x4 r = *(const u32x4*)(MQK + (size_t)(tok0 + tA - 3 + j) * 1024 + ch); unpack8(r, u[j]); }
            else {
#pragma unroll
                for (int e = 0; e < 8; ++e) u[j][e] = 0.f; } }
        float yA[8], yB[8]; const float osc = isk ? 0.125f : 1.f;
#pragma unroll
        for (int e = 0; e < 8; ++e) { const float w0 = cw[e], w1 = cw[1024 + e], w2 = cw[2048 + e], w3 = cw[3072 + e], bb = cb[e];
            float sA = u[0][e] * w0; sA += u[1][e] * w1; sA += u[2][e] * w2; sA += u[3][e] * w3; sA += bb;
            float sB = u[1][e] * w0; sB += u[2][e] * w1; sB += u[3][e] * w2; sB += u[4][e] * w3; sB += bb;
            yA[e] = siluf(sA) * osc; yB[e] = siluf(sB) * osc; }
        u32x4 oA, oB; oA.x = pk2(yA[0], yA[1]); oA.y = pk2(yA[2], yA[3]); oA.z = pk2(yA[4], yA[5]); oA.w = pk2(yA[6], yA[7]);
        oB.x = pk2(yB[0], yB[1]); oB.y = pk2(yB[2], yB[3]); oB.z = pk2(yB[4], yB[5]); oB.w = pk2(yB[6], yB[7]);
        bf16* dst = (bf16*)(a.ws + (isk ? WS_KC : WS_QC)) + ((size_t)bh * SEQ + s0 + tA) * 64 + d0;
        *(u32x4*)dst = oA; *(u32x4*)(dst + 64) = oB;
        if (isk) { *(LAS u32x4*)(lds + 16384 + t_st(tA, d0)) = oA; *(LAS u32x4*)(lds + 16384 + t_st(tA + 1, d0)) = oB; }
    }
    const bf16* MV = (const bf16*)(a.ws + WS_SEC + SEC_MV * SEC_BYTES);
    u32x4 vr[2];
#pragma unroll
    for (int i = 0; i < 2; ++i) { const int ci = tid + 512 * i, s = ci >> 4, vc = (ci & 15) * 8; vr[i] = *(const u32x4*)(MV + (size_t)(tok0 + s) * 1024 + h * 128 + vc); }
    __syncthreads();
#pragma unroll
    for (int i = 0; i < 2; ++i) { const int ci = tid + 512 * i, s = ci >> 4, vc = (ci & 15) * 8; const float ws_ = wgt[s]; float f[8]; unpack8(vr[i], f);
        u32x4 o; o.x = pk2(f[0] * ws_, f[1] * ws_); o.y = pk2(f[2] * ws_, f[3] * ws_); o.z = pk2(f[4] * ws_, f[5] * ws_); o.w = pk2(f[6] * ws_, f[7] * ws_);
        *(LAS u32x4*)(lds + t_st(s, vc)) = o; }
    __syncthreads();
    {
        const int vb = wid & 3, db = wid >> 2;
        const int va = (int)(uintptr_t)lds + t_rd_base(lane) + vb * 512, ka = (int)(uintptr_t)lds + 16384 + t_rd_base(lane) + db * 512;
        f32x16 acc = {};
        bf16x8 A, Bf;
        TRFRAG(A, va, 0); TRFRAG(Bf, ka, 0); acc = __builtin_amdgcn_mfma_f32_32x32x16_bf16(A, Bf, acc, 0, 0, 0);
        TRFRAG(A, va, 1); TRFRAG(Bf, ka, 1); acc = __builtin_amdgcn_mfma_f32_32x32x16_bf16(A, Bf, acc, 0, 0, 0);
        TRFRAG(A, va, 2); TRFRAG(Bf, ka, 2); acc = __builtin_amdgcn_mfma_f32_32x32x16_bf16(A, Bf, acc, 0, 0, 0);
        TRFRAG(A, va, 3); TRFRAG(Bf, ka, 3); acc = __builtin_amdgcn_mfma_f32_32x32x16_bf16(A, Bf, acc, 0, 0, 0);
        float* KL = (float*)(a.ws + WS_KLOC) + (size_t)g * 8192;
#pragma unroll
        for (int r = 0; r < 16; ++r) KL[(vb * 32 + crow(r, hi)) * 64 + db * 32 + r32] = acc[r];
    }
    if (wid == 0) {
        const int d = lane; float n = 0.f;
        for (int s = 0; s < 64; ++s) { const int kk = (s & ~0xC) | ((s & 4) << 1) | ((s & 8) >> 1);
            const unsigned short kv = *(const LAS unsigned short*)(lds + 16384 + ((kk >> 3) * 4 + (d >> 5)) * 512 + ((kk & 7) * 32 + (d & 31)) * 2);
            n += wgt[s] * bf2f(kv); }
        ((float*)(a.ws + WS_NLOC))[(size_t)g * 64 + d] = n;
    }
    __syncthreads();
}

__device__ __forceinline__ void m2_scan(const Args& a, int nblk, int blk) {
    const int tid = threadIdx.x;
    for (int vb = blk; vb < 256; vb += nblk) {
        const int bh = vb >> 3, e0 = ((vb & 7) * 512 + tid) * 2;
        const float* KL = (const float*)(a.ws + WS_KLOC) + (size_t)bh * 64 * 8192 + e0; unsigned* CP = (unsigned*)((bf16*)(a.ws + WS_CPREV) + (size_t)bh * 64 * 8192 + e0);
        float* NL = (float*)(a.ws + WS_NLOC) + (size_t)bh * 64 * 64 + 2 * tid; float* MST = (float*)(a.ws + WS_MST) + (size_t)bh * 64 * 4;
        const bool do_n = ((vb & 7) == 0) && tid < 32;
        float c0 = 0.f, c1 = 0.f, n0 = 0.f, n1 = 0.f, m = 0.f;
#pragma unroll 8
        for (int c = 0; c < 64; ++c) {
            const float amax = MST[c * 4 + 0], bl = MST[c * 4 + 1];
            const float2 kl = *(const float2*)(KL + (size_t)c * 8192);
            CP[(size_t)c * 4096] = pk2(c0, c1);
            if (do_n) { const float2 nl = *(const float2*)(NL + c * 64); *(float2*)(NL + c * 64) = make_float2(n0, n1);
                const float mn = fmaxf(bl + m, amax), fC = expf(bl + m - mn), fK = expf(amax - mn); n0 = fC * n0 + fK * nl.x; n1 = fC * n1 + fK * nl.y; }
            if ((vb & 7) == 0 && tid == 0) MST[c * 4 + 2] = m;
            const float mn = fmaxf(bl + m, amax), fC = expf(bl + m - mn), fK = expf(amax - mn);
            c0 = fC * c0 + fK * kl.x; c1 = fC * c1 + fK * kl.y; m = mn;
        }
    }
}

__device__ __forceinline__ void m3_item(const Args& a, lptr lds, int g) {
    const int tid = threadIdx.x, lane = tid & 63, wid = __builtin_amdgcn_readfirstlane(tid >> 6), r32 = lane & 31, hi = lane >> 5;
    const int bh = g >> 6, c = g & 63, b = bh >> 3, h = bh & 7; const int s0 = c * 64, tok0 = b * SEQ + s0;
    const float* G = (const float*)(a.ws + WS_GATE); const float* MST = (const float*)(a.ws + WS_MST);
    LAS float* fu = (LAS float*)(lds + 53248); LAS float* fMt = fu + 64; LAS float* fwi = fu + 128; LAS float* fmt = fu + 192; LAS float* fnp = fu + 256; LAS float* fhd = fu + 320; LAS float* fss = fu + 384;
    constexpr int QIMG = 16384, KIMG = 25600, SIMG = 34816, QPIMG = 44032;
    const int prow = tid >> 3, pc = (tid & 7) * 8;
    const u32x4 qv = *(const u32x4*)((const bf16*)(a.ws + WS_QC) + ((size_t)bh * SEQ + s0 + prow) * 64 + pc);
    const u32x4 kv = *(const u32x4*)((const bf16*)(a.ws + WS_KC) + ((size_t)bh * SEQ + s0 + prow) * 64 + pc);
    const bf16* MV = (const bf16*)(a.ws + WS_SEC + SEC_MV * SEC_BYTES);
    u32x4 vr[2];
#pragma unroll
    for (int i = 0; i < 2; ++i) { const int ci = tid + 512 * i, s = ci >> 4, vc = (ci & 15) * 8; vr[i] = *(const u32x4*)(MV + (size_t)(tok0 + s) * 1024 + h * 128 + vc); }
    if (wid == 0) {
        const float lf = G[(size_t)(tok0 + lane) * 32 + 16 + h], ig = G[(size_t)(tok0 + lane) * 32 + 8 + h];
        const float mprev = MST[(size_t)g * 4 + 2];
        float bc = lf;
#pragma unroll
        for (int o = 1; o < 64; o <<= 1) { const float t = __shfl_up(bc, o); if (lane >= o) bc += t; }
        const float u = ig - bc; float gm = u;
#pragma unroll
        for (int o = 1; o < 64; o <<= 1) { const float t = __shfl_up(gm, o); if (lane >= o) gm = fmaxf(gm, t); }
        const float Mt = fmaxf(mprev, gm);
        fu[lane] = u; fMt[lane] = Mt; fwi[lane] = expf(mprev - Mt); fmt[lane] = bc + Mt;
        fnp[lane] = ((const float*)(a.ws + WS_NLOC))[(size_t)g * 64 + lane];
    }
#pragma unroll
    for (int i = 0; i < 2; ++i) { const int ci = tid + 512 * i, s = ci >> 4, vc = (ci & 15) * 8; *(LAS u32x4*)(lds + t_st(s, vc)) = vr[i]; }
    *(LAS u32x4*)(lds + QIMG + prow * ROWP + pc * 2) = qv; *(LAS u32x4*)(lds + KIMG + prow * ROWP + pc * 2) = kv;
    __syncthreads();
    {
        float f[8]; unpack8(qv, f); const float wi = fwi[prow];
        u32x4 o; o.x = pk2(f[0] * wi, f[1] * wi); o.y = pk2(f[2] * wi, f[3] * wi); o.z = pk2(f[4] * wi, f[5] * wi); o.w = pk2(f[6] * wi, f[7] * wi);
        *(LAS u32x4*)(lds + QPIMG + prow * ROWP + pc * 2) = o;
    }
    if (wid < 4) {
        const int sb = wid & 1, tb = wid >> 1;
        f32x16 acc = {};
        if (sb <= tb) {
#pragma unroll
            for (int k0 = 0; k0 < 4; ++k0) { const bf16x8 Kf = *(const LAS bf16x8*)(lds + KIMG + (sb * 32 + r32) * ROWP + (k0 * 16 + hi * 8) * 2);
                const bf16x8 Qf = *(const LAS bf16x8*)(lds + QIMG + (tb * 32 + r32) * ROWP + (k0 * 16 + hi * 8) * 2);
                acc = __builtin_amdgcn_mfma_f32_32x32x16_bf16(Kf, Qf, acc, 0, 0, 0); }
        }
        const int t = tb * 32 + r32; const float Mt = fMt[t];
#pragma unroll
        for (int gq = 0; gq < 4; ++gq) { float v[4];
#pragma unroll
            for (int e = 0; e < 4; ++e) { const int s = sb * 32 + 8 * gq + 4 * hi + e; const float d = expf(fu[s] - Mt); v[e] = (s <= t) ? acc[4 * gq + e] * d : 0.f; }
            v2u o; o.x = pk2(v[0], v[1]); o.y = pk2(v[2], v[3]);
            *(LAS v2u*)(lds + SIMG + t * ROWP + (sb * 32 + 8 * gq + 4 * hi) * 2) = o; }
    }
    __syncthreads();
    const int tb = wid >> 2, vb = wid & 3;
    f32x16 acc = {};
    {
        const int va = (int)(uintptr_t)lds + t_rd_base(lane) + vb * 512;
        const bf16* CP = (const bf16*)(a.ws + WS_CPREV) + (size_t)g * 8192 + (size_t)(vb * 32 + r32) * 64 + hi * 8;
        bf16x8 Cf[4];
#pragma unroll
        for (int k0 = 0; k0 < 4; ++k0) Cf[k0] = *(const bf16x8*)(CP + k0 * 16);
        bf16x8 Af, Bf;
#define M3_STEP(ks) do { Af = *(const LAS bf16x8*)(lds + SIMG + (tb * 32 + r32) * ROWP + ((ks) * 16 + hi * 8) * 2); TRFRAG(Bf, va, ks); acc = __builtin_amdgcn_mfma_f32_32x32x16_bf16(Af, Bf, acc, 0, 0, 0); } while (0)
        M3_STEP(0); M3_STEP(1); M3_STEP(2); M3_STEP(3);
#undef M3_STEP
#pragma unroll
        for (int k0 = 0; k0 < 4; ++k0) { const bf16x8 Aq = *(const LAS bf16x8*)(lds + QPIMG + (tb * 32 + r32) * ROWP + (k0 * 16 + hi * 8) * 2);
            acc = __builtin_amdgcn_mfma_f32_32x32x16_bf16(Aq, Cf[k0], acc, 0, 0, 0); }
    }
    if (wid == 0) {
        const int t = lane; float ds = 0.f, qn = 0.f;
#pragma unroll
        for (int j = 0; j < 8; ++j) { const u32x4 sv = *(const LAS u32x4*)(lds + SIMG + t * ROWP + j * 16); float f[8]; unpack8(sv, f);
            ds += ((f[0] + f[1]) + (f[2] + f[3])) + ((f[4] + f[5]) + (f[6] + f[7]));
            const u32x4 qq = *(const LAS u32x4*)(lds + QIMG + t * ROWP + j * 16); float q[8]; unpack8(qq, q);
#pragma unroll
            for (int e = 0; e < 8; ++e) qn += q[e] * fnp[8 * j + e]; }
        const float den = ds + fwi[t] * qn;
        fhd[t] = 1.0f / fmaxf(fabsf(den), expf(-fmt[t]));
    }
    __syncthreads();
    const bf16* MO = (const bf16*)(a.ws + WS_SEC + SEC_MO * SEC_BYTES); const bf16* MZ = (const bf16*)(a.ws + WS_SEC + SEC_MZ * SEC_BYTES);
    const int vcol = h * 128 + vb * 32 + r32;
    float hb[16];
#pragma unroll
    for (int r = 0; r < 16; ++r) { const int t = tb * 32 + crow(r, hi);
        const float og = bf2f(MO[(size_t)(tok0 + t) * 1024 + vcol]);
        hb[r] = acc[r] * fhd[t] * sigmoidf_(og);
        float ss = hb[r] * hb[r];
        ss += __shfl_xor(ss, 1); ss += __shfl_xor(ss, 2); ss += __shfl_xor(ss, 4); ss += __shfl_xor(ss, 8); ss += __shfl_xor(ss, 16);
        if (r32 == 0) fss[t * 4 + vb] = ss; }
    __syncthreads();
    const float gw = a.in[IN_MNW][vcol]; bf16* Y = (bf16*)(a.ws + WS_Y);
#pragma unroll
    for (int r = 0; r < 16; ++r) { const int t = tb * 32 + crow(r, hi);
        const float ss = (fss[t * 4 + 0] + fss[t * 4 + 1]) + (fss[t * 4 + 2] + fss[t * 4 + 3]);
        const float rs = 1.0f / sqrtf(ss * (1.f / 128.f) + NORM_EPS);
        const float z = bf2f(MZ[(size_t)(tok0 + t) * 1024 + vcol]);
        const float y = hb[r] * rs * gw * siluf(z);
        const float yn = __shfl_xor(y, 1);
        if ((r32 & 1) == 0) *(unsigned*)(Y + (size_t)(tok0 + t) * 2048 + 1024 + vcol) = pk2(y, yn); }
    __syncthreads();
}
#undef TRFRAG
}

__global__ void __launch_bounds__(NTHREADS, 2) k_prep(Args a) {
    extern __shared__ __attribute__((aligned(16))) unsigned char lds[];
    phase_prep(a, (LAS unsigned char*)lds, gridDim.x, blockIdx.x);
}
__global__ void __launch_bounds__(NTHREADS, 2) k_gemm1(Args a) {
    extern __shared__ __attribute__((aligned(16))) unsigned char lds[];
    for (int c = blockIdx.x; c < M_TOK / 64; c += gridDim.x) gate_unit(a, (LAS unsigned char*)lds, c);
    pg8::Gemm g{(const pg8::bf16_t*)(a.ws + WS_XN), (const pg8::bf16_t*)(a.ws + WS_WIN), M_TOK, NMAIN, DM};
    pg8::StaticOrder S; S.init(M_TOK, NMAIN, gridDim.x, blockIdx.x);
    pg8::EpiProj E{a.ws + WS_SEC, QSCALE};
    pg8::gemm_phase<pg8::EpiProj, pg8::StaticOrder, true, true>((LAS unsigned char*)lds, g, S, E);
}
__global__ void __launch_bounds__(NTHREADS, 2) k_gemm2(Args a) {
    extern __shared__ __attribute__((aligned(16))) unsigned char lds[];
    pg8::Gemm g{(const pg8::bf16_t*)(a.ws + WS_Y), (const pg8::bf16_t*)(a.ws + WS_WOUT), M_TOK, DM, DM};
    pg8::StaticOrder S; S.init(M_TOK, DM, gridDim.x, blockIdx.x);
    pg8::EpiOut E{a.in[IN_X], a.out, (float*)(a.ws + WS_ROWSS)};
    pg8::gemm_phase<pg8::EpiOut, pg8::StaticOrder, true, true>((LAS unsigned char*)lds, g, S, E);
}
__global__ void __launch_bounds__(NTHREADS, 2) k_scan(Args a) {
    extern __shared__ __attribute__((aligned(16))) unsigned char lds[];
    for (int it = blockIdx.x; it < BATCH * NH; it += gridDim.x) fox_cumsum_item(a, (LAS unsigned char*)lds, it);
}
__global__ void __launch_bounds__(NTHREADS, 2) k_final(Args a) { phase_final(a, gridDim.x, blockIdx.x); }

__global__ void __launch_bounds__(NTHREADS, 2) k_attn(Args a) {
    extern __shared__ __attribute__((aligned(16))) unsigned char lds[];
    fox::phase(a, (fox::lptr)lds, gridDim.x, blockIdx.x);
}
__global__ void __launch_bounds__(NTHREADS, 2) k_m1(Args a) {
    extern __shared__ __attribute__((aligned(16))) unsigned char lds[];
    for (int g = blockIdx.x; g < BATCH * NH * NCHUNK; g += gridDim.x) ml::m1_item(a, (ml::lptr)lds, g);
}
__global__ void __launch_bounds__(NTHREADS, 2) k_m2(Args a) { ml::m2_scan(a, gridDim.x, blockIdx.x); }
__global__ void __launch_bounds__(NTHREADS, 2) k_m3(Args a) {
    extern __shared__ __attribute__((aligned(16))) unsigned char lds[];
    for (int g = blockIdx.x; g < BATCH * NH * NCHUNK; g += gridDim.x) ml::m3_item(a, (ml::lptr)lds, g);
}
extern "C" void kernel_launch(void* const* d_in, const int* in_sizes, int n_in, void* d_out, int out_size, void* d_ws, size_t ws_size, hipStream_t stream) {
    static int ok = 0;
    if (ok == 0) {
        if (n_in != 12 || in_sizes[0] != M_TOK * DM || in_sizes[2] != DM * IN_COLS || out_size != M_TOK * DM || ws_size < WS_END) {
            fprintf(stderr, "kernel_launch: shape mismatch n_in %d in0 %d in2 %d out %d ws %zu\n", n_in, n_in > 0 ? in_sizes[0] : -1, n_in > 2 ? in_sizes[2] : -1, out_size, ws_size); ok = -1; return; }
        hipFuncSetAttribute((const void*)k_prep, hipFuncAttributeMaxDynamicSharedMemorySize, LDS_BYTES);
        hipFuncSetAttribute((const void*)k_gemm1, hipFuncAttributeMaxDynamicSharedMemorySize, LDS_BYTES);
        hipFuncSetAttribute((const void*)k_gemm2, hipFuncAttributeMaxDynamicSharedMemorySize, LDS_BYTES);
        hipFuncSetAttribute((const void*)k_attn, hipFuncAttributeMaxDynamicSharedMemorySize, LDS_BYTES);
        hipFuncSetAttribute((const void*)k_m1, hipFuncAttributeMaxDynamicSharedMemorySize, LDS_BYTES);
        hipFuncSetAttribute((const void*)k_m3, hipFuncAttributeMaxDynamicSharedMemorySize, LDS_BYTES);
        hipFuncSetAttribute((const void*)k_scan, hipFuncAttributeMaxDynamicSharedMemorySize, LDS_BYTES);
        ok = 1;
    }
    if (ok < 0) return;
    Args a{};
    for (int i = 0; i < 12; ++i) a.in[i] = (const float*)d_in[i];
    a.out = (float*)d_out; a.ws = (unsigned char*)d_ws; a.ph_lo = 0; a.ph_hi = 0;
    hipLaunchKernelGGL(k_prep, dim3(256), dim3(NTHREADS), LDS_BYTES, stream, a);
    hipLaunchKernelGGL(k_gemm1, dim3(256), dim3(NTHREADS), LDS_BYTES, stream, a);
    hipLaunchKernelGGL(k_scan, dim3(32), dim3(NTHREADS), LDS_BYTES, stream, a);
    hipLaunchKernelGGL(k_m1, dim3(256), dim3(NTHREADS), LDS_BYTES, stream, a);
    hipLaunchKernelGGL(k_m2, dim3(256), dim3(NTHREADS), 0, stream, a);
    hipLaunchKernelGGL(k_attn, dim3(256), dim3(NTHREADS), LDS_BYTES, stream, a);
    hipLaunchKernelGGL(k_m3, dim3(256), dim3(NTHREADS), LDS_BYTES, stream, a);
    hipLaunchKernelGGL(k_gemm2, dim3(256), dim3(NTHREADS), LDS_BYTES, stream, a);
    hipLaunchKernelGGL(k_final, dim3(256), dim3(NTHREADS), 0, stream, a);
}
```

```cpp
#include <hip/hip_runtime.h>
#include <hip/hip_cooperative_groups.h>
#include <cstdio>
#include <cstdint>
namespace cg = cooperative_groups;

constexpr int BATCH = 4, SEQ = 4096, DM = 2048, M_TOK = BATCH * SEQ;
constexpr int NH = 8, HD = 128, DK = 64, CHUNK = 64, NCHUNK = SEQ / CHUNK;
constexpr int IN_COLS = 8216, NMAIN = 8192, NGATE = 32;
constexpr float NORM_EPS = 1e-6f;
constexpr float LOG2E = 1.4426950408889634f;
constexpr float QSCALE = 0.08838834764831845f * 1.4426950408889634f;

constexpr size_t MiB = 1u << 20;
constexpr size_t WS_CTL = 0;
constexpr size_t WS_KNRM = 1 * MiB, WS_KSUF = 1 * MiB + 8192, WS_KBND = 1 * MiB + 16384;
constexpr size_t WS_GATE = 2 * MiB;
constexpr size_t WS_ROWSS = 4 * MiB;
constexpr size_t WS_WGT = 6 * MiB;
constexpr size_t WS_KBIAS = 7 * MiB;
constexpr size_t WS_MST = 9 * MiB;
constexpr size_t WS_NLOC = 10 * MiB;
constexpr size_t WS_NPREV = 11 * MiB;
constexpr size_t WS_GV = 12 * MiB;
constexpr size_t WS_WOUT = 16 * MiB;
constexpr size_t WS_WIN = 32 * MiB;
constexpr size_t WS_QC = 32 * MiB;
constexpr size_t WS_KC = 48 * MiB;
constexpr size_t WS_XN = 64 * MiB;
constexpr size_t WS_Y = 64 * MiB;
constexpr size_t WS_SEC = 128 * MiB;
constexpr size_t SEC_BYTES = 32 * MiB;
constexpr size_t WS_KLOC = 384 * MiB;
constexpr size_t WS_DELTA = 384 * MiB;
constexpr size_t WS_CPREV = 448 * MiB;
constexpr size_t WS_END = 480 * MiB;
enum { SEC_FQ = 0, SEC_FK, SEC_FV, SEC_FZ, SEC_MQK, SEC_MV, SEC_MO, SEC_MZ };

typedef unsigned short bf16;
typedef unsigned v4u __attribute__((ext_vector_type(4)));
typedef unsigned v2u __attribute__((ext_vector_type(2)));
typedef float f32x16 __attribute__((ext_vector_type(16)));
#define LAS __attribute__((address_space(3)))
#define LDS_WAIT() asm volatile("s_waitcnt lgkmcnt(0)" ::: "memory")

__device__ __forceinline__ unsigned f2bf(float f) { unsigned u = __builtin_bit_cast(unsigned, f); return (u + 0x7fffu + ((u >> 16) & 1u)) >> 16; }
typedef float f32x2_t __attribute__((ext_vector_type(2))); typedef __bf16 bf16x2_t __attribute__((ext_vector_type(2)));
__device__ __forceinline__ unsigned pk2(float lo, float hi) { f32x2_t v = {lo, hi}; bf16x2_t b = __builtin_convertvector(v, bf16x2_t); return __builtin_bit_cast(unsigned, b); }
__device__ __forceinline__ float bf2f(unsigned h) { return __builtin_bit_cast(float, (h & 0xffffu) << 16); }
__device__ __forceinline__ float bflo(unsigned w) { return __builtin_bit_cast(float, w << 16); }
__device__ __forceinline__ float bfhi(unsigned w) { return __builtin_bit_cast(float, w & 0xffff0000u); }
__device__ __forceinline__ float wave_sum(float v) {
#pragma unroll
    for (int o = 1; o < 64; o <<= 1) v += __shfl_xor(v, o);
    return v;
}
__device__ __forceinline__ float wave_max(float v) {
#pragma unroll
    for (int o = 1; o < 64; o <<= 1) v = fmaxf(v, __shfl_xor(v, o));
    return v;
}
#define DPP_F(x, old, ctrl, rm, bm) __builtin_bit_cast(float, __builtin_amdgcn_update_dpp(__builtin_bit_cast(int, (float)(old)), __builtin_bit_cast(int, (float)(x)), ctrl, rm, bm, false))
__device__ __forceinline__ float wave_scan_add(float v) {
    float s = v + DPP_F(v, 0.f, 0x111, 0xf, 0xf); s += DPP_F(v, 0.f, 0x112, 0xf, 0xf); s += DPP_F(v, 0.f, 0x113, 0xf, 0xf);
    s += DPP_F(s, 0.f, 0x114, 0xf, 0xe); s += DPP_F(s, 0.f, 0x118, 0xf, 0xc);
    s += DPP_F(s, 0.f, 0x142, 0xa, 0xf); s += DPP_F(s, 0.f, 0x143, 0xc, 0xf);
    return s;
}
__device__ __forceinline__ float wave_scan_max(float v) {
    const float NI = -__builtin_inff();
    float s = fmaxf(v, DPP_F(v, NI, 0x111, 0xf, 0xf)); s = fmaxf(s, DPP_F(v, NI, 0x112, 0xf, 0xf)); s = fmaxf(s, DPP_F(v, NI, 0x113, 0xf, 0xf));
    s = fmaxf(s, DPP_F(s, NI, 0x114, 0xf, 0xe)); s = fmaxf(s, DPP_F(s, NI, 0x118, 0xf, 0xc));
    s = fmaxf(s, DPP_F(s, NI, 0x142, 0xa, 0xf)); s = fmaxf(s, DPP_F(s, NI, 0x143, 0xc, 0xf));
    return s;
}
__device__ __forceinline__ float logsigmoidf(float x) { return fminf(x, 0.f) - log1pf(expf(-fabsf(x))); }
__device__ __forceinline__ float siluf(float x) { return x / (1.f + expf(-x)); }
__device__ __forceinline__ float sigmoidf_(float x) { return 1.f / (1.f + expf(-x)); }

namespace pg8 {
#define PG8_LAS __attribute__((address_space(3)))
typedef unsigned short bf16_t;
typedef short bf16x8 __attribute__((ext_vector_type(8)));
typedef float f32x4 __attribute__((ext_vector_type(4)));
typedef unsigned u32x4 __attribute__((ext_vector_type(4)));
constexpr int BM = 256, BK = 64, HALF = 128, HTB = HALF * BK * 2  , STAGE_BYTES = 8 * HTB, NXCD = 8, WGM = 4;

__host__ __device__ __forceinline__ int lds_byte(int r, int c) { const int st = (r >> 4) * 2 + (c >> 5), rr = r & 15, cc = c & 31, ob = rr * 64 + cc * 2; return st * 1024 + (ob ^ (((ob >> 9) & 1) << 5)); }
__host__ __device__ __forceinline__ void stage_rc(int b, int& R, int& C) { const int st = b / 1024, sb = b % 1024, swz = sb ^ (((sb >> 9) & 1) << 5); R = (st >> 1) * 16 + swz / 64; C = (st & 1) * 32 + (swz % 64) / 2; }
__host__ __device__ __forceinline__ int perm32(int rho) { const int n = rho >> 4, i = rho & 15; return 8 * (i >> 2) + 4 * n + (i & 3); }

struct Unit { int pm, pn; };
struct Gemm { const bf16_t* A; const bf16_t* Bt; int M, N, K; };

struct StaticOrder {
    int nM, nN, nwg, G, c;
    __host__ __device__ void init(int M, int N, int G_, int c_) { nM = M / BM; nN = N / BM; nwg = nM * nN; G = G_; c = c_; }
    __host__ __device__ bool next(int i, Unit& u) const {
        const long L = (long)i * G + c; if (L >= nwg) return false;
        int wgid = (int)L; { const int q = nwg / NXCD, r = nwg % NXCD, xcd = wgid % NXCD, off = wgid / NXCD; wgid = (xcd < r ? xcd * (q + 1) : r * (q + 1) + (xcd - r) * q) + off; }
        const int nig = WGM * nN, gid = wgid / nig, fm = gid * WGM, gsz = (nM - fm) < WGM ? (nM - fm) : WGM;
        u.pm = fm + ((wgid % nig) % gsz); u.pn = (wgid % nig) / gsz; return true;
    }
    __device__ __forceinline__ void a_ready(const Unit&) const {}
    __device__ __forceinline__ void done(const Unit&) const {}
};

__device__ __forceinline__ unsigned cvt_pk_bf16(float lo, float hi) { return pk2(lo, hi); }

struct XcdColOrder {
    int nM, nN, G, c;
    __host__ __device__ void init(int M, int N, int G_, int c_) { nM = M / BM; nN = N / BM; G = G_; c = c_; }
    __host__ __device__ bool next(int i, Unit& u) const {
        const int x = c & 7, j = c >> 3, per = nN >> 3, rows = (G >> 3) / per;
        u.pn = x * per + j / rows; u.pm = i * rows + j % rows; return u.pm < nM;
    }
    __device__ __forceinline__ void a_ready(const Unit&) const {}
    __device__ __forceinline__ void done(const Unit&) const {}
};

#ifndef STORE_AUX
#define STORE_AUX 16
#endif
struct EpiProj {
    static constexpr bool PERM = true, AFTER_DRAIN = false;
    unsigned char* secbase; float qscale;
    __device__ __forceinline__ void operator()(const f32x4 (&acc)[2][2][4][2], const Unit& u, int wr, int wc, int fr, int fq) const {
        const int sec = u.pn >> 2, t4 = u.pn & 3;
        const int row0 = u.pm * BM + wr * 64 + fr;
        bf16_t* base = (bf16_t*)(secbase + (size_t)sec * (32u << 20));
        const __amdgpu_buffer_rsrc_t rs = __builtin_amdgcn_make_buffer_rsrc((void*)secbase, 0, (int)(256u << 20), 0x00020000);
        const float sc = sec == 0 ? qscale : 1.f;
        size_t rstride, bjstride, off0;
        if (sec < 3) {
            const int b = row0 >> 12, s0 = row0 & 4095;
            rstride = 128; bjstride = (size_t)4096 * 128; off0 = ((size_t)(b * 8 + t4 * 2) * 4096 + s0) * 128 + wc * 32 + 8 * fq;
        } else {
            rstride = 1024; bjstride = 128; off0 = (size_t)row0 * 1024 + t4 * 256 + wc * 32 + 8 * fq;
        }
#pragma unroll
        for (int ai = 0; ai < 2; ++ai)
#pragma unroll
            for (int m = 0; m < 4; ++m) { bf16_t* rowp = base + off0 + (size_t)(ai * HALF + m * 16) * rstride;
#pragma unroll
                for (int bj = 0; bj < 2; ++bj) { f32x4 v0 = acc[ai][bj][m][0] * sc, v1 = acc[ai][bj][m][1] * sc;
                    u32x4 w; w.x = cvt_pk_bf16(v0[0], v0[1]); w.y = cvt_pk_bf16(v0[2], v0[3]); w.z = cvt_pk_bf16(v1[0], v1[1]); w.w = cvt_pk_bf16(v1[2], v1[3]);
                    __builtin_amdgcn_raw_buffer_store_b128(w, rs, (int)((const unsigned char*)(rowp + bj * bjstride) - secbase), 0, STORE_AUX); } }
    }
};
struct EpiOut {
    static constexpr bool PERM = true, AFTER_DRAIN = false;
    bf16_t* delta;
    __device__ __forceinline__ void operator()(const f32x4 (&acc)[2][2][4][2], const Unit& u, int wr, int wc, int fr, int fq) const {
        const int row0 = u.pm * BM + wr * 64 + fr; bf16_t* base = delta + (size_t)row0 * 2048 + u.pn * BM + wc * 32 + 8 * fq;
#pragma unroll
        for (int ai = 0; ai < 2; ++ai)
#pragma unroll
            for (int m = 0; m < 4; ++m) { bf16_t* rowp = base + (size_t)(ai * HALF + m * 16) * 2048;
#pragma unroll
                for (int bj = 0; bj < 2; ++bj) { const f32x4 v0 = acc[ai][bj][m][0], v1 = acc[ai][bj][m][1];
                    u32x4 w; w.x = cvt_pk_bf16(v0[0], v0[1]); w.y = cvt_pk_bf16(v0[2], v0[3]); w.z = cvt_pk_bf16(v1[0], v1[1]); w.w = cvt_pk_bf16(v1[2], v1[3]);
                    *(u32x4*)(rowp + bj * HALF) = w; } }
    }
};

template <class Epi, class Sched, bool ALIGN_EPI = false, bool SP2 = false>
__device__ __forceinline__ void gemm_phase(PG8_LAS unsigned char* lds, const Gemm g, const Sched& S, const Epi& E) {
    const int tid = threadIdx.x, wid = __builtin_amdgcn_readfirstlane(tid >> 6), lane = tid & 63, wr = wid >> 2, wc = wid & 3, fr = lane & 15, fq = lane >> 4;
    const int K = g.K, nt = K / BK;
    unsigned voffA[2], voffB[2];
#pragma unroll
    for (int i = 0; i < 2; ++i) { int R, C; stage_rc(tid * 16 + i * 8192, R, C); const int Rb = Epi::PERM ? ((R & ~31) + perm32(R & 31)) : R;
        voffA[i] = (unsigned)(R * K + C) * 2u; voffB[i] = (unsigned)(Rb * K + C) * 2u; }
    const size_t kstep = (size_t)(BK * 2);
    const size_t hstep = (size_t)HALF * K * 2;
    const size_t tstep = 2 * hstep;
    const unsigned ldsw = (unsigned)wid * 1024u;
    const int aoff = lds_byte(wr * 64 + fr, fq * 8), boff = lds_byte(wc * 32 + fr, fq * 8);
#define PG8_SA(b, h) (((b) * 2 + (h)) * HTB)
#define PG8_SB(b, h) ((4 + (b) * 2 + (h)) * HTB)
#define PG8_STAGE(bufoff, gbase, voff) do { _Pragma("unroll") for (int _i = 0; _i < 2; ++_i) \
        __builtin_amdgcn_global_load_lds((const unsigned*)((const char*)(gbase) + (voff)[_i]), (PG8_LAS unsigned*)(lds + (bufoff) + ldsw + _i * 8192), 16, 0, 0); } while (0)
#define PG8_LDA(dst, b, h) do { _Pragma("unroll") for (int m = 0; m < 4; ++m) _Pragma("unroll") for (int k = 0; k < 2; ++k) dst[m][k] = *(const PG8_LAS bf16x8*)(lds + PG8_SA(b, h) + aoff + m * 2048 + k * 1024); } while (0)
#define PG8_LDB(dst, b, h) do { _Pragma("unroll") for (int n = 0; n < 2; ++n) _Pragma("unroll") for (int k = 0; k < 2; ++k) dst[n][k] = *(const PG8_LAS bf16x8*)(lds + PG8_SB(b, h) + boff + n * 2048 + k * 1024); } while (0)
#define PG8_MMA(ai, bj, At, Bt) do { __builtin_amdgcn_s_setprio(1); _Pragma("unroll") for (int m = 0; m < 4; ++m) _Pragma("unroll") for (int n = 0; n < 2; ++n) _Pragma("unroll") for (int k = 0; k < 2; ++k) \
        acc[ai][bj][m][n] = __builtin_amdgcn_mfma_f32_16x16x32_bf16(Bt[n][k], At[m][k], acc[ai][bj][m][n], 0, 0, 0); __builtin_amdgcn_s_setprio(0); } while (0)
#define PG8_WAIT_V(n) asm volatile("s_waitcnt vmcnt(" #n ")" ::: "memory")
#define PG8_WAIT_L(n) asm volatile("s_waitcnt lgkmcnt(" #n ")" ::: "memory")
#define PG8_BAR __builtin_amdgcn_s_barrier()
#define PG8_SCHED __builtin_amdgcn_sched_barrier(0)
    Unit cur, nxt; int ui = 0;
    if (!S.next(0, cur)) return;
    f32x4 acc[2][2][4][2];
#pragma unroll
    for (int a = 0; a < 2; ++a)
#pragma unroll
        for (int b = 0; b < 2; ++b)
#pragma unroll
            for (int m = 0; m < 4; ++m)
#pragma unroll
                for (int n = 0; n < 2; ++n) acc[a][b][m][n] = (f32x4){0.f, 0.f, 0.f, 0.f};
    bf16x8 At[4][2], B0[2][2], B1[2][2];
    const char* cA = (const char*)g.A + (size_t)cur.pm * tstep; const char* cB = (const char*)g.Bt + (size_t)cur.pn * tstep;
    S.a_ready(cur);
    if constexpr (SP2) {
        PG8_STAGE(PG8_SB(0, 0), cB, voffB); PG8_STAGE(PG8_SB(0, 1), cB + hstep, voffB); PG8_STAGE(PG8_SA(0, 0), cA, voffA); PG8_STAGE(PG8_SA(0, 1), cA + hstep, voffA);
        if (wr == 1) PG8_BAR;
        PG8_WAIT_V(2); PG8_BAR;
        PG8_STAGE(PG8_SB(1, 0), cB + kstep, voffB); PG8_STAGE(PG8_SA(1, 0), cA + kstep, voffA); PG8_STAGE(PG8_SB(1, 1), cB + hstep + kstep, voffB);
        PG8_WAIT_V(6); PG8_BAR;
    } else {
        PG8_STAGE(PG8_SB(0, 0), cB, voffB); PG8_STAGE(PG8_SA(0, 0), cA, voffA); PG8_STAGE(PG8_SB(0, 1), cB + hstep, voffB); PG8_STAGE(PG8_SA(0, 1), cA + hstep, voffA);
        if (wr == 1) PG8_BAR;
        PG8_WAIT_V(4); PG8_BAR;
        PG8_STAGE(PG8_SB(1, 0), cB + kstep, voffB); PG8_STAGE(PG8_SA(1, 0), cA + kstep, voffA); PG8_STAGE(PG8_SB(1, 1), cB + hstep + kstep, voffB);
        PG8_WAIT_V(6); PG8_BAR;
    }
    for (;;) {
        const bool has_next = S.next(ui + 1, nxt);
        const char* nA = has_next ? (const char*)g.A + (size_t)nxt.pm * tstep : cA; const char* nB = has_next ? (const char*)g.Bt + (size_t)nxt.pn * tstep : cB;
        for (int t = 0; t < nt; t += 2) {
            const bool last = (t == nt - 2);
            const char* a1 = cA + (size_t)(t + 1) * kstep;
            const char* a2 = last ? nA : cA + (size_t)(t + 2) * kstep; const char* b2 = last ? nB : cB + (size_t)(t + 2) * kstep;
            const char* a3 = a2 + kstep; const char* b3 = b2 + kstep;
            if (last && has_next) S.a_ready(nxt);
            if constexpr (SP2) {
            PG8_LDB(B0, 0, 0); PG8_LDB(B1, 0, 1); PG8_SCHED; PG8_LDA(At, 0, 0); PG8_STAGE(PG8_SA(1, 1), a1 + hstep, voffA);
            PG8_WAIT_V(8); PG8_WAIT_L(0); PG8_BAR; PG8_MMA(0, 0, At, B0); PG8_MMA(0, 1, At, B1); PG8_BAR; PG8_SCHED;
            PG8_LDA(At, 0, 1); PG8_STAGE(PG8_SB(0, 0), b2, voffB); PG8_STAGE(PG8_SB(0, 1), b2 + hstep, voffB); PG8_STAGE(PG8_SA(0, 0), a2, voffA);
            PG8_WAIT_V(8); PG8_WAIT_L(0); PG8_BAR; PG8_MMA(1, 0, At, B0); PG8_MMA(1, 1, At, B1); PG8_BAR; PG8_SCHED;
            PG8_LDB(B0, 1, 0); PG8_LDB(B1, 1, 1); PG8_SCHED; PG8_LDA(At, 1, 0); PG8_STAGE(PG8_SA(0, 1), a2 + hstep, voffA);
            PG8_WAIT_V(8); PG8_WAIT_L(0); PG8_BAR; PG8_MMA(0, 0, At, B0); PG8_MMA(0, 1, At, B1); PG8_BAR; PG8_SCHED;
            PG8_LDA(At, 1, 1); PG8_STAGE(PG8_SB(1, 0), b3, voffB); PG8_STAGE(PG8_SB(1, 1), b3 + hstep, voffB); PG8_STAGE(PG8_SA(1, 0), a3, voffA);
            PG8_WAIT_V(8); PG8_WAIT_L(0); PG8_BAR; PG8_MMA(1, 0, At, B0); PG8_MMA(1, 1, At, B1); PG8_BAR; PG8_SCHED;
            } else {
            PG8_LDB(B0, 0, 0); PG8_SCHED; PG8_LDA(At, 0, 0); PG8_STAGE(PG8_SA(1, 1), a1 + hstep, voffA);
            PG8_WAIT_L(8); PG8_BAR; PG8_WAIT_L(0); PG8_MMA(0, 0, At, B0); PG8_BAR; PG8_SCHED;
            PG8_LDB(B1, 0, 1); PG8_STAGE(PG8_SB(0, 0), b2, voffB);
            PG8_BAR; PG8_WAIT_L(0); PG8_MMA(0, 1, At, B1); PG8_BAR;
            PG8_LDA(At, 0, 1); PG8_STAGE(PG8_SA(0, 0), a2, voffA);
            PG8_BAR; PG8_WAIT_L(0); PG8_MMA(1, 0, At, B0); PG8_BAR; PG8_SCHED;
            PG8_STAGE(PG8_SB(0, 1), b2 + hstep, voffB);
            PG8_WAIT_V(6); PG8_BAR; PG8_MMA(1, 1, At, B1); PG8_BAR;
            PG8_LDB(B0, 1, 0); PG8_SCHED; PG8_LDA(At, 1, 0); PG8_STAGE(PG8_SA(0, 1), a2 + hstep, voffA);
            PG8_WAIT_L(8); PG8_BAR; PG8_WAIT_L(0); PG8_MMA(0, 0, At, B0); PG8_BAR; PG8_SCHED;
            PG8_LDB(B1, 1, 1); PG8_STAGE(PG8_SB(1, 0), b3, voffB);
            PG8_BAR; PG8_WAIT_L(0); PG8_MMA(0, 1, At, B1); PG8_BAR;
            PG8_LDA(At, 1, 1); PG8_STAGE(PG8_SA(1, 0), a3, voffA);
            PG8_BAR; PG8_WAIT_L(0); PG8_MMA(1, 0, At, B0); PG8_BAR; PG8_SCHED;
            PG8_STAGE(PG8_SB(1, 1), b3 + hstep, voffB);
            PG8_WAIT_V(6); PG8_BAR; PG8_MMA(1, 1, At, B1); PG8_BAR;
            }
        }
        if constexpr (ALIGN_EPI) { if (wr == 0) PG8_BAR; }
        if constexpr (!Epi::AFTER_DRAIN) { E(acc, cur, wr, wc, fr, fq); S.done(cur); }
        if (!has_next) break;
#pragma unroll
        for (int a = 0; a < 2; ++a)
#pragma unroll
            for (int b = 0; b < 2; ++b)
#pragma unroll
                for (int m = 0; m < 4; ++m)
#pragma unroll
                    for (int n = 0; n < 2; ++n) acc[a][b][m][n] = (f32x4){0.f, 0.f, 0.f, 0.f};
        cur = nxt; cA = nA; cB = nB; ++ui;
        if constexpr (ALIGN_EPI) { if (wr == 1) PG8_BAR; }
    }
    PG8_WAIT_V(0);
    if constexpr (!ALIGN_EPI) { if (wr == 0) PG8_BAR; }
    PG8_BAR;
    if constexpr (Epi::AFTER_DRAIN) { E.fused(acc, cur, wr, wc, fr, fq, lds, wid, lane); S.done(cur); }
#undef PG8_SA
#undef PG8_SB
#undef PG8_STAGE
#undef PG8_LDA
#undef PG8_LDB
#undef PG8_MMA
#undef PG8_WAIT_V
#undef PG8_WAIT_L
#undef PG8_BAR
#undef PG8_SCHED
}
}
struct Args { const float* in[12]; float* out; unsigned char* ws; int ph_lo, ph_hi, flags, pad; };
enum { IN_X = 0, IN_NORMW, IN_WIN, IN_FOXFB, IN_CONVW, IN_CONVB, IN_MIB, IN_MFB, IN_FOXNW, IN_MNW, IN_WOUT, IN_FINW };
constexpr int NWAVES = 8, NTHREADS = 512;
constexpr int LDS_BYTES = 147456;

__device__ __forceinline__ void p0_transpose_gate(const float* W, int ldw, int k0, bf16* WT, int K, LAS float* scr, int lane) {
    const int n_ = lane & 31; const int sc = n_ < 8 ? 4096 + n_ : n_ < 16 ? 8200 + (n_ - 8) : n_ < 24 ? 8208 + (n_ - 16) : -1;
#pragma unroll 8
    for (int i = 0; i < 32; ++i) { const int kk = 2 * i + (lane >> 5); scr[kk * 33 + (lane & 31)] = sc >= 0 ? W[(size_t)(k0 + kk) * ldw + sc] : 0.f; }
    LDS_WAIT(); asm volatile("" ::: "memory");
    const int c = lane & 7;
#pragma unroll
    for (int j = 0; j < 4; ++j) { const int n = (lane >> 3) + 8 * j; const LAS float* s = scr + (8 * c) * 33 + n;
        v4u o; o.x = pk2(s[0 * 33], s[1 * 33]); o.y = pk2(s[2 * 33], s[3 * 33]); o.z = pk2(s[4 * 33], s[5 * 33]); o.w = pk2(s[6 * 33], s[7 * 33]);
        *(v4u*)(WT + (size_t)n * K + k0 + 8 * c) = o; }
    LDS_WAIT(); asm volatile("" ::: "memory");
}
struct XRow { pg8::f32x4 v[8]; };
__device__ __forceinline__ void xrow_load(XRow& R, const float* x, int m, int lane) {
    const pg8::f32x4* xr = (const pg8::f32x4*)(x + (size_t)m * DM) + 2 * lane;
#pragma unroll
    for (int j = 0; j < 4; ++j) { R.v[2 * j] = xr[128 * j]; R.v[2 * j + 1] = xr[128 * j + 1]; }
}
__device__ __forceinline__ void xrow_store(const XRow& R, const pg8::f32x4 (&g)[8], bf16* XN, int m, int lane) {
    float s = 0.f;
#pragma unroll
    for (int j = 0; j < 8; ++j) s += (R.v[j][0] * R.v[j][0] + R.v[j][1] * R.v[j][1]) + (R.v[j][2] * R.v[j][2] + R.v[j][3] * R.v[j][3]);
    const float rstd = 1.0f / sqrtf(wave_sum(s) * (1.f / DM) + NORM_EPS);
    v4u* o = (v4u*)(XN + (size_t)m * DM) + lane;
#pragma unroll
    for (int j = 0; j < 4; ++j) { const pg8::f32x4 a0 = R.v[2 * j] * rstd * g[2 * j], a1 = R.v[2 * j + 1] * rstd * g[2 * j + 1];
        v4u w; w.x = pk2(a0[0], a0[1]); w.y = pk2(a0[2], a0[3]); w.z = pk2(a1[0], a1[1]); w.w = pk2(a1[2], a1[3]); o[64 * j] = w; }
}
struct TTile { const float* src; bf16* dst; int ldw; };
__device__ __forceinline__ void ttile_load(const TTile& t, pg8::f32x4 (&r)[8], int wave, int lane) {
#pragma unroll
    for (int i = 0; i < 8; ++i) r[i] = *(const pg8::f32x4*)(t.src + (size_t)(8 * i + wave) * t.ldw + 4 * lane);
}
__device__ __forceinline__ void phase_prep(const Args& a, LAS unsigned char* lds, int nblk, int blk) {
    const int tid = threadIdx.x, lane = tid & 63, wave = tid >> 6;
    const int gw = blk * NWAVES + wave, NGW = nblk * NWAVES;
    const float* win = a.in[IN_WIN]; const float* wout = a.in[IN_WOUT];
    bf16* WIN_T = (bf16*)(a.ws + WS_WIN); bf16* WG_T = (bf16*)(a.ws + WS_WGT); bf16* WOUT_T = (bf16*)(a.ws + WS_WOUT);
    constexpr int T_MAIN = 32 * 32, T_OUT = 32 * 8, NTILES = T_MAIN + T_OUT, TP = 260;
    LAS float* tile = (LAS float*)lds;
#define P0_DECODE(it_, T_) do { int r_ = (it_); if (r_ < T_MAIN) { const int kb = r_ >> 5, n0 = 256 * (r_ & 31); T_.src = win + (size_t)(64 * kb) * IN_COLS + (n0 < 4096 ? n0 : n0 + 8); T_.dst = WIN_T + (size_t)n0 * DM + 64 * kb; T_.ldw = IN_COLS; } \
        else { r_ -= T_MAIN; const int kb = r_ >> 3, n0 = 256 * (r_ & 7); T_.src = wout + (size_t)(64 * kb) * DM + n0; T_.dst = WOUT_T + (size_t)n0 * DM + 64 * kb; T_.ldw = DM; } } while (0)
    if (!(a.flags & 1)) {
        TTile T; pg8::f32x4 r[8];
        int it = blk; if (it < NTILES) { P0_DECODE(it, T); ttile_load(T, r, wave, lane); }
        for (; it < NTILES; it += nblk) {
#pragma unroll
            for (int i = 0; i < 8; ++i) { const int k = 8 * i + wave; *(LAS pg8::f32x4*)(tile + k * TP + ((4 * lane + 4 * i) & 255)) = r[i]; }
            const bf16* dummy = nullptr; (void)dummy;
            bf16* dst = T.dst;
            const int itn = it + nblk; { const int itc = itn < NTILES ? itn : it; P0_DECODE(itc, T); ttile_load(T, r, wave, lane); } __builtin_amdgcn_sched_barrier(0);
            __syncthreads();
            const int c = lane & 7;
#pragma unroll
            for (int j = 0; j < 4; ++j) { const int n = 32 * wave + 8 * j + (lane >> 3); const LAS float* s = tile + (8 * c) * TP + ((n + 4 * c) & 255);
                v4u o; o.x = pk2(s[0 * TP], s[1 * TP]); o.y = pk2(s[2 * TP], s[3 * TP]); o.z = pk2(s[4 * TP], s[5 * TP]); o.w = pk2(s[6 * TP], s[7 * TP]);
                *(v4u*)(dst + (size_t)n * DM + 8 * c) = o; }
            __syncthreads();
        }
        if (gw < 32) p0_transpose_gate(win, IN_COLS, 64 * gw, WG_T, DM, (LAS float*)(lds + wave * 16384), lane);
        __syncthreads();
    }
#undef P0_DECODE
    const float* x = a.in[IN_X]; bf16* XN = (bf16*)(a.ws + WS_XN);
    pg8::f32x4 g[8];
    { const pg8::f32x4* wr = (const pg8::f32x4*)a.in[IN_NORMW] + 2 * lane;
#pragma unroll
      for (int j = 0; j < 4; ++j) { g[2 * j] = wr[128 * j]; g[2 * j + 1] = wr[128 * j + 1]; } }
    XRow R0, R1, R2, R3;
    int m = (a.flags & 2) ? M_TOK : gw;
#define XLD(R_, m_) do { xrow_load(R_, x, (m_) < M_TOK ? (m_) : M_TOK - 1, lane); __builtin_amdgcn_sched_barrier(0); } while (0)
#define XST(R_, m_) do { if ((m_) < M_TOK) xrow_store(R_, g, XN, (m_), lane); __builtin_amdgcn_sched_barrier(0); } while (0)
    XLD(R0, m); XLD(R1, m + NGW); XLD(R2, m + 2 * NGW);
    for (; m < M_TOK; m += 4 * NGW) {
        XLD(R3, m + 3 * NGW); XST(R0, m);
        XLD(R0, m + 4 * NGW); XST(R1, m + NGW);
        XLD(R1, m + 5 * NGW); XST(R2, m + 2 * NGW);
        XLD(R2, m + 6 * NGW); XST(R3, m + 3 * NGW);
    }
#undef XLD
#undef XST
}

__device__ __forceinline__ void gate_unit(const Args& a, LAS unsigned char* lds, int c) {
    const int tid = threadIdx.x, lane = tid & 63, wave = tid >> 6, r32 = lane & 31, hi = lane >> 5;
    const bf16* XN = (const bf16*)(a.ws + WS_XN); const bf16* WG_T = (const bf16*)(a.ws + WS_WGT);
    f32x16 acc0 = {}, acc1 = {};
    const bf16* a0 = XN + (size_t)(64 * c + r32) * DM + 256 * wave + 8 * hi; const bf16* a1 = a0 + (size_t)32 * DM;
    const bf16* bp = WG_T + (size_t)r32 * DM + 256 * wave + 8 * hi;
#pragma unroll 8
    for (int ks = 0; ks < 16; ++ks) {
        const pg8::bf16x8 A0 = *(const pg8::bf16x8*)(a0 + 16 * ks), A1 = *(const pg8::bf16x8*)(a1 + 16 * ks), Bf = *(const pg8::bf16x8*)(bp + 16 * ks);
        acc0 = __builtin_amdgcn_mfma_f32_32x32x16_bf16(A0, Bf, acc0, 0, 0, 0);
        acc1 = __builtin_amdgcn_mfma_f32_32x32x16_bf16(A1, Bf, acc1, 0, 0, 0);
    }
    LAS float* part = (LAS float*)lds;
#pragma unroll
    for (int r = 0; r < 16; ++r) { const int row = (r & 3) + 8 * (r >> 2) + 4 * hi;
        part[(wave * 64 + row) * 32 + r32] = acc0[r]; part[(wave * 64 + 32 + row) * 32 + r32] = acc1[r]; }
    __syncthreads();
    float* G = (float*)(a.ws + WS_GATE);
    for (int e = tid; e < 64 * 32; e += NTHREADS) { const int row = e >> 5, j = e & 31; float s = 0.f;
#pragma unroll
        for (int w = 0; w < 8; ++w) s += part[(w * 64 + row) * 32 + j];
        float v;
        if (j < 8) v = logsigmoidf(s + a.in[IN_FOXFB][j]); else if (j < 16) v = s + a.in[IN_MIB][j - 8]; else if (j < 24) v = logsigmoidf(s + a.in[IN_MFB][j - 16]); else v = 0.f;
        G[(size_t)(64 * c + row) * 32 + j] = v; }
    __syncthreads();
}

__device__ __forceinline__ void fox_cumsum_item(const Args& a, LAS unsigned char* lds, int it) {
    const int tid = threadIdx.x, lane = tid & 63, wave = tid >> 6; const int bh = it >> 3, part = it & 7, b = bh >> 3, h = bh & 7;
    const float* G = (const float*)(a.ws + WS_GATE) + (size_t)b * SEQ * 32 + h; bf16* KB = (bf16*)(a.ws + WS_KBIAS);
    LAS float* wtot = (LAS float*)lds;
    const int s = part * 512 + tid;
    const float v = G[(size_t)s * 32];
    float pre = 0.f;
    for (int j = 0; j < part; ++j) pre += G[(size_t)(j * 512 + tid) * 32];
    const float incl = wave_scan_add(v);
    pre = wave_sum(pre);
    if (lane == 63) wtot[wave] = incl;
    if (lane == 0) wtot[8 + wave] = pre;
    __syncthreads();
    float base = 0.f;
#pragma unroll
    for (int w = 0; w < 8; ++w) { base += wtot[8 + w]; if (w < wave) base += wtot[w]; }
    const float kb2 = -(base + incl) * LOG2E;
    const unsigned h1 = f2bf(kb2); const float r1 = kb2 - bf2f(h1); const unsigned h2 = f2bf(r1); const float r2 = r1 - bf2f(h2); const unsigned h3 = f2bf(r2);
    v4u o; o.x = h1 | (h2 << 16); o.y = h3; o.z = 0u; o.w = 0u;
    *(v4u*)(KB + ((size_t)bh * SEQ + s) * 8) = o;
    if ((s & 63) == 63) ((float*)(a.ws + WS_KBND))[bh * 64 + (s >> 6)] = kb2 + 0.01f;
    __syncthreads();
}

struct ORow { pg8::f32x4 v[8]; v4u d[4]; };
__device__ __forceinline__ void orow_load(ORow& R, const float* x, const bf16* delta, int m, int lane) {
    const pg8::f32x4* xr = (const pg8::f32x4*)(x + (size_t)m * DM) + 2 * lane; const v4u* dr = (const v4u*)(delta + (size_t)m * DM) + lane;
#pragma unroll
    for (int j = 0; j < 4; ++j) { R.v[2 * j] = xr[128 * j]; R.v[2 * j + 1] = xr[128 * j + 1]; R.d[j] = dr[64 * j]; }
}
__device__ __forceinline__ void orow_store(ORow& R, const pg8::f32x4 (&g)[8], float* out, int m, int lane) {
    float s = 0.f;
#pragma unroll
    for (int j = 0; j < 4; ++j) { const v4u d = R.d[j];
        R.v[2 * j] += (pg8::f32x4){bflo(d.x), bfhi(d.x), bflo(d.y), bfhi(d.y)}; R.v[2 * j + 1] += (pg8::f32x4){bflo(d.z), bfhi(d.z), bflo(d.w), bfhi(d.w)};
        const pg8::f32x4 a0 = R.v[2 * j], a1 = R.v[2 * j + 1];
        s += ((a0[0] * a0[0] + a0[1] * a0[1]) + (a0[2] * a0[2] + a0[3] * a0[3])) + ((a1[0] * a1[0] + a1[1] * a1[1]) + (a1[2] * a1[2] + a1[3] * a1[3])); }
    const float rstd = 1.0f / sqrtf(wave_sum(s) * (1.f / DM) + NORM_EPS);
    pg8::f32x4* o = (pg8::f32x4*)(out + (size_t)m * DM) + 2 * lane;
#pragma unroll
    for (int j = 0; j < 4; ++j) { o[128 * j] = R.v[2 * j] * rstd * g[2 * j]; o[128 * j + 1] = R.v[2 * j + 1] * rstd * g[2 * j + 1]; }
}
__device__ __forceinline__ void phase_final(const Args& a, int nblk, int blk) {
    const int tid = threadIdx.x, lane = tid & 63, wave = tid >> 6; const int gw = blk * NWAVES + wave, NGW = nblk * NWAVES;
    const bf16* delta = (const bf16*)(a.ws + WS_DELTA); const float* x = a.in[IN_X];
    pg8::f32x4 g[8];
    { const pg8::f32x4* wr = (const pg8::f32x4*)a.in[IN_FINW] + 2 * lane;
#pragma unroll
      for (int j = 0; j < 4; ++j) { g[2 * j] = wr[128 * j]; g[2 * j + 1] = wr[128 * j + 1]; } }
    ORow RA, RB;
    int m = gw; orow_load(RA, x, delta, m < M_TOK ? m : M_TOK - 1, lane);
    for (; m < M_TOK; m += 2 * NGW) {
        const int mb = m + NGW, mc = m + 2 * NGW;
        orow_load(RB, x, delta, mb < M_TOK ? mb : M_TOK - 1, lane); __builtin_amdgcn_sched_barrier(0);
        orow_store(RA, g, a.out, m, lane); __builtin_amdgcn_sched_barrier(0);
        orow_load(RA, x, delta, mc < M_TOK ? mc : M_TOK - 1, lane); __builtin_amdgcn_sched_barrier(0);
        if (mb < M_TOK) orow_store(RB, g, a.out, mb, lane);
        __builtin_amdgcn_sched_barrier(0);
    }
}

namespace fox {
typedef short bf16x8 __attribute__((ext_vector_type(8)));
typedef short s16x4 __attribute__((ext_vector_type(4)));
typedef float f32x16 __attribute__((ext_vector_type(16)));
typedef unsigned u32x4 __attribute__((ext_vector_type(4)));
typedef LAS char* lptr;
constexpr int D = 128, NW = 8, QBLK = 32, KVBLK = 64, QB = NW * QBLK;
constexpr int SHM_V = KVBLK * D * 2, SHM_K = KVBLK * D * 2;
constexpr int OFF_V = 0, OFF_K = 2 * SHM_V, OFF_WS = 2 * SHM_V + 2 * SHM_K, OFF_KB = OFF_WS + NW * 64 * 4, OFF_VOTE = OFF_KB + 2 * 1024, LDS_NEED = OFF_VOTE + 64;
constexpr float THR2 = 11.5f;
#define KSWZ(row, colB) ((row) * 256 + ((colB) ^ (((row) & 7) << 4)))
#define SBAR() __builtin_amdgcn_sched_barrier(0)
__device__ __forceinline__ int v_st(int k, int c) { const int kk = (k & ~0xC) | ((k & 4) << 1) | ((k & 8) >> 1); return ((kk >> 3) * 4 + (c >> 5)) * 512 + ((kk & 7) * 32 + (c & 31)) * 2; }
__device__ __forceinline__ int v_rd_base(int lane) { return ((lane & 3) << 3) | (((lane >> 2) & 3) << 6) | (((lane >> 4) & 1) << 5) | (((lane >> 5) & 1) << 8); }
constexpr int v_rd_off(int d0, int ks, int half) { return d0 * 512 + ks * 4096 + half * 2048; }
__device__ __forceinline__ int crow(int r, int hi) { return (r & 3) + 8 * (r >> 2) + 4 * hi; }
__device__ __forceinline__ unsigned cvtpk(float lo, float hi) { return pk2(lo, hi); }
__device__ __forceinline__ void mask_tile(f32x16& p0, f32x16& p1, int dq) {
    const float NEG = -__builtin_inff();
#pragma unroll
    for (int r = 0; r < 16; ++r) { const int c = (r & 3) + 8 * (r >> 2);
        if (dq - c < 0) p0[r] = NEG;
        if (dq - c - 32 < 0) p1[r] = NEG; }
}
__device__ __forceinline__ void partialSM(f32x16& p0, f32x16& p1, float& m_reg, float& mn, float& alpha) {
    float pmax = p0[0];
#pragma unroll
    for (int r = 1; r < 16; ++r) pmax = fmaxf(pmax, p0[r]);
#pragma unroll
    for (int r = 0; r < 16; ++r) pmax = fmaxf(pmax, p1[r]);
    { auto rr = __builtin_amdgcn_permlane32_swap(__float_as_uint(pmax), __float_as_uint(pmax), false, false);
      pmax = fmaxf(__uint_as_float(rr[0]), __uint_as_float(rr[1])); }
    if (__builtin_expect(__all((pmax - m_reg) <= THR2), 1)) { mn = m_reg; alpha = 1.f; }
    else { mn = fmaxf(m_reg, pmax); alpha = __builtin_amdgcn_exp2f(m_reg - mn); m_reg = mn; }
#pragma unroll
    for (int r = 0; r < 16; ++r) p0[r] = p0[r] - mn;
#pragma unroll
    for (int r = 0; r < 16; ++r) p1[r] = p1[r] - mn;
#pragma unroll
    for (int r = 0; r < 16; ++r) p0[r] = __builtin_amdgcn_exp2f(p0[r]);
}
__device__ __forceinline__ void finishSM(f32x16& p0, f32x16& p1, float alpha, float& l_reg, bf16x8& pa0, bf16x8& pa1, bf16x8& pa2, bf16x8& pa3) {
#pragma unroll
    for (int r = 0; r < 16; ++r) p1[r] = __builtin_amdgcn_exp2f(p1[r]);
    float ps = 0;
#pragma unroll
    for (int r = 0; r < 16; ++r) ps += p0[r];
#pragma unroll
    for (int r = 0; r < 16; ++r) ps += p1[r];
    { auto rr = __builtin_amdgcn_permlane32_swap(__float_as_uint(ps), __float_as_uint(ps), false, false);
      ps = __uint_as_float(rr[0]) + __uint_as_float(rr[1]); }
    l_reg = l_reg * alpha + ps;
#define PK4(P, B_, OUT) do { unsigned a0 = cvtpk(P[B_+0], P[B_+1]), a1 = cvtpk(P[B_+2], P[B_+3]);                          \
        unsigned b0 = cvtpk(P[B_+4], P[B_+5]), b1 = cvtpk(P[B_+6], P[B_+7]);                                             \
        auto r0 = __builtin_amdgcn_permlane32_swap(a0, b0, false, false); auto r1 = __builtin_amdgcn_permlane32_swap(a1, b1, false, false); \
        u32x4 w = {r0[0], r1[0], r0[1], r1[1]}; OUT = __builtin_bit_cast(bf16x8, w); } while (0)
    PK4(p0, 0, pa0); PK4(p0, 8, pa1); PK4(p1, 0, pa2); PK4(p1, 8, pa3);
#undef PK4
}
template <int KB>
__device__ __forceinline__ void qkt(f32x16& p0, f32x16& p1, lptr lds, int r32, int hi, const bf16x8* qr, bf16x8 qone) {
    p0 = f32x16{}; p1 = f32x16{};
    __builtin_amdgcn_s_setprio(1);
    lptr kb[4];
#pragma unroll
    for (int dd = 0; dd < 4; ++dd) kb[dd] = lds + OFF_K + KB * SHM_K + KSWZ(r32, (dd * 16 + hi * 8) * 2);
#pragma unroll
    for (int d0 = 0; d0 < 8; ++d0) { lptr a = kb[d0 & 3] + (d0 >> 2) * 128;
        bf16x8 b0 = *(const LAS bf16x8*)(a);
        bf16x8 b1 = *(const LAS bf16x8*)(a + 32 * 256);
        p0 = __builtin_amdgcn_mfma_f32_32x32x16_bf16(b0, qr[d0], p0, 0, 0, 0);
        p1 = __builtin_amdgcn_mfma_f32_32x32x16_bf16(b1, qr[d0], p1, 0, 0, 0); }
    { lptr a = lds + OFF_KB + KB * 1024 + r32 * 16;
        bf16x8 b0 = *(const LAS bf16x8*)(a);
        bf16x8 b1 = *(const LAS bf16x8*)(a + 512);
        p0 = __builtin_amdgcn_mfma_f32_32x32x16_bf16(b0, qone, p0, 0, 0, 0);
        p1 = __builtin_amdgcn_mfma_f32_32x32x16_bf16(b1, qone, p1, 0, 0, 0); }
    __builtin_amdgcn_s_setprio(0);
}
template <int VB>
__device__ __forceinline__ void pv_tile(f32x16* o, int vb0, bf16x8 pa0, bf16x8 pa1, bf16x8 pa2, bf16x8 pa3) {
#define TRRD(dst, off) asm volatile("ds_read_b64_tr_b16 %0, %1 offset:%2" : "=&v"(dst) : "v"(vb0), "i"(off) : "memory")
#define PV_D0(d0) do { s16x4 l0, l1, l2, l3, h0, h1, h2, h3; constexpr int b_ = OFF_V + VB * SHM_V + v_rd_off(d0, 0, 0); \
        TRRD(l0, b_); TRRD(h0, b_ + 2048); TRRD(l1, b_ + 4096); TRRD(h1, b_ + 6144); TRRD(l2, b_ + 8192); TRRD(h2, b_ + 10240); TRRD(l3, b_ + 12288); TRRD(h3, b_ + 14336); \
        asm volatile("s_waitcnt lgkmcnt(0)" ::: "memory"); SBAR();   \
        o[d0] = __builtin_amdgcn_mfma_f32_32x32x16_bf16(pa0, (bf16x8){l0[0], l0[1], l0[2], l0[3], h0[0], h0[1], h0[2], h0[3]}, o[d0], 0, 0, 0);   \
        o[d0] = __builtin_amdgcn_mfma_f32_32x32x16_bf16(pa1, (bf16x8){l1[0], l1[1], l1[2], l1[3], h1[0], h1[1], h1[2], h1[3]}, o[d0], 0, 0, 0);   \
        o[d0] = __builtin_amdgcn_mfma_f32_32x32x16_bf16(pa2, (bf16x8){l2[0], l2[1], l2[2], l2[3], h2[0], h2[1], h2[2], h2[3]}, o[d0], 0, 0, 0);   \
        o[d0] = __builtin_amdgcn_mfma_f32_32x32x16_bf16(pa3, (bf16x8){l3[0], l3[1], l3[2], l3[3], h3[0], h3[1], h3[2], h3[3]}, o[d0], 0, 0, 0); } while (0)
    __builtin_amdgcn_s_setprio(1); PV_D0(0); PV_D0(1); PV_D0(2); PV_D0(3); __builtin_amdgcn_s_setprio(0);
#undef PV_D0
#undef TRRD
}
struct BlockRef { const bf16* Q; const bf16* K; const bf16* V; const bf16* KB; const float* ksuf; const float* kbnd; int P0; int tok0; int h; };
struct Seam { bf16x8 qr[8]; bf16x8 st_v0, st_v1, st_k0, st_k1; u32x4 st_kb; };
#define VMW() asm volatile("s_waitcnt vmcnt(0)" ::: "memory")
#define BL128(rs, vo, so) __builtin_bit_cast(bf16x8, __builtin_amdgcn_raw_buffer_load_b128(rs, (int)(vo), (int)(so), 0))
#define SLOAD_H(k0) do { const int so_ = (k0) * 256; S.st_v0 = BL128(rsV, voffKV, so_); S.st_v1 = BL128(rsV, voffKV, so_ + 8192);              \
                         S.st_k0 = BL128(rsK, voffKV, so_); S.st_k1 = BL128(rsK, voffKV, so_ + 8192); \
                         S.st_kb = __builtin_amdgcn_raw_buffer_load_b128(rsB, lane * 16, (k0) * 16, 0); } while (0)
#define SWRITE_HK(bf) do { *(LAS bf16x8*)(lds + OFF_K + (bf) * SHM_K + kws) = S.st_k0; *(LAS bf16x8*)(lds + OFF_K + (bf) * SHM_K + kws + 32 * 256) = S.st_k1; \
                         if (wid == 0) *(LAS u32x4*)(lds + OFF_KB + (bf) * 1024 + lane * 16) = S.st_kb; } while (0)
#define SWRITE_HV(bf) do { *(LAS bf16x8*)(lds + OFF_V + (bf) * SHM_V + vst0) = S.st_v0; *(LAS bf16x8*)(lds + OFF_V + (bf) * SHM_V + vst1) = S.st_v1; } while (0)
#define SWRITE_H(bf) do { SWRITE_HV(bf); SWRITE_HK(bf); } while (0)
__device__ __forceinline__ __amdgpu_buffer_rsrc_t mk_rsrc(const void* p, unsigned bytes) {
    const unsigned long long v = (unsigned long long)p; const unsigned lo = __builtin_amdgcn_readfirstlane((unsigned)v), hi = __builtin_amdgcn_readfirstlane((unsigned)(v >> 32));
    return __builtin_amdgcn_make_buffer_rsrc((void*)(((unsigned long long)hi << 32) | lo), 0, bytes, 0x00020000);
}
struct EpiParams { const float* g; const bf16* FZ; bf16* Y; };
__device__ __forceinline__ void block(const BlockRef& cur, lptr lds, const EpiParams& E, unsigned* ctr, int blk, LAS int* slot) {
    Seam S;
    const int tid = threadIdx.x, wid = __builtin_amdgcn_readfirstlane(tid >> 6), lane = tid & 63, r32 = lane & 31, hi = lane >> 5;
    const int NT = (cur.P0 + QB) / KVBLK;
    int NTe = NT;
    LAS int* vote = (LAS int*)(lds + OFF_VOTE);
    const int qlo = cur.P0 + wid * QBLK, qm = qlo + r32 - 4 * hi;
    LAS float* ws = (LAS float*)(lds + OFF_WS) + wid * 64; LAS float* li_l = ws; LAS float* al_l = ws + 32;
    float m_reg = -1e30f, l_reg = 0; f32x16 o[4] = {};
    const int sr = tid >> 4, sc = (tid & 15) * 8, vst0 = v_st(sr, sc), vst1 = v_st(32 + sr, sc), kws = KSWZ(sr, sc * 2);
    const int vb0 = (int)(uintptr_t)(lds) + v_rd_base(lane);
    const __amdgpu_buffer_rsrc_t rsK = mk_rsrc(cur.K, SEQ * 256), rsV = mk_rsrc(cur.V, SEQ * 256), rsB = mk_rsrc(cur.KB, SEQ * 16), rsQ = mk_rsrc(cur.Q, QB * 256);
    const int voffKV = (sr * D + sc) * 2;
    bf16x8 qone; { u32x4 w = {hi ? 0u : 0x3F803F80u, hi ? 0u : 0x00003F80u, 0u, 0u}; qone = __builtin_bit_cast(bf16x8, w); }
#define RESC(a) do { if (__any((a) < 1.f)) { if (hi == 0) al_l[r32] = (a); asm volatile("s_waitcnt lgkmcnt(0)" ::: "memory");              \
                     _Pragma("unroll") for (int d_ = 0; d_ < 4; ++d_) _Pragma("unroll") for (int r = 0; r < 16; ++r) o[d_][r] *= al_l[crow(r, hi)]; } } while (0)
#define KBASE(t) ((NT - 1 - (t)) * KVBLK)
#define MASKT(P0_, P1_, t) do { const int kb_ = KBASE(t); if (kb_ + KVBLK - 1 > qlo) mask_tile(P0_, P1_, qm - kb_); } while (0)
    f32x16 pA0, pA1, pB0, pB1; float mnA, mnB, alA, alB; bf16x8 pa0, pa1, pa2, pa3;
    { const int voffQ = ((wid * QBLK + r32) * D + hi * 8) * 2;
#pragma unroll
      for (int d0 = 0; d0 < 8; ++d0) S.qr[d0] = BL128(rsQ, voffQ, d0 * 32); }
    float qn;
    { float ssq = 0.f;
#pragma unroll
      for (int d0 = 0; d0 < 8; ++d0) { const u32x4 w = __builtin_bit_cast(u32x4, S.qr[d0]);
          ssq += (bflo(w.x) * bflo(w.x) + bfhi(w.x) * bfhi(w.x)) + (bflo(w.y) * bflo(w.y) + bfhi(w.y) * bfhi(w.y)) + (bflo(w.z) * bflo(w.z) + bfhi(w.z) * bfhi(w.z)) + (bflo(w.w) * bflo(w.w) + bfhi(w.w) * bfhi(w.w)); }
      auto rr = __builtin_amdgcn_permlane32_swap(__float_as_uint(ssq), __float_as_uint(ssq), false, false);
      qn = sqrtf(__uint_as_float(rr[0]) + __uint_as_float(rr[1])) * 1.001f; }
    SLOAD_H(KBASE(0)); VMW(); SWRITE_HK(0);
    __syncthreads();
    SWRITE_HV(0); SBAR();
    SLOAD_H(KBASE(1));
    SBAR(); qkt<0>(pA0, pA1, lds, r32, hi, S.qr, qone);
    MASKT(pA0, pA1, 0); partialSM(pA0, pA1, m_reg, mnA, alA);
    VMW(); SWRITE_H(1);
    __syncthreads();
#define HALF_STEP(PX0, PX1, mnX, alX, PY0, PY1, alY, t, KB, VB, SB, VOTE) do {                                                      \
        SBAR(); qkt<KB>(PX0, PX1, lds, r32, hi, S.qr, qone);                                             \
        finishSM(PY0, PY1, alY, l_reg, pa0, pa1, pa2, pa3); SBAR();                                                           \
        if ((t) + 1 < NTe) { SLOAD_H(KBASE((t) + 1)); SBAR(); }                                               \
        pv_tile<VB>(o, vb0, pa0, pa1, pa2, pa3); MASKT(PX0, PX1, (t)); partialSM(PX0, PX1, m_reg, mnX, alX);                                        \
        const int jj_ = NT - 1 - ((t) + 2);                                                                                   \
        if (VOTE && jj_ >= 0) { const bool sk_ = __all(qn * cur.ksuf[jj_] + cur.kbnd[jj_] - m_reg < -152.f); if (lane == 0) vote[wid] = sk_ ? 1 : 0; }                      \
        __syncthreads();                                                                                                      \
        if ((t) + 1 < NTe) { VMW(); SWRITE_H(SB); }                                                                          \
        if (VOTE && jj_ >= 0) { const int v_ = vote[lane & 7]; if (__all(v_ != 0)) NTe = (t) + 2; }                                          \
        RESC(alX); __syncthreads(); } while (0)
    for (int t = 1; t + 1 < NTe; t += 2) {
        HALF_STEP(pB0, pB1, mnB, alB, pA0, pA1, alA, t, 1, 0, 0, false);
        HALF_STEP(pA0, pA1, mnA, alA, pB0, pB1, alB, t + 1, 0, 1, 1, true);
    }
    SBAR(); qkt<1>(pB0, pB1, lds, r32, hi, S.qr, qone); SBAR();
    finishSM(pA0, pA1, alA, l_reg, pa0, pa1, pa2, pa3); SBAR();
    pv_tile<0>(o, vb0, pa0, pa1, pa2, pa3);
    MASKT(pB0, pB1, NTe - 1); partialSM(pB0, pB1, m_reg, mnB, alB); __syncthreads(); RESC(alB);
    finishSM(pB0, pB1, alB, l_reg, pa0, pa1, pa2, pa3); SBAR(); pv_tile<1>(o, vb0, pa0, pa1, pa2, pa3);
    SBAR();
    if (tid == 0) { int it_ = -1;
        for (int k_ = 0; k_ < 8; ++k_) { const int q_ = (blk + k_) & 7; const unsigned i_ = atomicAdd(&ctr[q_ * 64], 1u); if (i_ < 64u) { it_ = q_ * 64 + (int)i_; break; } }
        *slot = it_; }
    if (hi == 0) li_l[r32] = l_reg; asm volatile("s_waitcnt lgkmcnt(0)" ::: "memory");
    {
        LAS float* stg = (LAS float*)(lds + OFF_K) + wid * 1024;
        int lane_o = lane; asm volatile("" : "+v"(lane_o));
        const int erow = lane_o >> 3, seg = lane_o & 7;
        const float* gp = E.g + cur.h * 128 + seg * 16;
        pg8::f32x4 g4[4];
#pragma unroll
        for (int j = 0; j < 4; ++j) g4[j] = *(const pg8::f32x4*)(gp + 4 * j);
        const unsigned trow = (unsigned)(cur.tok0 + wid * QBLK);
#pragma unroll
        for (int p = 0; p < 4; ++p) {
            const unsigned tokr = trow + 8u * p + (unsigned)erow;
            const bf16* zp = E.FZ + (tokr * 1024u + (unsigned)(cur.h * 128 + seg * 16));
            const u32x4 z0 = *(const u32x4*)zp, z1 = *(const u32x4*)(zp + 8);
#pragma unroll
            for (int rr = 0; rr < 4; ++rr) { const int r = 4 * p + rr; const float rl = __builtin_amdgcn_rcpf(li_l[crow(r, hi)]);
#pragma unroll
                for (int d0 = 0; d0 < 4; ++d0) stg[(rr + 4 * hi) * 128 + d0 * 32 + r32] = o[d0][r] * rl; }
            asm volatile("s_waitcnt lgkmcnt(0)" ::: "memory");
            float x[16]; float ss = 0.f;
#pragma unroll
            for (int j = 0; j < 4; ++j) { const pg8::f32x4 v = *(const LAS pg8::f32x4*)(stg + erow * 128 + seg * 16 + 4 * j); x[4 * j] = v[0]; x[4 * j + 1] = v[1]; x[4 * j + 2] = v[2]; x[4 * j + 3] = v[3];
                ss += (v[0] * v[0] + v[1] * v[1]) + (v[2] * v[2] + v[3] * v[3]); }
            asm volatile("s_waitcnt lgkmcnt(0)" ::: "memory");
            ss += __shfl_xor(ss, 1); ss += __shfl_xor(ss, 2); ss += __shfl_xor(ss, 4);
            const float rs = 1.0f / sqrtf(ss * (1.f / 128.f) + NORM_EPS);
            float zf[16]; zf[0] = bflo(z0.x); zf[1] = bfhi(z0.x); zf[2] = bflo(z0.y); zf[3] = bfhi(z0.y); zf[4] = bflo(z0.z); zf[5] = bfhi(z0.z); zf[6] = bflo(z0.w); zf[7] = bfhi(z0.w);
            zf[8] = bflo(z1.x); zf[9] = bfhi(z1.x); zf[10] = bflo(z1.y); zf[11] = bfhi(z1.y); zf[12] = bflo(z1.z); zf[13] = bfhi(z1.z); zf[14] = bflo(z1.w); zf[15] = bfhi(z1.w);
            float y[16];
#pragma unroll
            for (int e = 0; e < 16; ++e) y[e] = x[e] * rs * g4[e >> 2][e & 3] * (zf[e] * __builtin_amdgcn_rcpf(1.f + __builtin_amdgcn_exp2f(-zf[e] * LOG2E)));
            u32x4 o0, o1; o0.x = cvtpk(y[0], y[1]); o0.y = cvtpk(y[2], y[3]); o0.z = cvtpk(y[4], y[5]); o0.w = cvtpk(y[6], y[7]);
            o1.x = cvtpk(y[8], y[9]); o1.y = cvtpk(y[10], y[11]); o1.z = cvtpk(y[12], y[13]); o1.w = cvtpk(y[14], y[15]);
            bf16* yp = E.Y + (tokr * 2048u + (unsigned)(cur.h * 128 + seg * 16));
            *(u32x4*)yp = o0; *(u32x4*)(yp + 8) = o1;
        }
    }
    __syncthreads();
#undef RESC
#undef KBASE
#undef MASKT
#undef HALF_STEP
}
#undef VMW
#undef BL128
#undef SLOAD_H
#undef SWRITE_HK
#undef SWRITE_HV
#undef SWRITE_H
#undef KSWZ
#undef SBAR
__device__ __forceinline__ BlockRef make_ref(const Args& a, int bh, int qb) {
    BlockRef r; const size_t hb = (size_t)bh * SEQ * 128;
    r.Q = (const bf16*)(a.ws + WS_SEC + SEC_FQ * SEC_BYTES) + hb + (size_t)qb * QB * 128;
    r.K = (const bf16*)(a.ws + WS_SEC + SEC_FK * SEC_BYTES) + hb; r.V = (const bf16*)(a.ws + WS_SEC + SEC_FV * SEC_BYTES) + hb;
    r.KB = (const bf16*)(a.ws + WS_KBIAS) + (size_t)bh * SEQ * 8;
    r.ksuf = (const float*)(a.ws + WS_KSUF) + bh * 64; r.kbnd = (const float*)(a.ws + WS_KBND) + bh * 64;
    r.P0 = qb * QB; r.tok0 = (bh >> 3) * SEQ + qb * QB; r.h = bh & 7; return r;
}
__device__ __forceinline__ void phase(const Args& a, lptr lds, int nblk, int blk) {
    const EpiParams E{a.in[IN_FOXNW], (const bf16*)(a.ws + WS_SEC + SEC_FZ * SEC_BYTES), (bf16*)(a.ws + WS_Y)};
    unsigned* ctr = (unsigned*)(a.ws + WS_CTL) + 1024; LAS int* slot = (LAS int*)(lds + OFF_VOTE + 32);
    if (threadIdx.x == 0) { int item = -1;
        for (int k = 0; k < 8; ++k) { const int q = (blk + k) & 7; const unsigned i = atomicAdd(&ctr[q * 64], 1u); if (i < 64u) { item = q * 64 + (int)i; break; } }
        *slot = item; }
    __syncthreads();
    for (;;) {
        const int item = __builtin_amdgcn_readfirstlane(*slot);
        if (item < 0) break;
        const int q = item >> 6, i = item & 63, qb = 15 - ((i & 31) >> 1), sl = 2 * (i >> 5) + (i & 1);
        const int h = (((q & 1) ? 0x7421 : 0x6530) >> (4 * sl)) & 0xF, bh = (q >> 1) * 8 + h;
        const BlockRef cur = make_ref(a, bh, qb);
        block(cur, lds, E, ctr, blk, slot);
    }
    __syncthreads();
}
__device__ __forceinline__ void knorm_pass(const Args& a, int nblk, int blk) {
    const int tid = threadIdx.x, lane = tid & 63, wave = tid >> 6; const int gw = blk * NW + wave, NGW = nblk * NW;
    const bf16* FK = (const bf16*)(a.ws + WS_SEC + SEC_FK * SEC_BYTES); float* KN = (float*)(a.ws + WS_KNRM);
    for (int it = gw; it < BATCH * NH * 64; it += NGW) {
        const u32x4* kr = (const u32x4*)(FK + (size_t)it * 64 * 128) + lane;
        u32x4 w[16];
#pragma unroll
        for (int c = 0; c < 16; ++c) w[c] = kr[64 * c];
        float mx = 0.f;
#pragma unroll
        for (int c = 0; c < 16; ++c) { const u32x4 v = w[c];
            float ss = (bflo(v.x) * bflo(v.x) + bfhi(v.x) * bfhi(v.x)) + (bflo(v.y) * bflo(v.y) + bfhi(v.y) * bfhi(v.y)) + (bflo(v.z) * bflo(v.z) + bfhi(v.z) * bfhi(v.z)) + (bflo(v.w) * bflo(v.w) + bfhi(v.w) * bfhi(v.w));
            ss += __shfl_xor(ss, 1); ss += __shfl_xor(ss, 2); ss += __shfl_xor(ss, 4); ss += __shfl_xor(ss, 8);
            mx = fmaxf(mx, ss); }
        mx = fmaxf(mx, __shfl_xor(mx, 16)); mx = fmaxf(mx, __shfl_xor(mx, 32));
        if (lane == 0) KN[it] = sqrtf(mx) * 1.001f;
    }
}
__device__ __forceinline__ void ksuf_pass(const Args& a, int nblk, int blk) {
    const int tid = threadIdx.x, lane = tid & 63;
    if (tid < 64) for (int bh = blk; bh < BATCH * NH; bh += nblk) {
        float v = ((const float*)(a.ws + WS_KNRM))[bh * 64 + lane];
#pragma unroll
        for (int o = 1; o < 64; o <<= 1) { const float t = __shfl_up(v, o); if (lane >= o) v = fmaxf(v, t); }
        ((float*)(a.ws + WS_KSUF))[bh * 64 + lane] = v; }
}
}

namespace ml {
typedef short bf16x8 __attribute__((ext_vector_type(8)));
typedef short s16x4 __attribute__((ext_vector_type(4)));
typedef float f32x16 __attribute__((ext_vector_type(16)));
typedef unsigned u32x4 __attribute__((ext_vector_type(4)));
typedef LAS char* lptr;
constexpr int ROWP = 144;
__device__ __forceinline__ int crow(int r, int hi) { return (r & 3) + 8 * (r >> 2) + 4 * hi; }
__device__ __forceinline__ int t_st(int k, int c) { const int kk = (k & ~0xC) | ((k & 4) << 1) | ((k & 8) >> 1); return ((kk >> 3) * 4 + (c >> 5)) * 512 + ((kk & 7) * 32 + (c & 31)) * 2; }
__device__ __forceinline__ int t_rd_base(int lane) { return ((lane & 3) << 3) | (((lane >> 2) & 3) << 6) | (((lane >> 4) & 1) << 5) | (((lane >> 5) & 1) << 8); }
#define TRFRAG(dst, addr, ks) do { s16x4 l_, h_; asm volatile("ds_read_b64_tr_b16 %0, %1 offset:%2" : "=&v"(l_) : "v"(addr), "i"((ks) * 4096) : "memory"); \
        asm volatile("ds_read_b64_tr_b16 %0, %1 offset:%2" : "=&v"(h_) : "v"(addr), "i"((ks) * 4096 + 2048) : "memory"); \
        asm volatile("s_waitcnt lgkmcnt(0)" ::: "memory"); __builtin_amdgcn_sched_barrier(0); \
        dst = (bf16x8){l_[0], l_[1], l_[2], l_[3], h_[0], h_[1], h_[2], h_[3]}; } while (0)
__device__ __forceinline__ void unpack8(const u32x4 r, float* f) { f[0] = bflo(r.x); f[1] = bfhi(r.x); f[2] = bflo(r.y); f[3] = bfhi(r.y); f[4] = bflo(r.z); f[5] = bfhi(r.z); f[6] = bflo(r.w); f[7] = bfhi(r.w); }

__device__ __forceinline__ float fexp(float x) { return __builtin_amdgcn_exp2f(x * LOG2E); }
__device__ __forceinline__ float fsigmoid(float x) { return __builtin_amdgcn_rcpf(1.f + fexp(-x)); }
__device__ __forceinline__ float rdlane63(float v) { return __builtin_bit_cast(float, __builtin_amdgcn_readlane(__builtin_bit_cast(int, v), 63)); }
struct M1Pre { u32x4 raw[5]; u32x4 vr[2]; pg8::f32x4 cw[8]; pg8::f32x4 cb[2]; float lf, ig; };
__device__ __forceinline__ void m1_load(const Args& a, int g, M1Pre& P) {
    const int tid = threadIdx.x; const int bh = g >> 6, c = g & 63, b = bh >> 3, h = bh & 7; const int s0 = c * 64, tok0 = b * SEQ + s0;
    const int cgp = tid & 15, trow = tid >> 4, tA = 2 * trow; const int ch = (cgp >= 8 ? 512 : 0) + h * 64 + (cgp & 7) * 8;
    const bf16* MQK = (const bf16*)(a.ws + WS_SEC + SEC_MQK * SEC_BYTES);
#pragma unroll
    for (int j = 0; j < 5; ++j) { const int s = s0 + tA - 3 + j; P.raw[j] = *(const u32x4*)(MQK + (size_t)(tok0 + tA - 3 + j + (s < 0 ? 3 : 0)) * 1024 + ch); }
    const bf16* MV = (const bf16*)(a.ws + WS_SEC + SEC_MV * SEC_BYTES);
#pragma unroll
    for (int i = 0; i < 2; ++i) { const int ci = tid + 512 * i, s = ci >> 4, vc = (ci & 15) * 8; P.vr[i] = *(const u32x4*)(MV + (size_t)(tok0 + s) * 1024 + h * 128 + vc); }
    const float* cw = a.in[IN_CONVW] + ch; const float* cb = a.in[IN_CONVB] + ch;
#pragma unroll
    for (int j = 0; j < 4; ++j) { P.cw[2 * j] = *(const pg8::f32x4*)(cw + j * 1024); P.cw[2 * j + 1] = *(const pg8::f32x4*)(cw + j * 1024 + 4); }
    P.cb[0] = *(const pg8::f32x4*)cb; P.cb[1] = *(const pg8::f32x4*)(cb + 4);
    if (tid < 64) { const float* G = (const float*)(a.ws + WS_GATE); P.lf = G[(size_t)(tok0 + tid) * 32 + 16 + h]; P.ig = G[(size_t)(tok0 + tid) * 32 + 8 + h]; }
}
__device__ __forceinline__ void m1_phase(const Args& a, lptr lds, int nblk, int blk) {
    const int tid = threadIdx.x, lane = tid & 63, wid = __builtin_amdgcn_readfirstlane(tid >> 6), r32 = lane & 31, hi = lane >> 5;
    constexpr int NITEM = BATCH * NH * NCHUNK;
    LAS float* wgt = (LAS float*)(lds + 49152); LAS float* npart = (LAS float*)(lds + 49408);
    int g = blk; if (g >= NITEM) return;
    M1Pre P; m1_load(a, g, P);
    const int cgp = tid & 15, trow = tid >> 4, tA = 2 * trow; const bool isk = cgp >= 8; const int d0 = (cgp & 7) * 8;
    int par = 0;
    for (;;) {
        const int bh = g >> 6, c = g & 63, b = bh >> 3, h = bh & 7; const int s0 = c * 64; (void)b; (void)h;
        const int KOFF = 16384 + par * 16384;
        if (wid == 0) {
            const float bc = wave_scan_add(P.lf);
            const float bl = rdlane63(bc), w = bl - bc + P.ig, amax = rdlane63(wave_scan_max(w));
            wgt[lane] = fexp(w - amax);
            float* MST = (float*)(a.ws + WS_MST);
            if (lane == 0) { MST[(size_t)g * 4 + 0] = amax; MST[(size_t)g * 4 + 1] = bl; }
            const float u = P.ig - bc; const float gm = wave_scan_max(u);
            float* GV = (float*)(a.ws + WS_GV) + (size_t)g * 192; GV[lane] = bc; GV[64 + lane] = gm; GV[128 + lane] = u;
        }
        float yA[8], yB[8];
        {
            float u[5][8];
#pragma unroll
            for (int j = 0; j < 5; ++j) { unpack8(P.raw[j], u[j]); if (s0 + tA - 3 + j < 0) {
#pragma unroll
                for (int e = 0; e < 8; ++e) u[j][e] = 0.f; } }
            const float osc = isk ? 0.125f : 1.f;
#pragma unroll
            for (int e = 0; e < 8; ++e) { const float w0 = P.cw[e >> 2][e & 3], w1 = P.cw[2 + (e >> 2)][e & 3], w2 = P.cw[4 + (e >> 2)][e & 3], w3 = P.cw[6 + (e >> 2)][e & 3], bb = P.cb[e >> 2][e & 3];
                float sA = u[0][e] * w0; sA += u[1][e] * w1; sA += u[2][e] * w2; sA += u[3][e] * w3; sA += bb;
                float sB = u[1][e] * w0; sB += u[2][e] * w1; sB += u[3][e] * w2; sB += u[4][e] * w3; sB += bb;
                yA[e] = sA * fsigmoid(sA) * osc; yB[e] = sB * fsigmoid(sB) * osc; }
            u32x4 oA, oB; oA.x = pk2(yA[0], yA[1]); oA.y = pk2(yA[2], yA[3]); oA.z = pk2(yA[4], yA[5]); oA.w = pk2(yA[6], yA[7]);
            oB.x = pk2(yB[0], yB[1]); oB.y = pk2(yB[2], yB[3]); oB.z = pk2(yB[4], yB[5]); oB.w = pk2(yB[6], yB[7]);
            bf16* dst = (bf16*)(a.ws + (isk ? WS_KC : WS_QC)) + ((size_t)bh * SEQ + s0 + tA) * 64 + d0;
            *(u32x4*)dst = oA; *(u32x4*)(dst + 64) = oB;
            if (isk) { *(LAS u32x4*)(lds + KOFF + t_st(tA, d0)) = oA; *(LAS u32x4*)(lds + KOFF + t_st(tA + 1, d0)) = oB;
                float fa[8], fb[8]; unpack8(oA, fa); unpack8(oB, fb);
#pragma unroll
                for (int e = 0; e < 8; ++e) { yA[e] = fa[e]; yB[e] = fb[e]; } }
        }
        const u32x4 vr0 = P.vr[0], vr1 = P.vr[1];
        const int gnext = g + nblk; const bool more = gnext < NITEM;
        m1_load(a, more ? gnext : g, P);
        __syncthreads();
        {   const float wA = wgt[tA], wB = wgt[tA + 1];
#pragma unroll
            for (int e = 0; e < 8; ++e) { float p = isk ? (wA * yA[e] + wB * yB[e]) : 0.f; p += __shfl_xor(p, 16); p += __shfl_xor(p, 32); if (lane >= 8 && lane < 16) npart[wid * 64 + d0 + e] = p; }
#pragma unroll
            for (int i = 0; i < 2; ++i) { const int ci = tid + 512 * i, s = ci >> 4, vc = (ci & 15) * 8; const float ws_ = wgt[s]; float f[8]; unpack8(i ? vr1 : vr0, f);
                u32x4 o; o.x = pk2(f[0] * ws_, f[1] * ws_); o.y = pk2(f[2] * ws_, f[3] * ws_); o.z = pk2(f[4] * ws_, f[5] * ws_); o.w = pk2(f[6] * ws_, f[7] * ws_);
                *(LAS u32x4*)(lds + t_st(s, vc)) = o; } }
        __syncthreads();
        {
            const int vb = wid & 3, db = wid >> 2;
            const int va = (int)(uintptr_t)lds + t_rd_base(lane) + vb * 512, ka = (int)(uintptr_t)lds + KOFF + t_rd_base(lane) + db * 512;
            f32x16 acc = {};
            bf16x8 A, Bf;
            TRFRAG(A, va, 0); TRFRAG(Bf, ka, 0); acc = __builtin_amdgcn_mfma_f32_32x32x16_bf16(A, Bf, acc, 0, 0, 0);
            TRFRAG(A, va, 1); TRFRAG(Bf, ka, 1); acc = __builtin_amdgcn_mfma_f32_32x32x16_bf16(A, Bf, acc, 0, 0, 0);
            TRFRAG(A, va, 2); TRFRAG(Bf, ka, 2); acc = __builtin_amdgcn_mfma_f32_32x32x16_bf16(A, Bf, acc, 0, 0, 0);
            TRFRAG(A, va, 3); TRFRAG(Bf, ka, 3); acc = __builtin_amdgcn_mfma_f32_32x32x16_bf16(A, Bf, acc, 0, 0, 0);
            bf16* KL = (bf16*)(a.ws + WS_KLOC) + (size_t)g * 8192;
#pragma unroll
            for (int r = 0; r < 16; ++r) { const float nb = __shfl_xor(acc[r], 1); if ((r32 & 1) == 0) *(unsigned*)(KL + (vb * 32 + crow(r, hi)) * 64 + db * 32 + r32) = pk2(acc[r], nb); }
        }
        if (tid < 64) { float n = 0.f;
#pragma unroll
            for (int w = 0; w < 8; ++w) n += npart[w * 64 + tid];
            ((float*)(a.ws + WS_NLOC))[(size_t)g * 64 + tid] = n; }
        if (!more) break;
        g = gnext; par ^= 1;
    }
    __syncthreads();
}

__device__ __forceinline__ float rdlane(float v, int l) { return __builtin_bit_cast(float, __builtin_amdgcn_readlane(__builtin_bit_cast(int, v), l)); }
__device__ __forceinline__ void m2_scan(const Args& a, int nblk, int blk) {
    const int tid = threadIdx.x, lane = tid & 63;
    for (int vb = blk; vb < 256; vb += nblk) {
        const int bh = vb >> 3, e0 = ((vb & 7) * 512 + tid) * 2;
        const unsigned* KL = (const unsigned*)((const bf16*)(a.ws + WS_KLOC) + (size_t)bh * 64 * 8192 + e0); unsigned* CP = (unsigned*)((bf16*)(a.ws + WS_CPREV) + (size_t)bh * 64 * 8192 + e0);
        const float* NL = (const float*)(a.ws + WS_NLOC) + (size_t)bh * 64 * 64 + 2 * tid; float* NP = (float*)(a.ws + WS_NPREV) + (size_t)bh * 64 * 64 + 2 * tid;
        float* MST = (float*)(a.ws + WS_MST) + (size_t)bh * 64 * 4;
        const bool do_n = ((vb & 7) == 0) && tid < 32, do_m = ((vb & 7) == 0) && tid == 0;
        const float2 ab = *(const float2*)(MST + lane * 4);
        float c0 = 0.f, c1 = 0.f, n0 = 0.f, n1 = 0.f, m = 0.f;
#pragma unroll
        for (int cb = 0; cb < 64; cb += 32) {
            unsigned kl[32]; float2 nl[32];
#pragma unroll
            for (int j = 0; j < 32; ++j) kl[j] = KL[(size_t)(cb + j) * 4096];
            if (do_n) {
#pragma unroll
                for (int j = 0; j < 32; ++j) nl[j] = *(const float2*)(NL + (cb + j) * 64); }
#pragma unroll
            for (int j = 0; j < 32; ++j) {
                const float am = rdlane(ab.x, cb + j), bl = rdlane(ab.y, cb + j);
                CP[(size_t)(cb + j) * 4096] = pk2(c0, c1);
                if (do_n) *(float2*)(NP + (cb + j) * 64) = make_float2(n0, n1);
                if (do_m) MST[(cb + j) * 4 + 2] = m;
                const float mn = fmaxf(bl + m, am), fC = __builtin_amdgcn_exp2f((bl + m - mn) * LOG2E), fK = __builtin_amdgcn_exp2f((am - mn) * LOG2E);
                c0 = fC * c0 + fK * bflo(kl[j]); c1 = fC * c1 + fK * bfhi(kl[j]);
                if (do_n) { n0 = fC * n0 + fK * nl[j].x; n1 = fC * n1 + fK * nl[j].y; }
                m = mn;
            }
        }
    }
}

struct M3Pre { u32x4 qv, kv, vr[2], cp[2]; float gmrow, mprev, bc, gm, u, np; };
__device__ __forceinline__ void m3_load_front(const Args& a, int g, M3Pre& P) {
    const int tid = threadIdx.x; const int bh = g >> 6, c = g & 63, b = bh >> 3, h = bh & 7; const int s0 = c * 64, tok0 = b * SEQ + s0;
    const int prow = tid >> 3, pc = (tid & 7) * 8;
    P.qv = *(const u32x4*)((const bf16*)(a.ws + WS_QC) + ((size_t)bh * SEQ + s0 + prow) * 64 + pc);
    P.kv = *(const u32x4*)((const bf16*)(a.ws + WS_KC) + ((size_t)bh * SEQ + s0 + prow) * 64 + pc);
    const bf16* MV = (const bf16*)(a.ws + WS_SEC + SEC_MV * SEC_BYTES); const bf16* CP = (const bf16*)(a.ws + WS_CPREV) + (size_t)g * 8192;
#pragma unroll
    for (int i = 0; i < 2; ++i) { const int ci = tid + 512 * i, s = ci >> 4, vc = (ci & 15) * 8; P.vr[i] = *(const u32x4*)(MV + (size_t)(tok0 + s) * 1024 + h * 128 + vc);
        P.cp[i] = *(const u32x4*)(CP + (size_t)ci * 8); }
    const float* GV = (const float*)(a.ws + WS_GV) + (size_t)g * 192;
    P.gmrow = GV[64 + prow]; P.mprev = ((const float*)(a.ws + WS_MST))[(size_t)g * 4 + 2];
    if (tid < 64) { P.bc = GV[tid]; P.gm = GV[64 + tid]; P.u = GV[128 + tid]; P.np = ((const float*)(a.ws + WS_NPREV))[(size_t)g * 64 + tid]; }
}
__device__ __forceinline__ void m3_phase(const Args& a, lptr lds, int nblk, int blk) {
    const int tid = threadIdx.x, lane = tid & 63, wid = __builtin_amdgcn_readfirstlane(tid >> 6), r32 = lane & 31, hi = lane >> 5;
    constexpr int QIMG = 16384, KIMG = 25600, SIMG = 34816, QPIMG = 44032, CPIMG = 53248, FARR = 71680, GNOFF = 74240, HIMG = 78336, HP = 132;
    LAS float* fu = (LAS float*)(lds + FARR); LAS float* fMt = fu + 64; LAS float* fwi = fu + 128; LAS float* fmt = fu + 192; LAS float* fnp = fu + 256; LAS float* fqn = fu + 320; LAS float* fdsp = fu + 384;
    LAS float* gn = (LAS float*)(lds + GNOFF); LAS float* himg = (LAS float*)(lds + HIMG); LAS float* fhd = (LAS float*)(lds + 112128 + 64);
    constexpr int NITEM = BATCH * NH * NCHUNK;
    unsigned* ctr = (unsigned*)(a.ws + WS_CTL) + 2048; LAS int* qslot = (LAS int*)(lds + 112128);
    if (tid == 0) { qslot[0] = (int)atomicAdd(ctr, 1u); qslot[1] = (int)atomicAdd(ctr, 1u); }
    for (int i = tid; i < 1024; i += NTHREADS) gn[i] = a.in[IN_MNW][i];
    __syncthreads();
    int g = __builtin_amdgcn_readfirstlane(qslot[0]), gnext = __builtin_amdgcn_readfirstlane(qslot[1]);
    __syncthreads();
    if (g >= NITEM) return;
    M3Pre P; m3_load_front(a, g, P);
    const int prow = tid >> 3, pc = (tid & 7) * 8, seg = tid & 7; int qpar = 0;
    for (;;) {
        const int bh = g >> 6, c = g & 63, b = bh >> 3, h = bh & 7; const int tok0 = b * SEQ + c * 64;
        if (tid == 0) qslot[qpar] = (int)atomicAdd(ctr, 1u);
        { const float Mtr = fmaxf(P.mprev, P.gmrow), wi = fexp(P.mprev - Mtr);
#pragma unroll
          for (int i = 0; i < 2; ++i) { const int ci = tid + 512 * i, s = ci >> 4, vc = (ci & 15) * 8; *(LAS u32x4*)(lds + t_st(s, vc)) = P.vr[i];
              const int v = ci >> 3, dc = (ci & 7) * 8; *(LAS u32x4*)(lds + CPIMG + v * ROWP + dc * 2) = P.cp[i]; }
          *(LAS u32x4*)(lds + QIMG + prow * ROWP + pc * 2) = P.qv; *(LAS u32x4*)(lds + KIMG + prow * ROWP + pc * 2) = P.kv;
          float f[8]; unpack8(P.qv, f); u32x4 o; o.x = pk2(f[0] * wi, f[1] * wi); o.y = pk2(f[2] * wi, f[3] * wi); o.z = pk2(f[4] * wi, f[5] * wi); o.w = pk2(f[6] * wi, f[7] * wi);
          *(LAS u32x4*)(lds + QPIMG + prow * ROWP + pc * 2) = o;
          if (tid < 64) { const float Mt = fmaxf(P.mprev, P.gm); fu[tid] = P.u; fMt[tid] = Mt; fwi[tid] = fexp(P.mprev - Mt); fmt[tid] = P.bc + Mt; fnp[tid] = P.np; } }
        const bf16* MO = (const bf16*)(a.ws + WS_SEC + SEC_MO * SEC_BYTES) + (size_t)(tok0 + prow) * 1024 + h * 128 + seg * 16;
        const bf16* MZ = (const bf16*)(a.ws + WS_SEC + SEC_MZ * SEC_BYTES) + (size_t)(tok0 + prow) * 1024 + h * 128 + seg * 16;
        const u32x4 mo0 = *(const u32x4*)MO, mo1 = *(const u32x4*)(MO + 8), mz0 = *(const u32x4*)MZ, mz1 = *(const u32x4*)(MZ + 8);
        const bool more = gnext < NITEM;
        M3Pre Pn; m3_load_front(a, more ? gnext : g, Pn);
        __syncthreads();
        if (wid < 4) {
            const int sb = wid & 1, tb = wid >> 1;
            f32x16 acc = {};
            if (sb <= tb) {
#pragma unroll
                for (int k0 = 0; k0 < 4; ++k0) { const bf16x8 Kf = *(const LAS bf16x8*)(lds + KIMG + (sb * 32 + r32) * ROWP + (k0 * 16 + hi * 8) * 2);
                    const bf16x8 Qf = *(const LAS bf16x8*)(lds + QIMG + (tb * 32 + r32) * ROWP + (k0 * 16 + hi * 8) * 2);
                    acc = __builtin_amdgcn_mfma_f32_32x32x16_bf16(Kf, Qf, acc, 0, 0, 0); }
            }
            const int t = tb * 32 + r32; const float Mt = fMt[t]; float rsum = 0.f;
#pragma unroll
            for (int gq = 0; gq < 4; ++gq) { float v[4];
#pragma unroll
                for (int e = 0; e < 4; ++e) { const int s = sb * 32 + 8 * gq + 4 * hi + e; const float d = fexp(fu[s] - Mt); v[e] = (s <= t) ? acc[4 * gq + e] * d : 0.f; rsum += v[e]; }
                v2u o; o.x = pk2(v[0], v[1]); o.y = pk2(v[2], v[3]);
                *(LAS v2u*)(lds + SIMG + t * ROWP + (sb * 32 + 8 * gq + 4 * hi) * 2) = o; }
            fdsp[t * 4 + sb * 2 + hi] = rsum;
        } else {
            const int tq = tid - 256, row = tq >> 2, part = tq & 3;
            const u32x4 q0 = *(const LAS u32x4*)(lds + QIMG + row * ROWP + part * 32), q1 = *(const LAS u32x4*)(lds + QIMG + row * ROWP + part * 32 + 16);
            float f[16]; unpack8(q0, f); unpack8(q1, f + 8); float s = 0.f;
#pragma unroll
            for (int e = 0; e < 16; ++e) s += f[e] * fnp[part * 16 + e];
            s += __shfl_xor(s, 1); s += __shfl_xor(s, 2);
            if (part == 0) fqn[row] = s;
        }
        __syncthreads();
        if (tid < 64) {
            const int t = tid; const float den = ((fdsp[t * 4 + 0] + fdsp[t * 4 + 1]) + (fdsp[t * 4 + 2] + fdsp[t * 4 + 3])) + fwi[t] * fqn[t];
            fhd[t] = __builtin_amdgcn_rcpf(fmaxf(fabsf(den), fexp(-fmt[t]))); }
        {
            const int tb = wid >> 2, vb = wid & 3;
            f32x16 acc = {};
            const int va = (int)(uintptr_t)lds + t_rd_base(lane) + vb * 512;
            bf16x8 Af, Bf;
#define M3_STEP(ks) do { Af = *(const LAS bf16x8*)(lds + SIMG + (tb * 32 + r32) * ROWP + ((ks) * 16 + hi * 8) * 2); TRFRAG(Bf, va, ks); acc = __builtin_amdgcn_mfma_f32_32x32x16_bf16(Af, Bf, acc, 0, 0, 0); } while (0)
            M3_STEP(0); M3_STEP(1); M3_STEP(2); M3_STEP(3);
#undef M3_STEP
#pragma unroll
            for (int k0 = 0; k0 < 4; ++k0) { const bf16x8 Aq = *(const LAS bf16x8*)(lds + QPIMG + (tb * 32 + r32) * ROWP + (k0 * 16 + hi * 8) * 2);
                const bf16x8 Cf = *(const LAS bf16x8*)(lds + CPIMG + (vb * 32 + r32) * ROWP + (k0 * 16 + hi * 8) * 2);
                acc = __builtin_amdgcn_mfma_f32_32x32x16_bf16(Aq, Cf, acc, 0, 0, 0); }
#pragma unroll
            for (int r = 0; r < 16; ++r) himg[(tb * 32 + crow(r, hi)) * HP + vb * 32 + r32] = acc[r];
        }
        __syncthreads();
        {
            float hv[16], of[16], zf[16];
#pragma unroll
            for (int j = 0; j < 4; ++j) { const pg8::f32x4 x = *(const LAS pg8::f32x4*)(himg + prow * HP + seg * 16 + 4 * j); hv[4 * j] = x[0]; hv[4 * j + 1] = x[1]; hv[4 * j + 2] = x[2]; hv[4 * j + 3] = x[3]; }
            unpack8(mo0, of); unpack8(mo1, of + 8); unpack8(mz0, zf); unpack8(mz1, zf + 8);
            float ss = 0.f; const float hdr = fhd[prow];
#pragma unroll
            for (int e = 0; e < 16; ++e) { hv[e] *= hdr * fsigmoid(of[e]); ss += hv[e] * hv[e]; }
            ss += __shfl_xor(ss, 1); ss += __shfl_xor(ss, 2); ss += __shfl_xor(ss, 4);
            const float rs = 1.0f / sqrtf(ss * (1.f / 128.f) + NORM_EPS);
            float y[16];
#pragma unroll
            for (int e = 0; e < 16; ++e) y[e] = hv[e] * rs * gn[h * 128 + seg * 16 + e] * (zf[e] * fsigmoid(zf[e]));
            u32x4 o0, o1; o0.x = pk2(y[0], y[1]); o0.y = pk2(y[2], y[3]); o0.z = pk2(y[4], y[5]); o0.w = pk2(y[6], y[7]);
            o1.x = pk2(y[8], y[9]); o1.y = pk2(y[10], y[11]); o1.z = pk2(y[12], y[13]); o1.w = pk2(y[14], y[15]);
            bf16* Y = (bf16*)(a.ws + WS_Y) + (size_t)(tok0 + prow) * 2048 + 1024 + h * 128 + seg * 16;
            *(u32x4*)Y = o0; *(u32x4*)(Y + 8) = o1;
        }
        if (!more) break;
        g = gnext; P = Pn; gnext = __builtin_amdgcn_readfirstlane(qslot[qpar]); qpar ^= 1;
    }
    __syncthreads();
}
#undef TRFRAG
}

#define XB_TMO      128
#define XB_XCNT(j)  (256  + 64 * (j))
#define XB_XSUB(j)  (1280 + 64 * (j))
#define XB_XGEN(j)  (2304 + 64 * (j))
#define XB_TOP      3328
#define XB_TOPGEN   3392
#define XCD_BAR_WORDS 3456
#define XB_SPIN_CAP (1u << 18)

__device__ __forceinline__ unsigned xb_ld(unsigned* p)              { return __hip_atomic_load(p, __ATOMIC_RELAXED, __HIP_MEMORY_SCOPE_AGENT); }
__device__ __forceinline__ unsigned xb_add(unsigned* p, unsigned v) { return __hip_atomic_fetch_add(p, v, __ATOMIC_RELAXED, __HIP_MEMORY_SCOPE_AGENT); }
__device__ __forceinline__ unsigned xb_xcc_id() { return (unsigned)__builtin_amdgcn_s_getreg((3 << 11) | 20) & 0xFu; }
#define XB_SPIN(cond, bar) do { unsigned _sp = 0; while (cond) { __builtin_amdgcn_s_sleep(1); \
    if ((++_sp & 255u) == 0u) { if (xb_ld(&(bar)[XB_TMO])) break; if (_sp > XB_SPIN_CAP) { atomicAdd(&(bar)[XB_TMO], 1u); break; } } } } while (0)

struct XcdBarrier {
    unsigned* bar; unsigned x;
    volatile LAS unsigned* st;
};

__device__ __forceinline__ XcdBarrier xcd_barrier_post(unsigned* bar, volatile LAS unsigned* st) {
    XcdBarrier b; b.bar = bar; b.x = xb_xcc_id(); b.st = st;
    if (threadIdx.x == 0) (void)xb_add(&bar[XB_XCNT(b.x)], 1u);
    return b;
}
__device__ __forceinline__ void xcd_barrier_complete(unsigned* bar, unsigned x, unsigned& nloc, unsigned& nx) {
    const unsigned G = gridDim.x * gridDim.y * gridDim.z;
    unsigned sum, cnt, mine, sp = 0u;
    for (;;) {
        sum = 0u; cnt = 0u; mine = 0u;
#pragma unroll
        for (unsigned j = 0; j < 16; ++j) { const unsigned c = xb_ld(&bar[XB_XCNT(j)]); sum += c; cnt += (c > 0u) ? 1u : 0u; mine = (j == x) ? c : mine; }
        if (sum == G) break;
        __builtin_amdgcn_s_sleep(1);
        if ((++sp & 255u) == 0u) { if (xb_ld(&bar[XB_TMO])) break; if (sp > XB_SPIN_CAP) { atomicAdd(&bar[XB_TMO], 1u); break; } }
    }
    nloc = mine > 0u ? mine : 1u; nx = cnt > 0u ? cnt : 1u;
}

__device__ __forceinline__ void xcd_barrier(const XcdBarrier& b) {
    asm volatile("s_waitcnt vmcnt(0)" ::: "memory");
    __syncthreads();
    if (threadIdx.x == 0) {
        unsigned* bar = b.bar;
        __builtin_amdgcn_s_waitcnt(0);
        unsigned nloc = b.st[0], nx = b.st[1];
        if (nloc == 0u) { xcd_barrier_complete(bar, b.x, nloc, nx); b.st[0] = nloc; b.st[1] = nx; }
        const unsigned old = xb_add(&bar[XB_XSUB(b.x)], 1u);
        const unsigned gen = old / nloc;
        if (old + 1u == (gen + 1u) * nloc) {
            __builtin_amdgcn_fence(__ATOMIC_RELEASE, "agent");
            asm volatile("s_waitcnt vmcnt(0)" ::: "memory");
            const unsigned og = xb_add(&bar[XB_TOP], 1u);
            const unsigned tg = og / nx;
            if (og + 1u == (tg + 1u) * nx) xb_add(&bar[XB_TOPGEN], 1u);
            else XB_SPIN(xb_ld(&bar[XB_TOPGEN]) == tg, bar);
            __builtin_amdgcn_fence(__ATOMIC_ACQUIRE, "agent");
            xb_add(&bar[XB_XGEN(b.x)], 1u);
            asm volatile("s_waitcnt vmcnt(0)" ::: "memory");
        } else {
            XB_SPIN(xb_ld(&bar[XB_XGEN(b.x)]) == gen, bar);
            __builtin_amdgcn_fence(__ATOMIC_ACQUIRE, "agent");
            asm volatile("s_waitcnt vmcnt(0)" ::: "memory");
        }
    }
    __syncthreads();
}

constexpr int N_PHASES = 7;
__global__ void __launch_bounds__(NTHREADS, 2) mega_fwd(Args a) {
    extern __shared__ __attribute__((aligned(16))) unsigned char lds_raw[];
    LAS unsigned char* lds = (LAS unsigned char*)lds_raw;
    const int blk = blockIdx.x, nblk = gridDim.x;
    const int lo = a.ph_lo, hi = a.ph_hi;
    volatile LAS unsigned* MISC = (volatile LAS unsigned*)(lds + LDS_BYTES - 64);
    if (threadIdx.x < 16) MISC[threadIdx.x] = 0u;
    __syncthreads();
    XcdBarrier bar = xcd_barrier_post((unsigned*)(a.ws + WS_CTL) + 4096, MISC + 8);
#ifndef PROBE_REPEAT
#define PROBE_REPEAT -1
#endif
#ifndef PROBE_FLAGS
#define PROBE_FLAGS 0
#endif
#define REP(k)
#define IN(k) (lo <= (k) && (k) < hi)
#define SEAM(k) do { if (IN(k) && IN((k) + 1)) xcd_barrier(bar); } while (0)
    if (IN(0)) { REP(0) phase_prep(a, lds, nblk, blk); }
    SEAM(0);
    if (IN(1)) REP(1) {
        for (int c = blk; c < M_TOK / 64; c += nblk) gate_unit(a, lds, c);
        pg8::Gemm g{(const pg8::bf16_t*)(a.ws + WS_XN), (const pg8::bf16_t*)(a.ws + WS_WIN), M_TOK, NMAIN, DM};
        pg8::EpiProj E{a.ws + WS_SEC, QSCALE};
        if (nblk == 256) { pg8::XcdColOrder S; S.init(M_TOK, NMAIN, nblk, blk); pg8::gemm_phase<pg8::EpiProj, pg8::XcdColOrder, true, true>(lds, g, S, E); }
        else { pg8::StaticOrder S; S.init(M_TOK, NMAIN, nblk, blk); pg8::gemm_phase<pg8::EpiProj, pg8::StaticOrder, true, true>(lds, g, S, E); }
    }
    SEAM(1);
    if (IN(2)) {
        for (int it = blk; it < BATCH * NH * 8; it += nblk) fox_cumsum_item(a, lds, it);
        fox::knorm_pass(a, nblk, blk);
        ml::m1_phase(a, (ml::lptr)lds, nblk, blk);
    }
    SEAM(2);
    if (IN(3) && !(a.flags & 16)) { fox::ksuf_pass(a, nblk, blk); ml::m2_scan(a, nblk, blk); }
    SEAM(3);
    if (IN(4)) {
        REP(4) fox::phase(a, (fox::lptr)lds, nblk, blk);
        REP(41) ml::m3_phase(a, (ml::lptr)lds, nblk, blk);
    }
    SEAM(4);
    if (IN(5)) REP(5) {
        pg8::Gemm g{(const pg8::bf16_t*)(a.ws + WS_Y), (const pg8::bf16_t*)(a.ws + WS_WOUT), M_TOK, DM, DM};
        pg8::StaticOrder S; S.init(M_TOK, DM, nblk, blk);
        pg8::EpiOut E{(pg8::bf16_t*)(a.ws + WS_DELTA)};
        pg8::gemm_phase<pg8::EpiOut, pg8::StaticOrder, true, true>(lds, g, S, E);
    }
    SEAM(5);
    if (IN(6)) { REP(6) phase_final(a, nblk, blk); }
#undef IN
#undef SEAM
}

#ifndef MK_N_LAUNCHES
#define MK_N_LAUNCHES 1
#endif
extern "C" void kernel_launch(void* const* d_in, const int* in_sizes, int n_in, void* d_out, int out_size, void* d_ws, size_t ws_size, hipStream_t stream) {
    static int grid = 0;
    if (grid == 0) {
        if (n_in != 12 || in_sizes[0] != M_TOK * DM || in_sizes[2] != DM * IN_COLS || out_size != M_TOK * DM || ws_size < WS_END) {
            fprintf(stderr, "kernel_launch: shape mismatch n_in %d in0 %d in2 %d out %d ws %zu\n", n_in, n_in > 0 ? in_sizes[0] : -1, n_in > 2 ? in_sizes[2] : -1, out_size, ws_size); grid = -1; return; }
        int dev = 0, cus = 0, per_cu = 0;
        if (hipGetDevice(&dev) != hipSuccess || hipDeviceGetAttribute(&cus, hipDeviceAttributeMultiprocessorCount, dev) != hipSuccess) { grid = -1; return; }
        if (hipFuncSetAttribute((const void*)mega_fwd, hipFuncAttributeMaxDynamicSharedMemorySize, LDS_BYTES) != hipSuccess) { fprintf(stderr, "kernel_launch: hipFuncSetAttribute failed\n"); grid = -1; return; }
        if (hipOccupancyMaxActiveBlocksPerMultiprocessor(&per_cu, (const void*)mega_fwd, NTHREADS, LDS_BYTES) != hipSuccess || per_cu < 1) { fprintf(stderr, "kernel_launch: occupancy query says %d blocks per CU\n", per_cu); per_cu = 1; }
        (void)hipGetLastError();
        grid = cus;
    }
    if (grid < 0) return;
    Args a{};
    for (int i = 0; i < 12; ++i) a.in[i] = (const float*)d_in[i];
    a.out = (float*)d_out; a.ws = (unsigned char*)d_ws;
    if (hipMemsetAsync((char*)d_ws + WS_CTL, 0, 65536, stream) != hipSuccess) { fprintf(stderr, "kernel_launch: hipMemsetAsync failed\n"); return; }
    if (MK_N_LAUNCHES == 1) {
        a.ph_lo = 0; a.ph_hi = N_PHASES;
        void* args[] = {&a};
        hipError_t e = hipLaunchCooperativeKernel((const void*)mega_fwd, dim3(grid), dim3(NTHREADS), args, LDS_BYTES, stream);
        if (e != hipSuccess) fprintf(stderr, "kernel_launch: cooperative launch failed: %s (grid %d)\n", hipGetErrorString(e), grid);
    } else {
        for (int p = 0; p < N_PHASES; ++p) { a.ph_lo = p; a.ph_hi = p + 1; for (int r = 0; r < (p == PROBE_REPEAT ? 2 : 1); ++r) { a.flags = r ? PROBE_FLAGS : 0; hipLaunchKernelGGL(mega_fwd, dim3(grid), dim3(NTHREADS), LDS_BYTES, stream, a); } }
        if (PROBE_REPEAT == 56) for (int p = 5; p < 7; ++p) { a.ph_lo = p; a.ph_hi = p + 1; hipLaunchKernelGGL(mega_fwd, dim3(grid), dim3(NTHREADS), LDS_BYTES, stream, a); }
    }
}
```

```cpp
#include <hip/hip_runtime.h>
#include <hip/hip_cooperative_groups.h>
#include <cstdio>
#include <cstdint>
namespace cg = cooperative_groups;

constexpr int BATCH = 4, SEQ = 4096, DM = 2048, M_TOK = BATCH * SEQ;
constexpr int NH = 8, HD = 128, DK = 64, CHUNK = 64, NCHUNK = SEQ / CHUNK;
constexpr int IN_COLS = 8216, NMAIN = 8192, NGATE = 32;
constexpr float NORM_EPS = 1e-6f;
constexpr float LOG2E = 1.4426950408889634f;
constexpr float QSCALE = 0.08838834764831845f * 1.4426950408889634f;

constexpr size_t MiB = 1u << 20;
constexpr size_t WS_CTL = 0;
constexpr size_t WS_KNRM = 1 * MiB, WS_KSUF = 1 * MiB + 8192, WS_KBND = 1 * MiB + 16384;
constexpr size_t WS_GATE = 2 * MiB;
constexpr size_t WS_ROWSS = 4 * MiB;
constexpr size_t WS_WGT = 6 * MiB;
constexpr size_t WS_KBIAS = 7 * MiB;
constexpr size_t WS_MST = 9 * MiB;
constexpr size_t WS_NLOC = 10 * MiB;
constexpr size_t WS_NPREV = 11 * MiB;
constexpr size_t WS_GV = 12 * MiB;
constexpr size_t WS_WOUT = 16 * MiB;
constexpr size_t WS_WIN = 32 * MiB;
constexpr size_t WS_QC = 32 * MiB;
constexpr size_t WS_KC = 48 * MiB;
constexpr size_t WS_XN = 64 * MiB;
constexpr size_t WS_Y = 64 * MiB;
constexpr size_t WS_SEC = 128 * MiB;
constexpr size_t SEC_BYTES = 32 * MiB;
constexpr size_t WS_KLOC = 384 * MiB;
constexpr size_t WS_DELTA = 384 * MiB;
constexpr size_t WS_CPREV = 448 * MiB;
constexpr size_t WS_END = 480 * MiB;
enum { SEC_FQ = 0, SEC_FK, SEC_FV, SEC_FZ, SEC_MQK, SEC_MV, SEC_MO, SEC_MZ };

typedef unsigned short bf16;
typedef unsigned v4u __attribute__((ext_vector_type(4)));
typedef unsigned v2u __attribute__((ext_vector_type(2)));
typedef float f32x16 __attribute__((ext_vector_type(16)));
#define LAS __attribute__((address_space(3)))
#define LDS_WAIT() asm volatile("s_waitcnt lgkmcnt(0)" ::: "memory")

__device__ __forceinline__ unsigned f2bf(float f) { unsigned u = __builtin_bit_cast(unsigned, f); return (u + 0x7fffu + ((u >> 16) & 1u)) >> 16; }
typedef float f32x2_t __attribute__((ext_vector_type(2))); typedef __bf16 bf16x2_t __attribute__((ext_vector_type(2)));
__device__ __forceinline__ unsigned pk2(float lo, float hi) { f32x2_t v = {lo, hi}; bf16x2_t b = __builtin_convertvector(v, bf16x2_t); return __builtin_bit_cast(unsigned, b); }
__device__ __forceinline__ float bf2f(unsigned h) { return __builtin_bit_cast(float, (h & 0xffffu) << 16); }
__device__ __forceinline__ float bflo(unsigned w) { return __builtin_bit_cast(float, w << 16); }
__device__ __forceinline__ float bfhi(unsigned w) { return __builtin_bit_cast(float, w & 0xffff0000u); }
__device__ __forceinline__ float wave_sum(float v) {
#pragma unroll
    for (int o = 1; o < 64; o <<= 1) v += __shfl_xor(v, o);
    return v;
}
__device__ __forceinline__ float wave_max(float v) {
#pragma unroll
    for (int o = 1; o < 64; o <<= 1) v = fmaxf(v, __shfl_xor(v, o));
    return v;
}
#define DPP_F(x, old, ctrl, rm, bm) __builtin_bit_cast(float, __builtin_amdgcn_update_dpp(__builtin_bit_cast(int, (float)(old)), __builtin_bit_cast(int, (float)(x)), ctrl, rm, bm, false))
__device__ __forceinline__ float wave_scan_add(float v) {
    float s = v + DPP_F(v, 0.f, 0x111, 0xf, 0xf); s += DPP_F(v, 0.f, 0x112, 0xf, 0xf); s += DPP_F(v, 0.f, 0x113, 0xf, 0xf);
    s += DPP_F(s, 0.f, 0x114, 0xf, 0xe); s += DPP_F(s, 0.f, 0x118, 0xf, 0xc);
    s += DPP_F(s, 0.f, 0x142, 0xa, 0xf); s += DPP_F(s, 0.f, 0x143, 0xc, 0xf);
    return s;
}
__device__ __forceinline__ float wave_scan_max(float v) {
    const float NI = -__builtin_inff();
    float s = fmaxf(v, DPP_F(v, NI, 0x111, 0xf, 0xf)); s = fmaxf(s, DPP_F(v, NI, 0x112, 0xf, 0xf)); s = fmaxf(s, DPP_F(v, NI, 0x113, 0xf, 0xf));
    s = fmaxf(s, DPP_F(s, NI, 0x114, 0xf, 0xe)); s = fmaxf(s, DPP_F(s, NI, 0x118, 0xf, 0xc));
    s = fmaxf(s, DPP_F(s, NI, 0x142, 0xa, 0xf)); s = fmaxf(s, DPP_F(s, NI, 0x143, 0xc, 0xf));
    return s;
}
__device__ __forceinline__ float logsigmoidf(float x) { return fminf(x, 0.f) - log1pf(expf(-fabsf(x))); }
__device__ __forceinline__ float siluf(float x) { return x / (1.f + expf(-x)); }
__device__ __forceinline__ float sigmoidf_(float x) { return 1.f / (1.f + expf(-x)); }

namespace pg8 {
#define PG8_LAS __attribute__((address_space(3)))
typedef unsigned short bf16_t;
typedef short bf16x8 __attribute__((ext_vector_type(8)));
typedef float f32x4 __attribute__((ext_vector_type(4)));
typedef unsigned u32x4 __attribute__((ext_vector_type(4)));
constexpr int BM = 256, BK = 64, HALF = 128, HTB = HALF * BK * 2  , STAGE_BYTES = 8 * HTB, NXCD = 8, WGM = 4;

__host__ __device__ __forceinline__ int lds_byte(int r, int c) { const int st = (r >> 4) * 2 + (c >> 5), rr = r & 15, cc = c & 31, ob = rr * 64 + cc * 2; return st * 1024 + (ob ^ (((ob >> 9) & 1) << 5)); }
__host__ __device__ __forceinline__ void stage_rc(int b, int& R, int& C) { const int st = b / 1024, sb = b % 1024, swz = sb ^ (((sb >> 9) & 1) << 5); R = (st >> 1) * 16 + swz / 64; C = (st & 1) * 32 + (swz % 64) / 2; }
__host__ __device__ __forceinline__ int perm32(int rho) { const int n = rho >> 4, i = rho & 15; return 8 * (i >> 2) + 4 * n + (i & 3); }

struct Unit { int pm, pn; };
struct Gemm { const bf16_t* A; const bf16_t* Bt; int M, N, K; };

struct StaticOrder {
    int nM, nN, nwg, G, c;
    __host__ __device__ void init(int M, int N, int G_, int c_) { nM = M / BM; nN = N / BM; nwg = nM * nN; G = G_; c = c_; }
    __host__ __device__ bool next(int i, Unit& u) const {
        const long L = (long)i * G + c; if (L >= nwg) return false;
        int wgid = (int)L; { const int q = nwg / NXCD, r = nwg % NXCD, xcd = wgid % NXCD, off = wgid / NXCD; wgid = (xcd < r ? xcd * (q + 1) : r * (q + 1) + (xcd - r) * q) + off; }
        const int nig = WGM * nN, gid = wgid / nig, fm = gid * WGM, gsz = (nM - fm) < WGM ? (nM - fm) : WGM;
        u.pm = fm + ((wgid % nig) % gsz); u.pn = (wgid % nig) / gsz; return true;
    }
    __device__ __forceinline__ void a_ready(const Unit&) const {}
    __device__ __forceinline__ void done(const Unit&) const {}
};

__device__ __forceinline__ unsigned cvt_pk_bf16(float lo, float hi) { return pk2(lo, hi); }

struct XcdColOrder {
    int nM, nN, G, c;
    __host__ __device__ void init(int M, int N, int G_, int c_) { nM = M / BM; nN = N / BM; G = G_; c = c_; }
    __host__ __device__ bool next(int i, Unit& u) const {
        const int x = c & 7, j = c >> 3, per = nN >> 3, rows = (G >> 3) / per;
        u.pn = x * per + j / rows; u.pm = i * rows + j % rows; return u.pm < nM;
    }
    __device__ __forceinline__ void a_ready(const Unit&) const {}
    __device__ __forceinline__ void done(const Unit&) const {}
};

struct EpiProj {
    static constexpr bool PERM = true, AFTER_DRAIN = false;
    unsigned char* secbase; float qscale;
    __device__ __forceinline__ void operator()(const f32x4 (&acc)[2][2][4][2], const Unit& u, int wr, int wc, int fr, int fq) const {
        const int sec = u.pn >> 2, t4 = u.pn & 3;
        const int row0 = u.pm * BM + wr * 64 + fr;
        bf16_t* base = (bf16_t*)(secbase + (size_t)sec * (32u << 20));
        const float sc = sec == 0 ? qscale : 1.f;
        size_t rstride, bjstride, off0;
        if (sec < 3) {
            const int b = row0 >> 12, s0 = row0 & 4095;
            rstride = 128; bjstride = (size_t)4096 * 128; off0 = ((size_t)(b * 8 + t4 * 2) * 4096 + s0) * 128 + wc * 32 + 8 * fq;
        } else {
            rstride = 1024; bjstride = 128; off0 = (size_t)row0 * 1024 + t4 * 256 + wc * 32 + 8 * fq;
        }
#pragma unroll
        for (int ai = 0; ai < 2; ++ai)
#pragma unroll
            for (int m = 0; m < 4; ++m) { bf16_t* rowp = base + off0 + (size_t)(ai * HALF + m * 16) * rstride;
#pragma unroll
                for (int bj = 0; bj < 2; ++bj) { f32x4 v0 = acc[ai][bj][m][0] * sc, v1 = acc[ai][bj][m][1] * sc;
                    u32x4 w; w.x = cvt_pk_bf16(v0[0], v0[1]); w.y = cvt_pk_bf16(v0[2], v0[3]); w.z = cvt_pk_bf16(v1[0], v1[1]); w.w = cvt_pk_bf16(v1[2], v1[3]);
                    __builtin_nontemporal_store(w, (u32x4*)(rowp + bj * bjstride)); } }
    }
};
struct EpiOut {
    static constexpr bool PERM = true, AFTER_DRAIN = false;
    bf16_t* delta;
    __device__ __forceinline__ void operator()(const f32x4 (&acc)[2][2][4][2], const Unit& u, int wr, int wc, int fr, int fq) const {
        const int row0 = u.pm * BM + wr * 64 + fr; bf16_t* base = delta + (size_t)row0 * 2048 + u.pn * BM + wc * 32 + 8 * fq;
#pragma unroll
        for (int ai = 0; ai < 2; ++ai)
#pragma unroll
            for (int m = 0; m < 4; ++m) { bf16_t* rowp = base + (size_t)(ai * HALF + m * 16) * 2048;
#pragma unroll
                for (int bj = 0; bj < 2; ++bj) { const f32x4 v0 = acc[ai][bj][m][0], v1 = acc[ai][bj][m][1];
                    u32x4 w; w.x = cvt_pk_bf16(v0[0], v0[1]); w.y = cvt_pk_bf16(v0[2], v0[3]); w.z = cvt_pk_bf16(v1[0], v1[1]); w.w = cvt_pk_bf16(v1[2], v1[3]);
                    *(u32x4*)(rowp + bj * HALF) = w; } }
    }
};

template <class Epi, class Sched, bool ALIGN_EPI = false, bool SP2 = false>
__device__ __forceinline__ void gemm_phase(PG8_LAS unsigned char* lds, const Gemm g, const Sched& S, const Epi& E) {
    const int tid = threadIdx.x, wid = __builtin_amdgcn_readfirstlane(tid >> 6), lane = tid & 63, wr = wid >> 2, wc = wid & 3, fr = lane & 15, fq = lane >> 4;
    const int K = g.K, nt = K / BK;
    unsigned voffA[2], voffB[2];
#pragma unroll
    for (int i = 0; i < 2; ++i) { int R, C; stage_rc(tid * 16 + i * 8192, R, C); const int Rb = Epi::PERM ? ((R & ~31) + perm32(R & 31)) : R;
        voffA[i] = (unsigned)(R * K + C) * 2u; voffB[i] = (unsigned)(Rb * K + C) * 2u; }
    const size_t kstep = (size_t)(BK * 2);
    const size_t hstep = (size_t)HALF * K * 2;
    const size_t tstep = 2 * hstep;
    const unsigned ldsw = (unsigned)wid * 1024u;
    const int aoff = lds_byte(wr * 64 + fr, fq * 8), boff = lds_byte(wc * 32 + fr, fq * 8);
#define PG8_SA(b, h) (((b) * 2 + (h)) * HTB)
#define PG8_SB(b, h) ((4 + (b) * 2 + (h)) * HTB)
#define PG8_STAGE(bufoff, gbase, voff) do { _Pragma("unroll") for (int _i = 0; _i < 2; ++_i) \
        __builtin_amdgcn_global_load_lds((const unsigned*)((const char*)(gbase) + (voff)[_i]), (PG8_LAS unsigned*)(lds + (bufoff) + ldsw + _i * 8192), 16, 0, 0); } while (0)
#define PG8_LDA(dst, b, h) do { _Pragma("unroll") for (int m = 0; m < 4; ++m) _Pragma("unroll") for (int k = 0; k < 2; ++k) dst[m][k] = *(const PG8_LAS bf16x8*)(lds + PG8_SA(b, h) + aoff + m * 2048 + k * 1024); } while (0)
#define PG8_LDB(dst, b, h) do { _Pragma("unroll") for (int n = 0; n < 2; ++n) _Pragma("unroll") for (int k = 0; k < 2; ++k) dst[n][k] = *(const PG8_LAS bf16x8*)(lds + PG8_SB(b, h) + boff + n * 2048 + k * 1024); } while (0)
#define PG8_MMA(ai, bj, At, Bt) do { __builtin_amdgcn_s_setprio(1); _Pragma("unroll") for (int m = 0; m < 4; ++m) _Pragma("unroll") for (int n = 0; n < 2; ++n) _Pragma("unroll") for (int k = 0; k < 2; ++k) \
        acc[ai][bj][m][n] = __builtin_amdgcn_mfma_f32_16x16x32_bf16(Bt[n][k], At[m][k], acc[ai][bj][m][n], 0, 0, 0); __builtin_amdgcn_s_setprio(0); } while (0)
#define PG8_WAIT_V(n) asm volatile("s_waitcnt vmcnt(" #n ")" ::: "memory")
#define PG8_WAIT_L(n) asm volatile("s_waitcnt lgkmcnt(" #n ")" ::: "memory")
#define PG8_BAR __builtin_amdgcn_s_barrier()
#define PG8_SCHED __builtin_amdgcn_sched_barrier(0)
    Unit cur, nxt; int ui = 0;
    if (!S.next(0, cur)) return;
    f32x4 acc[2][2][4][2];
#pragma unroll
    for (int a = 0; a < 2; ++a)
#pragma unroll
        for (int b = 0; b < 2; ++b)
#pragma unroll
            for (int m = 0; m < 4; ++m)
#pragma unroll
                for (int n = 0; n < 2; ++n) acc[a][b][m][n] = (f32x4){0.f, 0.f, 0.f, 0.f};
    bf16x8 At[4][2], B0[2][2], B1[2][2];
    const char* cA = (const char*)g.A + (size_t)cur.pm * tstep; const char* cB = (const char*)g.Bt + (size_t)cur.pn * tstep;
    S.a_ready(cur);
    if constexpr (SP2) {
        PG8_STAGE(PG8_SB(0, 0), cB, voffB); PG8_STAGE(PG8_SB(0, 1), cB + hstep, voffB); PG8_STAGE(PG8_SA(0, 0), cA, voffA); PG8_STAGE(PG8_SA(0, 1), cA + hstep, voffA);
        if (wr == 1) PG8_BAR;
        PG8_WAIT_V(2); PG8_BAR;
        PG8_STAGE(PG8_SB(1, 0), cB + kstep, voffB); PG8_STAGE(PG8_SA(1, 0), cA + kstep, voffA); PG8_STAGE(PG8_SB(1, 1), cB + hstep + kstep, voffB);
        PG8_WAIT_V(6); PG8_BAR;
    } else {
        PG8_STAGE(PG8_SB(0, 0), cB, voffB); PG8_STAGE(PG8_SA(0, 0), cA, voffA); PG8_STAGE(PG8_SB(0, 1), cB + hstep, voffB); PG8_STAGE(PG8_SA(0, 1), cA + hstep, voffA);
        if (wr == 1) PG8_BAR;
        PG8_WAIT_V(4); PG8_BAR;
        PG8_STAGE(PG8_SB(1, 0), cB + kstep, voffB); PG8_STAGE(PG8_SA(1, 0), cA + kstep, voffA); PG8_STAGE(PG8_SB(1, 1), cB + hstep + kstep, voffB);
        PG8_WAIT_V(6); PG8_BAR;
    }
    for (;;) {
        const bool has_next = S.next(ui + 1, nxt);
        const char* nA = has_next ? (const char*)g.A + (size_t)nxt.pm * tstep : cA; const char* nB = has_next ? (const char*)g.Bt + (size_t)nxt.pn * tstep : cB;
        for (int t = 0; t < nt; t += 2) {
            const bool last = (t == nt - 2);
            const char* a1 = cA + (size_t)(t + 1) * kstep;
            const char* a2 = last ? nA : cA + (size_t)(t + 2) * kstep; const char* b2 = last ? nB : cB + (size_t)(t + 2) * kstep;
            const char* a3 = a2 + kstep; const char* b3 = b2 + kstep;
            if (last && has_next) S.a_ready(nxt);
            if constexpr (SP2) {
            PG8_LDB(B0, 0, 0); PG8_LDB(B1, 0, 1); PG8_SCHED; PG8_LDA(At, 0, 0); PG8_STAGE(PG8_SA(1, 1), a1 + hstep, voffA);
            PG8_WAIT_V(8); PG8_WAIT_L(0); PG8_BAR; PG8_MMA(0, 0, At, B0); PG8_MMA(0, 1, At, B1); PG8_BAR; PG8_SCHED;
            PG8_LDA(At, 0, 1); PG8_STAGE(PG8_SB(0, 0), b2, voffB); PG8_STAGE(PG8_SB(0, 1), b2 + hstep, voffB); PG8_STAGE(PG8_SA(0, 0), a2, voffA);
            PG8_WAIT_V(8); PG8_WAIT_L(0); PG8_BAR; PG8_MMA(1, 0, At, B0); PG8_MMA(1, 1, At, B1); PG8_BAR; PG8_SCHED;
            PG8_LDB(B0, 1, 0); PG8_LDB(B1, 1, 1); PG8_SCHED; PG8_LDA(At, 1, 0); PG8_STAGE(PG8_SA(0, 1), a2 + hstep, voffA);
            PG8_WAIT_V(8); PG8_WAIT_L(0); PG8_BAR; PG8_MMA(0, 0, At, B0); PG8_MMA(0, 1, At, B1); PG8_BAR; PG8_SCHED;
            PG8_LDA(At, 1, 1); PG8_STAGE(PG8_SB(1, 0), b3, voffB); PG8_STAGE(PG8_SB(1, 1), b3 + hstep, voffB); PG8_STAGE(PG8_SA(1, 0), a3, voffA);
            PG8_WAIT_V(8); PG8_WAIT_L(0); PG8_BAR; PG8_MMA(1, 0, At, B0); PG8_MMA(1, 1, At, B1); PG8_BAR; PG8_SCHED;
            } else {
            PG8_LDB(B0, 0, 0); PG8_SCHED; PG8_LDA(At, 0, 0); PG8_STAGE(PG8_SA(1, 1), a1 + hstep, voffA);
            PG8_WAIT_L(8); PG8_BAR; PG8_WAIT_L(0); PG8_MMA(0, 0, At, B0); PG8_BAR; PG8_SCHED;
            PG8_LDB(B1, 0, 1); PG8_STAGE(PG8_SB(0, 0), b2, voffB);
            PG8_BAR; PG8_WAIT_L(0); PG8_MMA(0, 1, At, B1); PG8_BAR;
            PG8_LDA(At, 0, 1); PG8_STAGE(PG8_SA(0, 0), a2, voffA);
            PG8_BAR; PG8_WAIT_L(0); PG8_MMA(1, 0, At, B0); PG8_BAR; PG8_SCHED;
            PG8_STAGE(PG8_SB(0, 1), b2 + hstep, voffB);
            PG8_WAIT_V(6); PG8_BAR; PG8_MMA(1, 1, At, B1); PG8_BAR;
            PG8_LDB(B0, 1, 0); PG8_SCHED; PG8_LDA(At, 1, 0); PG8_STAGE(PG8_SA(0, 1), a2 + hstep, voffA);
            PG8_WAIT_L(8); PG8_BAR; PG8_WAIT_L(0); PG8_MMA(0, 0, At, B0); PG8_BAR; PG8_SCHED;
            PG8_LDB(B1, 1, 1); PG8_STAGE(PG8_SB(1, 0), b3, voffB);
            PG8_BAR; PG8_WAIT_L(0); PG8_MMA(0, 1, At, B1); PG8_BAR;
            PG8_LDA(At, 1, 1); PG8_STAGE(PG8_SA(1, 0), a3, voffA);
            PG8_BAR; PG8_WAIT_L(0); PG8_MMA(1, 0, At, B0); PG8_BAR; PG8_SCHED;
            PG8_STAGE(PG8_SB(1, 1), b3 + hstep, voffB);
            PG8_WAIT_V(6); PG8_BAR; PG8_MMA(1, 1, At, B1); PG8_BAR;
            }
        }
        if constexpr (ALIGN_EPI) { if (wr == 0) PG8_BAR; }
        if constexpr (!Epi::AFTER_DRAIN) { E(acc, cur, wr, wc, fr, fq); S.done(cur); }
        if (!has_next) break;
#pragma unroll
        for (int a = 0; a < 2; ++a)
#pragma unroll
            for (int b = 0; b < 2; ++b)
#pragma unroll
                for (int m = 0; m < 4; ++m)
#pragma unroll
                    for (int n = 0; n < 2; ++n) acc[a][b][m][n] = (f32x4){0.f, 0.f, 0.f, 0.f};
        cur = nxt; cA = nA; cB = nB; ++ui;
        if constexpr (ALIGN_EPI) { if (wr == 1) PG8_BAR; }
    }
    PG8_WAIT_V(0);
    if constexpr (!ALIGN_EPI) { if (wr == 0) PG8_BAR; }
    PG8_BAR;
    if constexpr (Epi::AFTER_DRAIN) { E.fused(acc, cur, wr, wc, fr, fq, lds, wid, lane); S.done(cur); }
#undef PG8_SA
#undef PG8_SB
#undef PG8_STAGE
#undef PG8_LDA
#undef PG8_LDB
#undef PG8_MMA
#undef PG8_WAIT_V
#undef PG8_WAIT_L
#undef PG8_BAR
#undef PG8_SCHED
}
}
struct Args { const float* in[12]; float* out; unsigned char* ws; int ph_lo, ph_hi, flags, pad; };
enum { IN_X = 0, IN_NORMW, IN_WIN, IN_FOXFB, IN_CONVW, IN_CONVB, IN_MIB, IN_MFB, IN_FOXNW, IN_MNW, IN_WOUT, IN_FINW };
constexpr int NWAVES = 8, NTHREADS = 512;
constexpr int LDS_BYTES = 147456;

__device__ __forceinline__ void p0_transpose_gate(const float* W, int ldw, int k0, bf16* WT, int K, LAS float* scr, int lane) {
    const int n_ = lane & 31; const int sc = n_ < 8 ? 4096 + n_ : n_ < 16 ? 8200 + (n_ - 8) : n_ < 24 ? 8208 + (n_ - 16) : -1;
#pragma unroll 8
    for (int i = 0; i < 32; ++i) { const int kk = 2 * i + (lane >> 5); scr[kk * 33 + (lane & 31)] = sc >= 0 ? W[(size_t)(k0 + kk) * ldw + sc] : 0.f; }
    LDS_WAIT(); asm volatile("" ::: "memory");
    const int c = lane & 7;
#pragma unroll
    for (int j = 0; j < 4; ++j) { const int n = (lane >> 3) + 8 * j; const LAS float* s = scr + (8 * c) * 33 + n;
        v4u o; o.x = pk2(s[0 * 33], s[1 * 33]); o.y = pk2(s[2 * 33], s[3 * 33]); o.z = pk2(s[4 * 33], s[5 * 33]); o.w = pk2(s[6 * 33], s[7 * 33]);
        *(v4u*)(WT + (size_t)n * K + k0 + 8 * c) = o; }
    LDS_WAIT(); asm volatile("" ::: "memory");
}
struct XRow { pg8::f32x4 v[8]; };
__device__ __forceinline__ void xrow_load(XRow& R, const float* x, int m, int lane) {
    const pg8::f32x4* xr = (const pg8::f32x4*)(x + (size_t)m * DM) + 2 * lane;
#pragma unroll
    for (int j = 0; j < 4; ++j) { R.v[2 * j] = xr[128 * j]; R.v[2 * j + 1] = xr[128 * j + 1]; }
}
__device__ __forceinline__ void xrow_store(const XRow& R, const pg8::f32x4 (&g)[8], bf16* XN, int m, int lane) {
    float s = 0.f;
#pragma unroll
    for (int j = 0; j < 8; ++j) s += (R.v[j][0] * R.v[j][0] + R.v[j][1] * R.v[j][1]) + (R.v[j][2] * R.v[j][2] + R.v[j][3] * R.v[j][3]);
    const float rstd = 1.0f / sqrtf(wave_sum(s) * (1.f / DM) + NORM_EPS);
    v4u* o = (v4u*)(XN + (size_t)m * DM) + lane;
#pragma unroll
    for (int j = 0; j < 4; ++j) { const pg8::f32x4 a0 = R.v[2 * j] * rstd * g[2 * j], a1 = R.v[2 * j + 1] * rstd * g[2 * j + 1];
        v4u w; w.x = pk2(a0[0], a0[1]); w.y = pk2(a0[2], a0[3]); w.z = pk2(a1[0], a1[1]); w.w = pk2(a1[2], a1[3]); o[64 * j] = w; }
}
struct TTile { const float* src; bf16* dst; int ldw; };
__device__ __forceinline__ void ttile_load(const TTile& t, pg8::f32x4 (&r)[8], int wave, int lane) {
#pragma unroll
    for (int i = 0; i < 8; ++i) r[i] = *(const pg8::f32x4*)(t.src + (size_t)(8 * i + wave) * t.ldw + 4 * lane);
}
__device__ __forceinline__ void phase_prep(const Args& a, LAS unsigned char* lds, int nblk, int blk) {
    const int tid = threadIdx.x, lane = tid & 63, wave = tid >> 6;
    const int gw = blk * NWAVES + wave, NGW = nblk * NWAVES;
    const float* win = a.in[IN_WIN]; const float* wout = a.in[IN_WOUT];
    bf16* WIN_T = (bf16*)(a.ws + WS_WIN); bf16* WG_T = (bf16*)(a.ws + WS_WGT); bf16* WOUT_T = (bf16*)(a.ws + WS_WOUT);
    constexpr int T_MAIN = 32 * 32, T_OUT = 32 * 8, NTILES = T_MAIN + T_OUT, TP = 260;
    LAS float* tile = (LAS float*)lds;
#define P0_DECODE(it_, T_) do { int r_ = (it_); if (r_ < T_MAIN) { const int kb = r_ >> 5, n0 = 256 * (r_ & 31); T_.src = win + (size_t)(64 * kb) * IN_COLS + (n0 < 4096 ? n0 : n0 + 8); T_.dst = WIN_T + (size_t)n0 * DM + 64 * kb; T_.ldw = IN_COLS; } \
        else { r_ -= T_MAIN; const int kb = r_ >> 3, n0 = 256 * (r_ & 7); T_.src = wout + (size_t)(64 * kb) * DM + n0; T_.dst = WOUT_T + (size_t)n0 * DM + 64 * kb; T_.ldw = DM; } } while (0)
    if (!(a.flags & 1)) {
        TTile T; pg8::f32x4 r[8];
        int it = blk; if (it < NTILES) { P0_DECODE(it, T); ttile_load(T, r, wave, lane); }
        for (; it < NTILES; it += nblk) {
#pragma unroll
            for (int i = 0; i < 8; ++i) { const int k = 8 * i + wave; *(LAS pg8::f32x4*)(tile + k * TP + ((4 * lane + 4 * i) & 255)) = r[i]; }
            const bf16* dummy = nullptr; (void)dummy;
            bf16* dst = T.dst;
            const int itn = it + nblk; { const int itc = itn < NTILES ? itn : it; P0_DECODE(itc, T); ttile_load(T, r, wave, lane); } __builtin_amdgcn_sched_barrier(0);
            __syncthreads();
            const int c = lane & 7;
#pragma unroll
            for (int j = 0; j < 4; ++j) { const int n = 32 * wave + 8 * j + (lane >> 3); const LAS float* s = tile + (8 * c) * TP + ((n + 4 * c) & 255);
                v4u o; o.x = pk2(s[0 * TP], s[1 * TP]); o.y = pk2(s[2 * TP], s[3 * TP]); o.z = pk2(s[4 * TP], s[5 * TP]); o.w = pk2(s[6 * TP], s[7 * TP]);
                *(v4u*)(dst + (size_t)n * DM + 8 * c) = o; }
            __syncthreads();
        }
        if (gw < 32) p0_transpose_gate(win, IN_COLS, 64 * gw, WG_T, DM, (LAS float*)(lds + wave * 16384), lane);
        __syncthreads();
    }
#undef P0_DECODE
    const float* x = a.in[IN_X]; bf16* XN = (bf16*)(a.ws + WS_XN);
    pg8::f32x4 g[8];
    { const pg8::f32x4* wr = (const pg8::f32x4*)a.in[IN_NORMW] + 2 * lane;
#pragma unroll
      for (int j = 0; j < 4; ++j) { g[2 * j] = wr[128 * j]; g[2 * j + 1] = wr[128 * j + 1]; } }
    XRow R0, R1, R2, R3;
    int m = (a.flags & 2) ? M_TOK : gw;
#define XLD(R_, m_) do { xrow_load(R_, x, (m_) < M_TOK ? (m_) : M_TOK - 1, lane); __builtin_amdgcn_sched_barrier(0); } while (0)
#define XST(R_, m_) do { if ((m_) < M_TOK) xrow_store(R_, g, XN, (m_), lane); __builtin_amdgcn_sched_barrier(0); } while (0)
    XLD(R0, m); XLD(R1, m + NGW); XLD(R2, m + 2 * NGW);
    for (; m < M_TOK; m += 4 * NGW) {
        XLD(R3, m + 3 * NGW); XST(R0, m);
        XLD(R0, m + 4 * NGW); XST(R1, m + NGW);
        XLD(R1, m + 5 * NGW); XST(R2, m + 2 * NGW);
        XLD(R2, m + 6 * NGW); XST(R3, m + 3 * NGW);
    }
#undef XLD
#undef XST
}

__device__ __forceinline__ void gate_unit(const Args& a, LAS unsigned char* lds, int c) {
    const int tid = threadIdx.x, lane = tid & 63, wave = tid >> 6, r32 = lane & 31, hi = lane >> 5;
    const bf16* XN = (const bf16*)(a.ws + WS_XN); const bf16* WG_T = (const bf16*)(a.ws + WS_WGT);
    f32x16 acc0 = {}, acc1 = {};
    const bf16* a0 = XN + (size_t)(64 * c + r32) * DM + 256 * wave + 8 * hi; const bf16* a1 = a0 + (size_t)32 * DM;
    const bf16* bp = WG_T + (size_t)r32 * DM + 256 * wave + 8 * hi;
#pragma unroll 8
    for (int ks = 0; ks < 16; ++ks) {
        const pg8::bf16x8 A0 = *(const pg8::bf16x8*)(a0 + 16 * ks), A1 = *(const pg8::bf16x8*)(a1 + 16 * ks), Bf = *(const pg8::bf16x8*)(bp + 16 * ks);
        acc0 = __builtin_amdgcn_mfma_f32_32x32x16_bf16(A0, Bf, acc0, 0, 0, 0);
        acc1 = __builtin_amdgcn_mfma_f32_32x32x16_bf16(A1, Bf, acc1, 0, 0, 0);
    }
    LAS float* part = (LAS float*)lds;
#pragma unroll
    for (int r = 0; r < 16; ++r) { const int row = (r & 3) + 8 * (r >> 2) + 4 * hi;
        part[(wave * 64 + row) * 32 + r32] = acc0[r]; part[(wave * 64 + 32 + row) * 32 + r32] = acc1[r]; }
    __syncthreads();
    float* G = (float*)(a.ws + WS_GATE);
    for (int e = tid; e < 64 * 32; e += NTHREADS) { const int row = e >> 5, j = e & 31; float s = 0.f;
#pragma unroll
        for (int w = 0; w < 8; ++w) s += part[(w * 64 + row) * 32 + j];
        float v;
        if (j < 8) v = logsigmoidf(s + a.in[IN_FOXFB][j]); else if (j < 16) v = s + a.in[IN_MIB][j - 8]; else if (j < 24) v = logsigmoidf(s + a.in[IN_MFB][j - 16]); else v = 0.f;
        G[(size_t)(64 * c + row) * 32 + j] = v; }
    __syncthreads();
}

__device__ __forceinline__ void fox_cumsum_item(const Args& a, LAS unsigned char* lds, int it) {
    const int tid = threadIdx.x, lane = tid & 63, wave = tid >> 6; const int bh = it >> 3, part = it & 7, b = bh >> 3, h = bh & 7;
    const float* G = (const float*)(a.ws + WS_GATE) + (size_t)b * SEQ * 32 + h; bf16* KB = (bf16*)(a.ws + WS_KBIAS);
    LAS float* wtot = (LAS float*)lds;
    const int s = part * 512 + tid;
    const float v = G[(size_t)s * 32];
    float pre = 0.f;
    for (int j = 0; j < part; ++j) pre += G[(size_t)(j * 512 + tid) * 32];
    const float incl = wave_scan_add(v);
    pre = wave_sum(pre);
    if (lane == 63) wtot[wave] = incl;
    if (lane == 0) wtot[8 + wave] = pre;
    __syncthreads();
    float base = 0.f;
#pragma unroll
    for (int w = 0; w < 8; ++w) { base += wtot[8 + w]; if (w < wave) base += wtot[w]; }
    const float kb2 = -(base + incl) * LOG2E;
    const unsigned h1 = f2bf(kb2); const float r1 = kb2 - bf2f(h1); const unsigned h2 = f2bf(r1); const float r2 = r1 - bf2f(h2); const unsigned h3 = f2bf(r2);
    v4u o; o.x = h1 | (h2 << 16); o.y = h3; o.z = 0u; o.w = 0u;
    *(v4u*)(KB + ((size_t)bh * SEQ + s) * 8) = o;
    if ((s & 63) == 63) ((float*)(a.ws + WS_KBND))[bh * 64 + (s >> 6)] = kb2 + 0.01f;
    __syncthreads();
}

struct ORow { pg8::f32x4 v[8]; v4u d[4]; };
__device__ __forceinline__ void orow_load(ORow& R, const float* x, const bf16* delta, int m, int lane) {
    const pg8::f32x4* xr = (const pg8::f32x4*)(x + (size_t)m * DM) + 2 * lane; const v4u* dr = (const v4u*)(delta + (size_t)m * DM) + lane;
#pragma unroll
    for (int j = 0; j < 4; ++j) { R.v[2 * j] = xr[128 * j]; R.v[2 * j + 1] = xr[128 * j + 1]; R.d[j] = dr[64 * j]; }
}
__device__ __forceinline__ void orow_store(ORow& R, const pg8::f32x4 (&g)[8], float* out, int m, int lane) {
    float s = 0.f;
#pragma unroll
    for (int j = 0; j < 4; ++j) { const v4u d = R.d[j];
        R.v[2 * j] += (pg8::f32x4){bflo(d.x), bfhi(d.x), bflo(d.y), bfhi(d.y)}; R.v[2 * j + 1] += (pg8::f32x4){bflo(d.z), bfhi(d.z), bflo(d.w), bfhi(d.w)};
        const pg8::f32x4 a0 = R.v[2 * j], a1 = R.v[2 * j + 1];
        s += ((a0[0] * a0[0] + a0[1] * a0[1]) + (a0[2] * a0[2] + a0[3] * a0[3])) + ((a1[0] * a1[0] + a1[1] * a1[1]) + (a1[2] * a1[2] + a1[3] * a1[3])); }
    const float rstd = 1.0f / sqrtf(wave_sum(s) * (1.f / DM) + NORM_EPS);
    pg8::f32x4* o = (pg8::f32x4*)(out + (size_t)m * DM) + 2 * lane;
#pragma unroll
    for (int j = 0; j < 4; ++j) { o[128 * j] = R.v[2 * j] * rstd * g[2 * j]; o[128 * j + 1] = R.v[2 * j + 1] * rstd * g[2 * j + 1]; }
}
__device__ __forceinline__ void phase_final(const Args& a, int nblk, int blk) {
    const int tid = threadIdx.x, lane = tid & 63, wave = tid >> 6; const int gw = blk * NWAVES + wave, NGW = nblk * NWAVES;
    const bf16* delta = (const bf16*)(a.ws + WS_DELTA); const float* x = a.in[IN_X];
    pg8::f32x4 g[8];
    { const pg8::f32x4* wr = (const pg8::f32x4*)a.in[IN_FINW] + 2 * lane;
#pragma unroll
      for (int j = 0; j < 4; ++j) { g[2 * j] = wr[128 * j]; g[2 * j + 1] = wr[128 * j + 1]; } }
    ORow RA, RB;
    int m = gw; orow_load(RA, x, delta, m < M_TOK ? m : M_TOK - 1, lane);
    for (; m < M_TOK; m += 2 * NGW) {
        const int mb = m + NGW, mc = m + 2 * NGW;
        orow_load(RB, x, delta, mb < M_TOK ? mb : M_TOK - 1, lane); __builtin_amdgcn_sched_barrier(0);
        orow_store(RA, g, a.out, m, lane); __builtin_amdgcn_sched_barrier(0);
        orow_load(RA, x, delta, mc < M_TOK ? mc : M_TOK - 1, lane); __builtin_amdgcn_sched_barrier(0);
        if (mb < M_TOK) orow_store(RB, g, a.out, mb, lane);
        __builtin_amdgcn_sched_barrier(0);
    }
}

namespace fox {
typedef short bf16x8 __attribute__((ext_vector_type(8)));
typedef short s16x4 __attribute__((ext_vector_type(4)));
typedef float f32x16 __attribute__((ext_vector_type(16)));
typedef unsigned u32x4 __attribute__((ext_vector_type(4)));
typedef LAS char* lptr;
constexpr int D = 128, NW = 8, QBLK = 32, KVBLK = 64, QB = NW * QBLK;
constexpr int SHM_V = KVBLK * D * 2, SHM_K = KVBLK * D * 2;
constexpr int OFF_V = 0, OFF_K = 2 * SHM_V, OFF_WS = 2 * SHM_V + 2 * SHM_K, OFF_KB = OFF_WS + NW * 64 * 4, OFF_VOTE = OFF_KB + 2 * 1024, LDS_NEED = OFF_VOTE + 64;
constexpr int OFF_KSUF = 73728;
constexpr float THR2 = 11.5f;
#define KSWZ(row, colB) ((row) * 256 + ((colB) ^ (((row) & 7) << 4)))
#define SBAR() __builtin_amdgcn_sched_barrier(0)
__device__ __forceinline__ int v_st(int k, int c) { const int kk = (k & ~0xC) | ((k & 4) << 1) | ((k & 8) >> 1); return ((kk >> 3) * 4 + (c >> 5)) * 512 + ((kk & 7) * 32 + (c & 31)) * 2; }
__device__ __forceinline__ int v_rd_base(int lane) { return ((lane & 3) << 3) | (((lane >> 2) & 3) << 6) | (((lane >> 4) & 1) << 5) | (((lane >> 5) & 1) << 8); }
constexpr int v_rd_off(int d0, int ks, int half) { return d0 * 512 + ks * 4096 + half * 2048; }
__device__ __forceinline__ int crow(int r, int hi) { return (r & 3) + 8 * (r >> 2) + 4 * hi; }
__device__ __forceinline__ unsigned cvtpk(float lo, float hi) { return pk2(lo, hi); }
__device__ __forceinline__ void mask_tile(f32x16& p0, f32x16& p1, int dq) {
    const float NEG = -__builtin_inff();
#pragma unroll
    for (int r = 0; r < 16; ++r) { const int c = (r & 3) + 8 * (r >> 2);
        if (dq - c < 0) p0[r] = NEG;
        if (dq - c - 32 < 0) p1[r] = NEG; }
}
__device__ __forceinline__ void partialSM(f32x16& p0, f32x16& p1, float& m_reg, float& mn, float& alpha) {
    float pmax = p0[0];
#pragma unroll
    for (int r = 1; r < 16; ++r) pmax = fmaxf(pmax, p0[r]);
#pragma unroll
    for (int r = 0; r < 16; ++r) pmax = fmaxf(pmax, p1[r]);
    { auto rr = __builtin_amdgcn_permlane32_swap(__float_as_uint(pmax), __float_as_uint(pmax), false, false);
      pmax = fmaxf(__uint_as_float(rr[0]), __uint_as_float(rr[1])); }
    if (__builtin_expect(__all((pmax - m_reg) <= THR2), 1)) { mn = m_reg; alpha = 1.f; }
    else { mn = fmaxf(m_reg, pmax); alpha = __builtin_amdgcn_exp2f(m_reg - mn); m_reg = mn; }
#pragma unroll
    for (int r = 0; r < 16; ++r) p0[r] = p0[r] - mn;
#pragma unroll
    for (int r = 0; r < 16; ++r) p1[r] = p1[r] - mn;
#pragma unroll
    for (int r = 0; r < 16; ++r) p0[r] = __builtin_amdgcn_exp2f(p0[r]);
}
__device__ __forceinline__ void finishSM(f32x16& p0, f32x16& p1, float alpha, float& l_reg, bf16x8& pa0, bf16x8& pa1, bf16x8& pa2, bf16x8& pa3) {
#pragma unroll
    for (int r = 0; r < 16; ++r) p1[r] = __builtin_amdgcn_exp2f(p1[r]);
    float ps = 0;
#pragma unroll
    for (int r = 0; r < 16; ++r) ps += p0[r];
#pragma unroll
    for (int r = 0; r < 16; ++r) ps += p1[r];
    { auto rr = __builtin_amdgcn_permlane32_swap(__float_as_uint(ps), __float_as_uint(ps), false, false);
      ps = __uint_as_float(rr[0]) + __uint_as_float(rr[1]); }
    l_reg = l_reg * alpha + ps;
#define PK4(P, B_, OUT) do { unsigned a0 = cvtpk(P[B_+0], P[B_+1]), a1 = cvtpk(P[B_+2], P[B_+3]);                          \
        unsigned b0 = cvtpk(P[B_+4], P[B_+5]), b1 = cvtpk(P[B_+6], P[B_+7]);                                             \
        auto r0 = __builtin_amdgcn_permlane32_swap(a0, b0, false, false); auto r1 = __builtin_amdgcn_permlane32_swap(a1, b1, false, false); \
        u32x4 w = {r0[0], r1[0], r0[1], r1[1]}; OUT = __builtin_bit_cast(bf16x8, w); } while (0)
    PK4(p0, 0, pa0); PK4(p0, 8, pa1); PK4(p1, 0, pa2); PK4(p1, 8, pa3);
#undef PK4
}
template <int KB>
__device__ __forceinline__ void qkt(f32x16& p0, f32x16& p1, lptr lds, int r32, int hi, const bf16x8* qr, bf16x8 qone) {
    p0 = f32x16{}; p1 = f32x16{};
    __builtin_amdgcn_s_setprio(1);
    lptr kb[4];
#pragma unroll
    for (int dd = 0; dd < 4; ++dd) kb[dd] = lds + OFF_K + KB * SHM_K + KSWZ(r32, (dd * 16 + hi * 8) * 2);
#pragma unroll
    for (int d0 = 0; d0 < 8; ++d0) { lptr a = kb[d0 & 3] + (d0 >> 2) * 128;
        bf16x8 b0 = *(const LAS bf16x8*)(a);
        bf16x8 b1 = *(const LAS bf16x8*)(a + 32 * 256);
        p0 = __builtin_amdgcn_mfma_f32_32x32x16_bf16(b0, qr[d0], p0, 0, 0, 0);
        p1 = __builtin_amdgcn_mfma_f32_32x32x16_bf16(b1, qr[d0], p1, 0, 0, 0); }
    { lptr a = lds + OFF_KB + KB * 1024 + r32 * 16;
        bf16x8 b0 = *(const LAS bf16x8*)(a);
        bf16x8 b1 = *(const LAS bf16x8*)(a + 512);
        p0 = __builtin_amdgcn_mfma_f32_32x32x16_bf16(b0, qone, p0, 0, 0, 0);
        p1 = __builtin_amdgcn_mfma_f32_32x32x16_bf16(b1, qone, p1, 0, 0, 0); }
    __builtin_amdgcn_s_setprio(0);
}
template <int VB>
__device__ __forceinline__ void pv_tile(f32x16* o, int vb0, bf16x8 pa0, bf16x8 pa1, bf16x8 pa2, bf16x8 pa3) {
#define TRRD(dst, off) asm volatile("ds_read_b64_tr_b16 %0, %1 offset:%2" : "=&v"(dst) : "v"(vb0), "i"(off) : "memory")
#define PV_D0(d0) do { s16x4 l0, l1, l2, l3, h0, h1, h2, h3; constexpr int b_ = OFF_V + VB * SHM_V + v_rd_off(d0, 0, 0); \
        TRRD(l0, b_); TRRD(h0, b_ + 2048); TRRD(l1, b_ + 4096); TRRD(h1, b_ + 6144); TRRD(l2, b_ + 8192); TRRD(h2, b_ + 10240); TRRD(l3, b_ + 12288); TRRD(h3, b_ + 14336); \
        asm volatile("s_waitcnt lgkmcnt(0)" ::: "memory"); SBAR();   \
        o[d0] = __builtin_amdgcn_mfma_f32_32x32x16_bf16(pa0, (bf16x8){l0[0], l0[1], l0[2], l0[3], h0[0], h0[1], h0[2], h0[3]}, o[d0], 0, 0, 0);   \
        o[d0] = __builtin_amdgcn_mfma_f32_32x32x16_bf16(pa1, (bf16x8){l1[0], l1[1], l1[2], l1[3], h1[0], h1[1], h1[2], h1[3]}, o[d0], 0, 0, 0);   \
        o[d0] = __builtin_amdgcn_mfma_f32_32x32x16_bf16(pa2, (bf16x8){l2[0], l2[1], l2[2], l2[3], h2[0], h2[1], h2[2], h2[3]}, o[d0], 0, 0, 0);   \
        o[d0] = __builtin_amdgcn_mfma_f32_32x32x16_bf16(pa3, (bf16x8){l3[0], l3[1], l3[2], l3[3], h3[0], h3[1], h3[2], h3[3]}, o[d0], 0, 0, 0); } while (0)
    __builtin_amdgcn_s_setprio(1); PV_D0(0); PV_D0(1); PV_D0(2); PV_D0(3); __builtin_amdgcn_s_setprio(0);
#undef PV_D0
#undef TRRD
}
struct BlockRef { const bf16* Q; const bf16* K; const bf16* V; const bf16* KB; const LAS float* ksuf; const float* kbnd; int P0; int tok0; int h; };
struct Seam { bf16x8 qr[8]; bf16x8 st_v0, st_v1, st_k0, st_k1; u32x4 st_kb; };
#define VMW() asm volatile("s_waitcnt vmcnt(0)" ::: "memory")
#define BL128(rs, vo, so) __builtin_bit_cast(bf16x8, __builtin_amdgcn_raw_buffer_load_b128(rs, (int)(vo), (int)(so), 0))
#define SLOAD_H(k0) do { const int so_ = (k0) * 256; S.st_v0 = BL128(rsV, voffKV, so_); S.st_v1 = BL128(rsV, voffKV, so_ + 8192);              \
                         S.st_k0 = BL128(rsK, voffKV, so_); S.st_k1 = BL128(rsK, voffKV, so_ + 8192); \
                         S.st_kb = __builtin_amdgcn_raw_buffer_load_b128(rsB, lane * 16, (k0) * 16, 0); } while (0)
#define SWRITE_HK(bf) do { *(LAS bf16x8*)(lds + OFF_K + (bf) * SHM_K + kws) = S.st_k0; *(LAS bf16x8*)(lds + OFF_K + (bf) * SHM_K + kws + 32 * 256) = S.st_k1; \
                         if (wid == 0) *(LAS u32x4*)(lds + OFF_KB + (bf) * 1024 + lane * 16) = S.st_kb; } while (0)
#define SWRITE_HV(bf) do { *(LAS bf16x8*)(lds + OFF_V + (bf) * SHM_V + vst0) = S.st_v0; *(LAS bf16x8*)(lds + OFF_V + (bf) * SHM_V + vst1) = S.st_v1; } while (0)
#define SWRITE_H(bf) do { SWRITE_HV(bf); SWRITE_HK(bf); } while (0)
__device__ __forceinline__ __amdgpu_buffer_rsrc_t mk_rsrc(const void* p, unsigned bytes) {
    const unsigned long long v = (unsigned long long)p; const unsigned lo = __builtin_amdgcn_readfirstlane((unsigned)v), hi = __builtin_amdgcn_readfirstlane((unsigned)(v >> 32));
    return __builtin_amdgcn_make_buffer_rsrc((void*)(((unsigned long long)hi << 32) | lo), 0, bytes, 0x00020000);
}
struct EpiParams { const float* g; const bf16* FZ; bf16* Y; };
__device__ __forceinline__ void block(const BlockRef& cur, lptr lds, const EpiParams& E, unsigned* ctr, int blk, LAS int* slot) {
    Seam S;
    const int tid = threadIdx.x, wid = __builtin_amdgcn_readfirstlane(tid >> 6), lane = tid & 63, r32 = lane & 31, hi = lane >> 5;
    const int NT = (cur.P0 + QB) / KVBLK;
    int NTe = NT;
    LAS int* vote = (LAS int*)(lds + OFF_VOTE);
    const int qlo = cur.P0 + wid * QBLK, qm = qlo + r32 - 4 * hi;
    LAS float* ws = (LAS float*)(lds + OFF_WS) + wid * 64; LAS float* li_l = ws; LAS float* al_l = ws + 32;
    float m_reg = -1e30f, l_reg = 0; f32x16 o[4] = {};
    const int sr = tid >> 4, sc = (tid & 15) * 8, vst0 = v_st(sr, sc), vst1 = v_st(32 + sr, sc), kws = KSWZ(sr, sc * 2);
    const int vb0 = (int)(uintptr_t)(lds) + v_rd_base(lane);
    const __amdgpu_buffer_rsrc_t rsK = mk_rsrc(cur.K, SEQ * 256), rsV = mk_rsrc(cur.V, SEQ * 256), rsB = mk_rsrc(cur.KB, SEQ * 16), rsQ = mk_rsrc(cur.Q, QB * 256);
    const int voffKV = (sr * D + sc) * 2;
    bf16x8 qone; { u32x4 w = {hi ? 0u : 0x3F803F80u, hi ? 0u : 0x00003F80u, 0u, 0u}; qone = __builtin_bit_cast(bf16x8, w); }
#define RESC(a) do { if (__any((a) < 1.f)) { if (hi == 0) al_l[r32] = (a); asm volatile("s_waitcnt lgkmcnt(0)" ::: "memory");              \
                     _Pragma("unroll") for (int d_ = 0; d_ < 4; ++d_) _Pragma("unroll") for (int r = 0; r < 16; ++r) o[d_][r] *= al_l[crow(r, hi)]; } } while (0)
#define KBASE(t) ((NT - 1 - (t)) * KVBLK)
#define MASKT(P0_, P1_, t) do { const int kb_ = KBASE(t); if (kb_ + KVBLK - 1 > qlo) mask_tile(P0_, P1_, qm - kb_); } while (0)
    f32x16 pA0, pA1, pB0, pB1; float mnA, mnB, alA, alB; bf16x8 pa0, pa1, pa2, pa3;
    { const int voffQ = ((wid * QBLK + r32) * D + hi * 8) * 2;
#pragma unroll
      for (int d0 = 0; d0 < 8; ++d0) S.qr[d0] = BL128(rsQ, voffQ, d0 * 32); }
    float qn;
    { float ssq = 0.f;
#pragma unroll
      for (int d0 = 0; d0 < 8; ++d0) { const u32x4 w = __builtin_bit_cast(u32x4, S.qr[d0]);
          ssq += (bflo(w.x) * bflo(w.x) + bfhi(w.x) * bfhi(w.x)) + (bflo(w.y) * bflo(w.y) + bfhi(w.y) * bfhi(w.y)) + (bflo(w.z) * bflo(w.z) + bfhi(w.z) * bfhi(w.z)) + (bflo(w.w) * bflo(w.w) + bfhi(w.w) * bfhi(w.w)); }
      auto rr = __builtin_amdgcn_permlane32_swap(__float_as_uint(ssq), __float_as_uint(ssq), false, false);
      qn = sqrtf(__uint_as_float(rr[0]) + __uint_as_float(rr[1])) * 1.001f; }
    SLOAD_H(KBASE(0)); VMW(); SWRITE_HK(0);
    __syncthreads();
    SWRITE_HV(0); SBAR();
    SLOAD_H(KBASE(1));
    SBAR(); qkt<0>(pA0, pA1, lds, r32, hi, S.qr, qone);
    MASKT(pA0, pA1, 0); partialSM(pA0, pA1, m_reg, mnA, alA);
    VMW(); SWRITE_H(1);
    __syncthreads();
#define HALF_STEP(PX0, PX1, mnX, alX, PY0, PY1, alY, t, KB, VB, SB, VOTE) do {                                                      \
        SBAR(); qkt<KB>(PX0, PX1, lds, r32, hi, S.qr, qone);                                             \
        finishSM(PY0, PY1, alY, l_reg, pa0, pa1, pa2, pa3); SBAR();                                                           \
        if ((t) + 1 < NTe) { SLOAD_H(KBASE((t) + 1)); SBAR(); }                                               \
        pv_tile<VB>(o, vb0, pa0, pa1, pa2, pa3); MASKT(PX0, PX1, (t)); partialSM(PX0, PX1, m_reg, mnX, alX);                                        \
        const int jj_ = NT - 1 - ((t) + 2);                                                                                   \
        if (VOTE && jj_ >= 0) { const bool sk_ = __all(qn * cur.ksuf[jj_] + cur.kbnd[jj_] - m_reg < -152.f); if (lane == 0) vote[wid] = sk_ ? 1 : 0; }                      \
        __syncthreads();                                                                                                      \
        if ((t) + 1 < NTe) { VMW(); SWRITE_H(SB); }                                                                          \
        if (VOTE && jj_ >= 0) { const int v_ = vote[lane & 7]; if (__all(v_ != 0)) NTe = (t) + 2; }                                          \
        RESC(alX); __syncthreads(); } while (0)
    for (int t = 1; t + 1 < NTe; t += 2) {
        HALF_STEP(pB0, pB1, mnB, alB, pA0, pA1, alA, t, 1, 0, 0, false);
        HALF_STEP(pA0, pA1, mnA, alA, pB0, pB1, alB, t + 1, 0, 1, 1, true);
    }
    SBAR(); qkt<1>(pB0, pB1, lds, r32, hi, S.qr, qone); SBAR();
    finishSM(pA0, pA1, alA, l_reg, pa0, pa1, pa2, pa3); SBAR();
    pv_tile<0>(o, vb0, pa0, pa1, pa2, pa3);
    MASKT(pB0, pB1, NTe - 1); partialSM(pB0, pB1, m_reg, mnB, alB); __syncthreads(); RESC(alB);
    finishSM(pB0, pB1, alB, l_reg, pa0, pa1, pa2, pa3); SBAR(); pv_tile<1>(o, vb0, pa0, pa1, pa2, pa3);
    SBAR();
    if (tid == 0) { int it_ = -1;
        for (int k_ = 0; k_ < 8; ++k_) { const int q_ = (blk + k_) & 7; const unsigned i_ = atomicAdd(&ctr[q_ * 64], 1u); if (i_ < 64u) { it_ = q_ * 64 + (int)i_; break; } }
        *slot = it_; }
    if (hi == 0) li_l[r32] = l_reg; asm volatile("s_waitcnt lgkmcnt(0)" ::: "memory");
    {
        LAS float* stg = (LAS float*)(lds + OFF_K) + wid * 1024;
        int lane_o = lane; asm volatile("" : "+v"(lane_o));
        const int erow = lane_o >> 3, seg = lane_o & 7;
        const float* gp = E.g + cur.h * 128 + seg * 16;
        pg8::f32x4 g4[4];
#pragma unroll
        for (int j = 0; j < 4; ++j) g4[j] = *(const pg8::f32x4*)(gp + 4 * j);
        const unsigned trow = (unsigned)(cur.tok0 + wid * QBLK);
#pragma unroll
        for (int p = 0; p < 4; ++p) {
            const unsigned tokr = trow + 8u * p + (unsigned)erow;
            const bf16* zp = E.FZ + (tokr * 1024u + (unsigned)(cur.h * 128 + seg * 16));
            const u32x4 z0 = *(const u32x4*)zp, z1 = *(const u32x4*)(zp + 8);
#pragma unroll
            for (int rr = 0; rr < 4; ++rr) { const int r = 4 * p + rr; const float rl = __builtin_amdgcn_rcpf(li_l[crow(r, hi)]);
#pragma unroll
                for (int d0 = 0; d0 < 4; ++d0) stg[(rr + 4 * hi) * 128 + d0 * 32 + r32] = o[d0][r] * rl; }
            asm volatile("s_waitcnt lgkmcnt(0)" ::: "memory");
            float x[16]; float ss = 0.f;
#pragma unroll
            for (int j = 0; j < 4; ++j) { const pg8::f32x4 v = *(const LAS pg8::f32x4*)(stg + erow * 128 + seg * 16 + 4 * j); x[4 * j] = v[0]; x[4 * j + 1] = v[1]; x[4 * j + 2] = v[2]; x[4 * j + 3] = v[3];
                ss += (v[0] * v[0] + v[1] * v[1]) + (v[2] * v[2] + v[3] * v[3]); }
            asm volatile("s_waitcnt lgkmcnt(0)" ::: "memory");
            ss += __shfl_xor(ss, 1); ss += __shfl_xor(ss, 2); ss += __shfl_xor(ss, 4);
            const float rs = 1.0f / sqrtf(ss * (1.f / 128.f) + NORM_EPS);
            float zf[16]; zf[0] = bflo(z0.x); zf[1] = bfhi(z0.x); zf[2] = bflo(z0.y); zf[3] = bfhi(z0.y); zf[4] = bflo(z0.z); zf[5] = bfhi(z0.z); zf[6] = bflo(z0.w); zf[7] = bfhi(z0.w);
            zf[8] = bflo(z1.x); zf[9] = bfhi(z1.x); zf[10] = bflo(z1.y); zf[11] = bfhi(z1.y); zf[12] = bflo(z1.z); zf[13] = bfhi(z1.z); zf[14] = bflo(z1.w); zf[15] = bfhi(z1.w);
            float y[16];
#pragma unroll
            for (int e = 0; e < 16; ++e) y[e] = x[e] * rs * g4[e >> 2][e & 3] * (zf[e] * __builtin_amdgcn_rcpf(1.f + __builtin_amdgcn_exp2f(-zf[e] * LOG2E)));
            u32x4 o0, o1; o0.x = cvtpk(y[0], y[1]); o0.y = cvtpk(y[2], y[3]); o0.z = cvtpk(y[4], y[5]); o0.w = cvtpk(y[6], y[7]);
            o1.x = cvtpk(y[8], y[9]); o1.y = cvtpk(y[10], y[11]); o1.z = cvtpk(y[12], y[13]); o1.w = cvtpk(y[14], y[15]);
            bf16* yp = E.Y + (tokr * 2048u + (unsigned)(cur.h * 128 + seg * 16));
            *(u32x4*)yp = o0; *(u32x4*)(yp + 8) = o1;
        }
    }
    __syncthreads();
#undef RESC
#undef KBASE
#undef MASKT
#undef HALF_STEP
}
#undef VMW
#undef BL128
#undef SLOAD_H
#undef SWRITE_HK
#undef SWRITE_HV
#undef SWRITE_H
#undef KSWZ
#undef SBAR
__device__ __forceinline__ BlockRef make_ref(const Args& a, lptr lds, int bh, int qb) {
    BlockRef r; const size_t hb = (size_t)bh * SEQ * 128;
    r.Q = (const bf16*)(a.ws + WS_SEC + SEC_FQ * SEC_BYTES) + hb + (size_t)qb * QB * 128;
    r.K = (const bf16*)(a.ws + WS_SEC + SEC_FK * SEC_BYTES) + hb; r.V = (const bf16*)(a.ws + WS_SEC + SEC_FV * SEC_BYTES) + hb;
    r.KB = (const bf16*)(a.ws + WS_KBIAS) + (size_t)bh * SEQ * 8;
    r.ksuf = (const LAS float*)(lds + OFF_KSUF) + bh * 64; r.kbnd = (const float*)(a.ws + WS_KBND) + bh * 64;
    r.P0 = qb * QB; r.tok0 = (bh >> 3) * SEQ + qb * QB; r.h = bh & 7; return r;
}
__device__ __forceinline__ void phase(const Args& a, lptr lds, int nblk, int blk) {
    const EpiParams E{a.in[IN_FOXNW], (const bf16*)(a.ws + WS_SEC + SEC_FZ * SEC_BYTES), (bf16*)(a.ws + WS_Y)};
    unsigned* ctr = (unsigned*)(a.ws + WS_CTL) + 1024; LAS int* slot = (LAS int*)(lds + OFF_VOTE + 32);
    {
        const int lane = threadIdx.x & 63, w4 = (threadIdx.x >> 6) * 4; float v[4];
#pragma unroll
        for (int k = 0; k < 4; ++k) v[k] = ((const float*)(a.ws + WS_KNRM))[(w4 + k) * 64 + lane];
#pragma unroll
        for (int k = 0; k < 4; ++k) ((LAS float*)(lds + OFF_KSUF))[(w4 + k) * 64 + lane] = wave_scan_max(v[k]);
    }
    if (threadIdx.x == 0) { int item = -1;
        for (int k = 0; k < 8; ++k) { const int q = (blk + k) & 7; const unsigned i = atomicAdd(&ctr[q * 64], 1u); if (i < 64u) { item = q * 64 + (int)i; break; } }
        *slot = item; }
    __syncthreads();
    for (;;) {
        const int item = __builtin_amdgcn_readfirstlane(*slot);
        if (item < 0) break;
        const int q = item >> 6, i = item & 63, qb = 15 - (i >> 2), sl = i & 3;
        const int h = (((q & 1) ? 0x7421 : 0x6530) >> (4 * sl)) & 0xF, bh = (q >> 1) * 8 + h;
        const BlockRef cur = make_ref(a, lds, bh, qb);
        block(cur, lds, E, ctr, blk, slot);
    }
    __syncthreads();
}
__device__ __forceinline__ void knorm_pass(const Args& a, int nblk, int blk) {
    const int tid = threadIdx.x, lane = tid & 63, wave = tid >> 6; const int gw = blk * NW + wave, NGW = nblk * NW;
    const bf16* FK = (const bf16*)(a.ws + WS_SEC + SEC_FK * SEC_BYTES); float* KN = (float*)(a.ws + WS_KNRM);
    for (int it = gw; it < BATCH * NH * 64; it += NGW) {
        const u32x4* kr = (const u32x4*)(FK + (size_t)it * 64 * 128) + lane;
        u32x4 w[16];
#pragma unroll
        for (int c = 0; c < 16; ++c) w[c] = kr[64 * c];
        float mx = 0.f;
#pragma unroll
        for (int c = 0; c < 16; ++c) { const u32x4 v = w[c];
            float ss = (bflo(v.x) * bflo(v.x) + bfhi(v.x) * bfhi(v.x)) + (bflo(v.y) * bflo(v.y) + bfhi(v.y) * bfhi(v.y)) + (bflo(v.z) * bflo(v.z) + bfhi(v.z) * bfhi(v.z)) + (bflo(v.w) * bflo(v.w) + bfhi(v.w) * bfhi(v.w));
            ss += __shfl_xor(ss, 1); ss += __shfl_xor(ss, 2); ss += __shfl_xor(ss, 4); ss += __shfl_xor(ss, 8);
            mx = fmaxf(mx, ss); }
        mx = fmaxf(mx, __shfl_xor(mx, 16)); mx = fmaxf(mx, __shfl_xor(mx, 32));
        if (lane == 0) KN[it] = sqrtf(mx) * 1.001f;
    }
}
}

namespace ml {
typedef short bf16x8 __attribute__((ext_vector_type(8)));
typedef short s16x4 __attribute__((ext_vector_type(4)));
typedef float f32x16 __attribute__((ext_vector_type(16)));
typedef unsigned u32x4 __attribute__((ext_vector_type(4)));
typedef LAS char* lptr;
constexpr int ROWP = 144;
__device__ __forceinline__ int crow(int r, int hi) { return (r & 3) + 8 * (r >> 2) + 4 * hi; }
__device__ __forceinline__ int t_st(int k, int c) { const int kk = (k & ~0xC) | ((k & 4) << 1) | ((k & 8) >> 1); return ((kk >> 3) * 4 + (c >> 5)) * 512 + ((kk & 7) * 32 + (c & 31)) * 2; }
__device__ __forceinline__ int t_rd_base(int lane) { return ((lane & 3) << 3) | (((lane >> 2) & 3) << 6) | (((lane >> 4) & 1) << 5) | (((lane >> 5) & 1) << 8); }
#define TRFRAG(dst, addr, ks) do { s16x4 l_, h_; asm volatile("ds_read_b64_tr_b16 %0, %1 offset:%2" : "=&v"(l_) : "v"(addr), "i"((ks) * 4096) : "memory"); \
        asm volatile("ds_read_b64_tr_b16 %0, %1 offset:%2" : "=&v"(h_) : "v"(addr), "i"((ks) * 4096 + 2048) : "memory"); \
        asm volatile("s_waitcnt lgkmcnt(0)" ::: "memory"); __builtin_amdgcn_sched_barrier(0); \
        dst = (bf16x8){l_[0], l_[1], l_[2], l_[3], h_[0], h_[1], h_[2], h_[3]}; } while (0)
__device__ __forceinline__ void unpack8(const u32x4 r, float* f) { f[0] = bflo(r.x); f[1] = bfhi(r.x); f[2] = bflo(r.y); f[3] = bfhi(r.y); f[4] = bflo(r.z); f[5] = bfhi(r.z); f[6] = bflo(r.w); f[7] = bfhi(r.w); }

__device__ __forceinline__ float fexp(float x) { return __builtin_amdgcn_exp2f(x * LOG2E); }
__device__ __forceinline__ float fsigmoid(float x) { return __builtin_amdgcn_rcpf(1.f + fexp(-x)); }
__device__ __forceinline__ float rdlane63(float v) { return __builtin_bit_cast(float, __builtin_amdgcn_readlane(__builtin_bit_cast(int, v), 63)); }
struct M1Pre { u32x4 raw[5]; u32x4 vr[2]; pg8::f32x4 cw[8]; pg8::f32x4 cb[2]; float lf, ig; };
__device__ __forceinline__ void m1_load(const Args& a, int g, M1Pre& P) {
    const int tid = threadIdx.x; const int bh = g >> 6, c = g & 63, b = bh >> 3, h = bh & 7; const int s0 = c * 64, tok0 = b * SEQ + s0;
    const int cgp = tid & 15, trow = tid >> 4, tA = 2 * trow; const int ch = (cgp >= 8 ? 512 : 0) + h * 64 + (cgp & 7) * 8;
    const bf16* MQK = (const bf16*)(a.ws + WS_SEC + SEC_MQK * SEC_BYTES);
#pragma unroll
    for (int j = 0; j < 5; ++j) { const int s = s0 + tA - 3 + j; P.raw[j] = *(const u32x4*)(MQK + (size_t)(tok0 + tA - 3 + j + (s < 0 ? 3 : 0)) * 1024 + ch); }
    const bf16* MV = (const bf16*)(a.ws + WS_SEC + SEC_MV * SEC_BYTES);
#pragma unroll
    for (int i = 0; i < 2; ++i) { const int ci = tid + 512 * i, s = ci >> 4, vc = (ci & 15) * 8; P.vr[i] = *(const u32x4*)(MV + (size_t)(tok0 + s) * 1024 + h * 128 + vc); }
    const float* cw = a.in[IN_CONVW] + ch; const float* cb = a.in[IN_CONVB] + ch;
#pragma unroll
    for (int j = 0; j < 4; ++j) { P.cw[2 * j] = *(const pg8::f32x4*)(cw + j * 1024); P.cw[2 * j + 1] = *(const pg8::f32x4*)(cw + j * 1024 + 4); }
    P.cb[0] = *(const pg8::f32x4*)cb; P.cb[1] = *(const pg8::f32x4*)(cb + 4);
    if (tid < 64) { const float* G = (const float*)(a.ws + WS_GATE); P.lf = G[(size_t)(tok0 + tid) * 32 + 16 + h]; P.ig = G[(size_t)(tok0 + tid) * 32 + 8 + h]; }
}
__device__ __forceinline__ void m1_phase(const Args& a, lptr lds, int nblk, int blk) {
    const int tid = threadIdx.x, lane = tid & 63, wid = __builtin_amdgcn_readfirstlane(tid >> 6), r32 = lane & 31, hi = lane >> 5;
    constexpr int NITEM = BATCH * NH * NCHUNK;
    LAS float* wgt = (LAS float*)(lds + 49152); LAS float* npart = (LAS float*)(lds + 49408);
    int g = blk; if (g >= NITEM) return;
    M1Pre P; m1_load(a, g, P);
    const int cgp = tid & 15, trow = tid >> 4, tA = 2 * trow; const bool isk = cgp >= 8; const int d0 = (cgp & 7) * 8;
    int par = 0;
    for (;;) {
        const int bh = g >> 6, c = g & 63, b = bh >> 3, h = bh & 7; const int s0 = c * 64; (void)b; (void)h;
        const int KOFF = 16384 + par * 16384;
        if (wid == 0) {
            const float bc = wave_scan_add(P.lf);
            const float bl = rdlane63(bc), w = bl - bc + P.ig, amax = rdlane63(wave_scan_max(w));
            wgt[lane] = fexp(w - amax);
            float* MST = (float*)(a.ws + WS_MST);
            if (lane == 0) { MST[(size_t)g * 4 + 0] = amax; MST[(size_t)g * 4 + 1] = bl; }
            const float u = P.ig - bc; const float gm = wave_scan_max(u);
            float* GV = (float*)(a.ws + WS_GV) + (size_t)g * 192; GV[lane] = bc; GV[64 + lane] = gm; GV[128 + lane] = u;
        }
        float yA[8], yB[8];
        {
            float u[5][8];
#pragma unroll
            for (int j = 0; j < 5; ++j) { unpack8(P.raw[j], u[j]); if (s0 + tA - 3 + j < 0) {
#pragma unroll
                for (int e = 0; e < 8; ++e) u[j][e] = 0.f; } }
            const float osc = isk ? 0.125f : 1.f;
#pragma unroll
            for (int e = 0; e < 8; ++e) { const float w0 = P.cw[e >> 2][e & 3], w1 = P.cw[2 + (e >> 2)][e & 3], w2 = P.cw[4 + (e >> 2)][e & 3], w3 = P.cw[6 + (e >> 2)][e & 3], bb = P.cb[e >> 2][e & 3];
                float sA = u[0][e] * w0; sA += u[1][e] * w1; sA += u[2][e] * w2; sA += u[3][e] * w3; sA += bb;
                float sB = u[1][e] * w0; sB += u[2][e] * w1; sB += u[3][e] * w2; sB += u[4][e] * w3; sB += bb;
                yA[e] = sA * fsigmoid(sA) * osc; yB[e] = sB * fsigmoid(sB) * osc; }
            u32x4 oA, oB; oA.x = pk2(yA[0], yA[1]); oA.y = pk2(yA[2], yA[3]); oA.z = pk2(yA[4], yA[5]); oA.w = pk2(yA[6], yA[7]);
            oB.x = pk2(yB[0], yB[1]); oB.y = pk2(yB[2], yB[3]); oB.z = pk2(yB[4], yB[5]); oB.w = pk2(yB[6], yB[7]);
            bf16* dst = (bf16*)(a.ws + (isk ? WS_KC : WS_QC)) + ((size_t)bh * SEQ + s0 + tA) * 64 + d0;
            *(u32x4*)dst = oA; *(u32x4*)(dst + 64) = oB;
            if (isk) { *(LAS u32x4*)(lds + KOFF + t_st(tA, d0)) = oA; *(LAS u32x4*)(lds + KOFF + t_st(tA + 1, d0)) = oB;
                float fa[8], fb[8]; unpack8(oA, fa); unpack8(oB, fb);
#pragma unroll
                for (int e = 0; e < 8; ++e) { yA[e] = fa[e]; yB[e] = fb[e]; } }
        }
        const u32x4 vr0 = P.vr[0], vr1 = P.vr[1];
        const int gnext = g + nblk; const bool more = gnext < NITEM;
        m1_load(a, more ? gnext : g, P);
        __syncthreads();
        {   const float wA = wgt[tA], wB = wgt[tA + 1];
#pragma unroll
            for (int e = 0; e < 8; ++e) { float p = isk ? (wA * yA[e] + wB * yB[e]) : 0.f; p += __shfl_xor(p, 16); p += __shfl_xor(p, 32); if (lane >= 8 && lane < 16) npart[wid * 64 + d0 + e] = p; }
#pragma unroll
            for (int i = 0; i < 2; ++i) { const int ci = tid + 512 * i, s = ci >> 4, vc = (ci & 15) * 8; const float ws_ = wgt[s]; float f[8]; unpack8(i ? vr1 : vr0, f);
                u32x4 o; o.x = pk2(f[0] * ws_, f[1] * ws_); o.y = pk2(f[2] * ws_, f[3] * ws_); o.z = pk2(f[4] * ws_, f[5] * ws_); o.w = pk2(f[6] * ws_, f[7] * ws_);
                *(LAS u32x4*)(lds + t_st(s, vc)) = o; } }
        __syncthreads();
        {
            const int vb = wid & 3, db = wid >> 2;
            const int va = (int)(uintptr_t)lds + t_rd_base(lane) + vb * 512, ka = (int)(uintptr_t)lds + KOFF + t_rd_base(lane) + db * 512;
            f32x16 acc = {};
            bf16x8 A, Bf;
            TRFRAG(A, va, 0); TRFRAG(Bf, ka, 0); acc = __builtin_amdgcn_mfma_f32_32x32x16_bf16(A, Bf, acc, 0, 0, 0);
            TRFRAG(A, va, 1); TRFRAG(Bf, ka, 1); acc = __builtin_amdgcn_mfma_f32_32x32x16_bf16(A, Bf, acc, 0, 0, 0);
            TRFRAG(A, va, 2); TRFRAG(Bf, ka, 2); acc = __builtin_amdgcn_mfma_f32_32x32x16_bf16(A, Bf, acc, 0, 0, 0);
            TRFRAG(A, va, 3); TRFRAG(Bf, ka, 3); acc = __builtin_amdgcn_mfma_f32_32x32x16_bf16(A, Bf, acc, 0, 0, 0);
            bf16* KL = (bf16*)(a.ws + WS_KLOC) + (size_t)g * 8192;
#pragma unroll
            for (int r = 0; r < 16; ++r) { const float nb = __shfl_xor(acc[r], 1); if ((r32 & 1) == 0) *(unsigned*)(KL + (vb * 32 + crow(r, hi)) * 64 + db * 32 + r32) = pk2(acc[r], nb); }
        }
        if (tid < 64) { float n = 0.f;
#pragma unroll
            for (int w = 0; w < 8; ++w) n += npart[w * 64 + tid];
            ((float*)(a.ws + WS_NLOC))[(size_t)g * 64 + tid] = n; }
        if (!more) break;
        g = gnext; par ^= 1;
    }
    __syncthreads();
}

__device__ __forceinline__ float rdlane(float v, int l) { return __builtin_bit_cast(float, __builtin_amdgcn_readlane(__builtin_bit_cast(int, v), l)); }
template <bool NST> __device__ __forceinline__ void m2_item_t(const Args& a, int vb) {
    const int tid = threadIdx.x, lane = tid & 63;
    const int bh = vb >> 3, e0 = ((vb & 7) * 512 + tid) * 2;
    const unsigned* KL = (const unsigned*)((const bf16*)(a.ws + WS_KLOC) + (size_t)bh * 64 * 8192 + e0); unsigned* CP = (unsigned*)((bf16*)(a.ws + WS_CPREV) + (size_t)bh * 64 * 8192 + e0);
    float* MST = (float*)(a.ws + WS_MST) + (size_t)bh * 64 * 4;
    const float2 ab = *(const float2*)(MST + lane * 4);
    unsigned kl[64]; float nl[NST ? 64 : 1];
#pragma unroll
    for (int j = 0; j < 64; ++j) kl[j] = KL[(size_t)j * 4096];
    if (NST) { const float* NL = (const float*)(a.ws + WS_NLOC) + (size_t)bh * 64 * 64 + lane;
#pragma unroll
        for (int j = 0; j < 64; ++j) nl[j] = NL[j * 64]; }
    float B = ab.y, A = ab.x;
#pragma unroll
    for (int o = 1; o < 64; o <<= 1) { const float Bp = __shfl_up(B, o), Ap = __shfl_up(A, o); if (lane >= o) { A = fmaxf(Ap + B, A); B = Bp + B; } }
    const float mc = fmaxf(B, A);
    float mp = __shfl_up(mc, 1); if (lane == 0) mp = 0.f;
    const float fCv = __builtin_amdgcn_exp2f((ab.y + mp - mc) * LOG2E), fKv = __builtin_amdgcn_exp2f((ab.x - mc) * LOG2E);
    if (NST) MST[lane * 4 + 2] = mp;
    float* NP = (float*)(a.ws + WS_NPREV) + (size_t)bh * 64 * 64 + lane;
    float c0 = 0.f, c1 = 0.f, n0 = 0.f;
#pragma unroll
    for (int j = 0; j < 64; ++j) {
        const float fC = rdlane(fCv, j), fK = rdlane(fKv, j);
        CP[(size_t)j * 4096] = pk2(c0, c1);
        c0 = fC * c0 + fK * bflo(kl[j]); c1 = fC * c1 + fK * bfhi(kl[j]);
        if (NST) { NP[j * 64] = n0; n0 = fC * n0 + fK * nl[j]; }
    }
}
__device__ __forceinline__ void m2_item(const Args& a, int vb) {
    if ((vb & 7) == 0 && __builtin_amdgcn_readfirstlane(threadIdx.x >> 6) == 0) m2_item_t<true>(a, vb); else m2_item_t<false>(a, vb);
}
#ifndef M2_MASK
#define M2_MASK 3
#endif
constexpr int M2_CTR_DONE = 2176;
__device__ __forceinline__ void m2_worker(const Args& a, int nblk, int blk) {
    unsigned n = 0;
    if (nblk == 256) {
        if (((blk >> 3) & M2_MASK) != 0) return;
        constexpr int NWK = 256 / (M2_MASK + 1);
        const int w = ((blk >> 3) / (M2_MASK + 1)) * 8 + (blk & 7);
        for (int vb = w; vb < 256; vb += NWK) { m2_item(a, vb); ++n; }
    } else for (int vb = blk; vb < 256; vb += nblk) { m2_item(a, vb); ++n; }
    asm volatile("s_waitcnt vmcnt(0)" ::: "memory");
    __syncthreads();
    if (threadIdx.x == 0 && n) {
        __builtin_amdgcn_fence(__ATOMIC_RELEASE, "agent");
        asm volatile("s_waitcnt vmcnt(0)" ::: "memory");
        (void)__hip_atomic_fetch_add((unsigned*)(a.ws + WS_CTL) + M2_CTR_DONE, n, __ATOMIC_RELAXED, __HIP_MEMORY_SCOPE_AGENT);
    }
}
__device__ __forceinline__ void m2_wait_all(const Args& a) {
    unsigned* done = (unsigned*)(a.ws + WS_CTL) + M2_CTR_DONE; unsigned sp = 0;
    while (__hip_atomic_load(done, __ATOMIC_RELAXED, __HIP_MEMORY_SCOPE_AGENT) < 256u) { __builtin_amdgcn_s_sleep(2); if (++sp > (1u << 22)) break; }
#ifndef M2_NOACQ
    __builtin_amdgcn_fence(__ATOMIC_ACQUIRE, "agent");
    asm volatile("s_waitcnt vmcnt(0)" ::: "memory");
#endif
}

struct M3Pre { u32x4 qv, kv, vr[2], cp[2]; float gmrow, mprev, bc, gm, u, np; };
__device__ __forceinline__ void m3_load_front(const Args& a, int g, M3Pre& P) {
    const int tid = threadIdx.x; const int bh = g >> 6, c = g & 63, b = bh >> 3, h = bh & 7; const int s0 = c * 64, tok0 = b * SEQ + s0;
    const int prow = tid >> 3, pc = (tid & 7) * 8;
    P.qv = *(const u32x4*)((const bf16*)(a.ws + WS_QC) + ((size_t)bh * SEQ + s0 + prow) * 64 + pc);
    P.kv = *(const u32x4*)((const bf16*)(a.ws + WS_KC) + ((size_t)bh * SEQ + s0 + prow) * 64 + pc);
    const bf16* MV = (const bf16*)(a.ws + WS_SEC + SEC_MV * SEC_BYTES); const bf16* CP = (const bf16*)(a.ws + WS_CPREV) + (size_t)g * 8192;
#pragma unroll
    for (int i = 0; i < 2; ++i) { const int ci = tid + 512 * i, s = ci >> 4, vc = (ci & 15) * 8; P.vr[i] = *(const u32x4*)(MV + (size_t)(tok0 + s) * 1024 + h * 128 + vc);
        P.cp[i] = *(const u32x4*)(CP + (size_t)ci * 8); }
    const float* GV = (const float*)(a.ws + WS_GV) + (size_t)g * 192;
    P.gmrow = GV[64 + prow]; P.mprev = ((const float*)(a.ws + WS_MST))[(size_t)g * 4 + 2];
    if (tid < 64) { P.bc = GV[tid]; P.gm = GV[64 + tid]; P.u = GV[128 + tid]; P.np = ((const float*)(a.ws + WS_NPREV))[(size_t)g * 64 + tid]; }
}
__device__ __forceinline__ void m3_phase(const Args& a, lptr lds, int nblk, int blk) {
    const int tid = threadIdx.x, lane = tid & 63, wid = __builtin_amdgcn_readfirstlane(tid >> 6), r32 = lane & 31, hi = lane >> 5;
    constexpr int QIMG = 16384, KIMG = 25600, SIMG = 34816, QPIMG = 44032, CPIMG = 53248, FARR = 71680, GNOFF = 74240, HIMG = 78336, HP = 132;
    LAS float* fu = (LAS float*)(lds + FARR); LAS float* fMt = fu + 64; LAS float* fwi = fu + 128; LAS float* fmt = fu + 192; LAS float* fnp = fu + 256; LAS float* fqn = fu + 320; LAS float* fdsp = fu + 384;
    LAS float* gn = (LAS float*)(lds + GNOFF); LAS float* himg = (LAS float*)(lds + HIMG); LAS float* fhd = (LAS float*)(lds + 112128 + 64);
    constexpr int NITEM = BATCH * NH * NCHUNK;
    unsigned* ctr = (unsigned*)(a.ws + WS_CTL) + 2048; LAS int* qslot = (LAS int*)(lds + 112128);
    if (tid == 0) { qslot[0] = (int)atomicAdd(ctr, 1u); qslot[1] = (int)atomicAdd(ctr, 1u); m2_wait_all(a); }
    for (int i = tid; i < 1024; i += NTHREADS) gn[i] = a.in[IN_MNW][i];
    __syncthreads();
    int g = __builtin_amdgcn_readfirstlane(qslot[0]), gnext = __builtin_amdgcn_readfirstlane(qslot[1]);
    __syncthreads();
    if (g >= NITEM) return;
    M3Pre P; m3_load_front(a, g, P);
    const int prow = tid >> 3, pc = (tid & 7) * 8, seg = tid & 7; int qpar = 0;
    for (;;) {
        const int bh = g >> 6, c = g & 63, b = bh >> 3, h = bh & 7; const int tok0 = b * SEQ + c * 64;
        if (tid == 0) qslot[qpar] = (int)atomicAdd(ctr, 1u);
        { const float Mtr = fmaxf(P.mprev, P.gmrow), wi = fexp(P.mprev - Mtr);
#pragma unroll
          for (int i = 0; i < 2; ++i) { const int ci = tid + 512 * i, s = ci >> 4, vc = (ci & 15) * 8; *(LAS u32x4*)(lds + t_st(s, vc)) = P.vr[i];
              const int v = ci >> 3, dc = (ci & 7) * 8; *(LAS u32x4*)(lds + CPIMG + v * ROWP + dc * 2) = P.cp[i]; }
          *(LAS u32x4*)(lds + QIMG + prow * ROWP + pc * 2) = P.qv; *(LAS u32x4*)(lds + KIMG + prow * ROWP + pc * 2) = P.kv;
          float f[8]; unpack8(P.qv, f); u32x4 o; o.x = pk2(f[0] * wi, f[1] * wi); o.y = pk2(f[2] * wi, f[3] * wi); o.z = pk2(f[4] * wi, f[5] * wi); o.w = pk2(f[6] * wi, f[7] * wi);
          *(LAS u32x4*)(lds + QPIMG + prow * ROWP + pc * 2) = o;
          if (tid < 64) { const float Mt = fmaxf(P.mprev, P.gm); fu[tid] = P.u; fMt[tid] = Mt; fwi[tid] = fexp(P.mprev - Mt); fmt[tid] = P.bc + Mt; fnp[tid] = P.np; } }
        const bf16* MO = (const bf16*)(a.ws + WS_SEC + SEC_MO * SEC_BYTES) + (size_t)(tok0 + prow) * 1024 + h * 128 + seg * 16;
        const bf16* MZ = (const bf16*)(a.ws + WS_SEC + SEC_MZ * SEC_BYTES) + (size_t)(tok0 + prow) * 1024 + h * 128 + seg * 16;
        const u32x4 mo0 = *(const u32x4*)MO, mo1 = *(const u32x4*)(MO + 8), mz0 = *(const u32x4*)MZ, mz1 = *(const u32x4*)(MZ + 8);
        const bool more = gnext < NITEM;
        M3Pre Pn; m3_load_front(a, more ? gnext : g, Pn);
        __syncthreads();
        if (wid < 4) {
            const int sb = wid & 1, tb = wid >> 1;
            f32x16 acc = {};
            if (sb <= tb) {
#pragma unroll
                for (int k0 = 0; k0 < 4; ++k0) { const bf16x8 Kf = *(const LAS bf16x8*)(lds + KIMG + (sb * 32 + r32) * ROWP + (k0 * 16 + hi * 8) * 2);
                    const bf16x8 Qf = *(const LAS bf16x8*)(lds + QIMG + (tb * 32 + r32) * ROWP + (k0 * 16 + hi * 8) * 2);
                    acc = __builtin_amdgcn_mfma_f32_32x32x16_bf16(Kf, Qf, acc, 0, 0, 0); }
            }
            const int t = tb * 32 + r32; const float Mt = fMt[t]; float rsum = 0.f;
#pragma unroll
            for (int gq = 0; gq < 4; ++gq) { float v[4];
#pragma unroll
                for (int e = 0; e < 4; ++e) { const int s = sb * 32 + 8 * gq + 4 * hi + e; const float d = fexp(fu[s] - Mt); v[e] = (s <= t) ? acc[4 * gq + e] * d : 0.f; rsum += v[e]; }
                v2u o; o.x = pk2(v[0], v[1]); o.y = pk2(v[2], v[3]);
                *(LAS v2u*)(lds + SIMG + t * ROWP + (sb * 32 + 8 * gq + 4 * hi) * 2) = o; }
            fdsp[t * 4 + sb * 2 + hi] = rsum;
        } else {
            const int tq = tid - 256, row = tq >> 2, part = tq & 3;
            const u32x4 q0 = *(const LAS u32x4*)(lds + QIMG + row * ROWP + part * 32), q1 = *(const LAS u32x4*)(lds + QIMG + row * ROWP + part * 32 + 16);
            float f[16]; unpack8(q0, f); unpack8(q1, f + 8); float s = 0.f;
#pragma unroll
            for (int e = 0; e < 16; ++e) s += f[e] * fnp[part * 16 + e];
            s += __shfl_xor(s, 1); s += __shfl_xor(s, 2);
            if (part == 0) fqn[row] = s;
        }
        __syncthreads();
        if (tid < 64) {
            const int t = tid; const float den = ((fdsp[t * 4 + 0] + fdsp[t * 4 + 1]) + (fdsp[t * 4 + 2] + fdsp[t * 4 + 3])) + fwi[t] * fqn[t];
            fhd[t] = __builtin_amdgcn_rcpf(fmaxf(fabsf(den), fexp(-fmt[t]))); }
        {
            const int tb = wid >> 2, vb = wid & 3;
            f32x16 acc = {};
            const int va = (int)(uintptr_t)lds + t_rd_base(lane) + vb * 512;
            bf16x8 Af, Bf;
#define M3_STEP(ks) do { Af = *(const LAS bf16x8*)(lds + SIMG + (tb * 32 + r32) * ROWP + ((ks) * 16 + hi * 8) * 2); TRFRAG(Bf, va, ks); acc = __builtin_amdgcn_mfma_f32_32x32x16_bf16(Af, Bf, acc, 0, 0, 0); } while (0)
            M3_STEP(0); M3_STEP(1); M3_STEP(2); M3_STEP(3);
#undef M3_STEP
#pragma unroll
            for (int k0 = 0; k0 < 4; ++k0) { const bf16x8 Aq = *(const LAS bf16x8*)(lds + QPIMG + (tb * 32 + r32) * ROWP + (k0 * 16 + hi * 8) * 2);
                const bf16x8 Cf = *(const LAS bf16x8*)(lds + CPIMG + (vb * 32 + r32) * ROWP + (k0 * 16 + hi * 8) * 2);
                acc = __builtin_amdgcn_mfma_f32_32x32x16_bf16(Aq, Cf, acc, 0, 0, 0); }
#pragma unroll
            for (int r = 0; r < 16; ++r) himg[(tb * 32 + crow(r, hi)) * HP + vb * 32 + r32] = acc[r];
        }
        __syncthreads();
        {
            float hv[16], of[16], zf[16];
#pragma unroll
            for (int j = 0; j < 4; ++j) { const pg8::f32x4 x = *(const LAS pg8::f32x4*)(himg + prow * HP + seg * 16 + 4 * j); hv[4 * j] = x[0]; hv[4 * j + 1] = x[1]; hv[4 * j + 2] = x[2]; hv[4 * j + 3] = x[3]; }
            unpack8(mo0, of); unpack8(mo1, of + 8); unpack8(mz0, zf); unpack8(mz1, zf + 8);
            float ss = 0.f; const float hdr = fhd[prow];
#pragma unroll
            for (int e = 0; e < 16; ++e) { hv[e] *= hdr * fsigmoid(of[e]); ss += hv[e] * hv[e]; }
            ss += __shfl_xor(ss, 1); ss += __shfl_xor(ss, 2); ss += __shfl_xor(ss, 4);
            const float rs = 1.0f / sqrtf(ss * (1.f / 128.f) + NORM_EPS);
            float y[16];
#pragma unroll
            for (int e = 0; e < 16; ++e) y[e] = hv[e] * rs * gn[h * 128 + seg * 16 + e] * (zf[e] * fsigmoid(zf[e]));
            u32x4 o0, o1; o0.x = pk2(y[0], y[1]); o0.y = pk2(y[2], y[3]); o0.z = pk2(y[4], y[5]); o0.w = pk2(y[6], y[7]);
            o1.x = pk2(y[8], y[9]); o1.y = pk2(y[10], y[11]); o1.z = pk2(y[12], y[13]); o1.w = pk2(y[14], y[15]);
            bf16* Y = (bf16*)(a.ws + WS_Y) + (size_t)(tok0 + prow) * 2048 + 1024 + h * 128 + seg * 16;
            *(u32x4*)Y = o0; *(u32x4*)(Y + 8) = o1;
        }
        if (!more) break;
        g = gnext; P = Pn; gnext = __builtin_amdgcn_readfirstlane(qslot[qpar]); qpar ^= 1;
    }
    __syncthreads();
}
#undef TRFRAG
}

#define XB_TMO      128
#define XB_XCNT(j)  (256  + 64 * (j))
#define XB_XSUB(j)  (1280 + 64 * (j))
#define XB_XGEN(j)  (2304 + 64 * (j))
#define XB_TOP      3328
#define XB_TOPGEN   3392
#define XCD_BAR_WORDS 3456
#define XB_SPIN_CAP (1u << 18)

__device__ __forceinline__ unsigned xb_ld(unsigned* p)              { return __hip_atomic_load(p, __ATOMIC_RELAXED, __HIP_MEMORY_SCOPE_AGENT); }
__device__ __forceinline__ unsigned xb_add(unsigned* p, unsigned v) { return __hip_atomic_fetch_add(p, v, __ATOMIC_RELAXED, __HIP_MEMORY_SCOPE_AGENT); }
__device__ __forceinline__ unsigned xb_xcc_id() { return (unsigned)__builtin_amdgcn_s_getreg((3 << 11) | 20) & 0xFu; }
#define XB_SPIN(cond, bar) do { unsigned _sp = 0; while (cond) { __builtin_amdgcn_s_sleep(1); \
    if ((++_sp & 255u) == 0u) { if (xb_ld(&(bar)[XB_TMO])) break; if (_sp > XB_SPIN_CAP) { atomicAdd(&(bar)[XB_TMO], 1u); break; } } } } while (0)

struct XcdBarrier {
    unsigned* bar; unsigned x;
    volatile LAS unsigned* st;
};

__device__ __forceinline__ XcdBarrier xcd_barrier_post(unsigned* bar, volatile LAS unsigned* st) {
    XcdBarrier b; b.bar = bar; b.x = xb_xcc_id(); b.st = st;
    if (threadIdx.x == 0) (void)xb_add(&bar[XB_XCNT(b.x)], 1u);
    return b;
}
__device__ __forceinline__ void xcd_barrier_complete(unsigned* bar, unsigned x, unsigned& nloc, unsigned& nx) {
    const unsigned G = gridDim.x * gridDim.y * gridDim.z;
    unsigned sum, cnt, mine, sp = 0u;
    for (;;) {
        sum = 0u; cnt = 0u; mine = 0u;
#pragma unroll
        for (unsigned j = 0; j < 16; ++j) { const unsigned c = xb_ld(&bar[XB_XCNT(j)]); sum += c; cnt += (c > 0u) ? 1u : 0u; mine = (j == x) ? c : mine; }
        if (sum == G) break;
        __builtin_amdgcn_s_sleep(1);
        if ((++sp & 255u) == 0u) { if (xb_ld(&bar[XB_TMO])) break; if (sp > XB_SPIN_CAP) { atomicAdd(&bar[XB_TMO], 1u); break; } }
    }
    nloc = mine > 0u ? mine : 1u; nx = cnt > 0u ? cnt : 1u;
}

__device__ __forceinline__ void xcd_barrier(const XcdBarrier& b) {
    asm volatile("s_waitcnt vmcnt(0)" ::: "memory");
    __syncthreads();
    if (threadIdx.x == 0) {
        unsigned* bar = b.bar;
        __builtin_amdgcn_s_waitcnt(0);
        unsigned nloc = b.st[0], nx = b.st[1];
        if (nloc == 0u) { xcd_barrier_complete(bar, b.x, nloc, nx); b.st[0] = nloc; b.st[1] = nx; }
        const unsigned old = xb_add(&bar[XB_XSUB(b.x)], 1u);
        const unsigned gen = old / nloc;
        if (old + 1u == (gen + 1u) * nloc) {
            __builtin_amdgcn_fence(__ATOMIC_RELEASE, "agent");
            asm volatile("s_waitcnt vmcnt(0)" ::: "memory");
            const unsigned og = xb_add(&bar[XB_TOP], 1u);
            const unsigned tg = og / nx;
            if (og + 1u == (tg + 1u) * nx) xb_add(&bar[XB_TOPGEN], 1u);
            else XB_SPIN(xb_ld(&bar[XB_TOPGEN]) == tg, bar);
            __builtin_amdgcn_fence(__ATOMIC_ACQUIRE, "agent");
            xb_add(&bar[XB_XGEN(b.x)], 1u);
            asm volatile("s_waitcnt vmcnt(0)" ::: "memory");
        } else {
            XB_SPIN(xb_ld(&bar[XB_XGEN(b.x)]) == gen, bar);
            __builtin_amdgcn_fence(__ATOMIC_ACQUIRE, "agent");
            asm volatile("s_waitcnt vmcnt(0)" ::: "memory");
        }
    }
    __syncthreads();
}

constexpr int N_PHASES = 7;
__global__ void __launch_bounds__(NTHREADS, 2) mega_fwd(Args a) {
    extern __shared__ __attribute__((aligned(16))) unsigned char lds_raw[];
    LAS unsigned char* lds = (LAS unsigned char*)lds_raw;
    const int blk = blockIdx.x, nblk = gridDim.x;
    const int lo = a.ph_lo, hi = a.ph_hi;
    volatile LAS unsigned* MISC = (volatile LAS unsigned*)(lds + LDS_BYTES - 64);
    if (threadIdx.x < 16) MISC[threadIdx.x] = 0u;
    __syncthreads();
    XcdBarrier bar = xcd_barrier_post((unsigned*)(a.ws + WS_CTL) + 4096, MISC + 8);
#ifndef PROBE_REPEAT
#define PROBE_REPEAT -1
#endif
#ifndef PROBE_FLAGS
#define PROBE_FLAGS 0
#endif
#define REP(k)
#define IN(k) (lo <= (k) && (k) < hi)
#define SEAM(k) do { if (IN(k) && IN((k) + 1)) xcd_barrier(bar); } while (0)
    if (IN(0)) { REP(0) phase_prep(a, lds, nblk, blk); }
    SEAM(0);
    if (IN(1)) REP(1) {
        for (int c = blk; c < M_TOK / 64; c += nblk) gate_unit(a, lds, c);
        pg8::Gemm g{(const pg8::bf16_t*)(a.ws + WS_XN), (const pg8::bf16_t*)(a.ws + WS_WIN), M_TOK, NMAIN, DM};
        pg8::EpiProj E{a.ws + WS_SEC, QSCALE};
        if (nblk == 256) { pg8::XcdColOrder S; S.init(M_TOK, NMAIN, nblk, blk); pg8::gemm_phase<pg8::EpiProj, pg8::XcdColOrder, true, true>(lds, g, S, E); }
        else { pg8::StaticOrder S; S.init(M_TOK, NMAIN, nblk, blk); pg8::gemm_phase<pg8::EpiProj, pg8::StaticOrder, true, true>(lds, g, S, E); }
    }
    SEAM(1);
    if (IN(2)) {
        for (int it = blk; it < BATCH * NH * 8; it += nblk) fox_cumsum_item(a, lds, it);
        fox::knorm_pass(a, nblk, blk);
        ml::m1_phase(a, (ml::lptr)lds, nblk, blk);
    }
    SEAM(2);
    if (IN(4)) {
        ml::m2_worker(a, nblk, blk);
        REP(4) fox::phase(a, (fox::lptr)lds, nblk, blk);
        REP(41) ml::m3_phase(a, (ml::lptr)lds, nblk, blk);
    }
    SEAM(4);
    if (IN(5)) REP(5) {
        pg8::Gemm g{(const pg8::bf16_t*)(a.ws + WS_Y), (const pg8::bf16_t*)(a.ws + WS_WOUT), M_TOK, DM, DM};
        pg8::StaticOrder S; S.init(M_TOK, DM, nblk, blk);
        pg8::EpiOut E{(pg8::bf16_t*)(a.ws + WS_DELTA)};
        pg8::gemm_phase<pg8::EpiOut, pg8::StaticOrder, true, true>(lds, g, S, E);
    }
    SEAM(5);
    if (IN(6)) { REP(6) phase_final(a, nblk, blk); }
#undef IN
#undef SEAM
}

#ifndef MK_N_LAUNCHES
#define MK_N_LAUNCHES 1
#endif
extern "C" void kernel_launch(void* const* d_in, const int* in_sizes, int n_in, void* d_out, int out_size, void* d_ws, size_t ws_size, hipStream_t stream) {
    static int grid = 0;
    if (grid == 0) {
        if (n_in != 12 || in_sizes[0] != M_TOK * DM || in_sizes[2] != DM * IN_COLS || out_size != M_TOK * DM || ws_size < WS_END) {
            fprintf(stderr, "kernel_launch: shape mismatch n_in %d in0 %d in2 %d out %d ws %zu\n", n_in, n_in > 0 ? in_sizes[0] : -1, n_in > 2 ? in_sizes[2] : -1, out_size, ws_size); grid = -1; return; }
        int dev = 0, cus = 0, per_cu = 0;
        if (hipGetDevice(&dev) != hipSuccess || hipDeviceGetAttribute(&cus, hipDeviceAttributeMultiprocessorCount, dev) != hipSuccess) { grid = -1; return; }
        if (hipFuncSetAttribute((const void*)mega_fwd, hipFuncAttributeMaxDynamicSharedMemorySize, LDS_BYTES) != hipSuccess) { fprintf(stderr, "kernel_launch: hipFuncSetAttribute failed\n"); grid = -1; return; }
        if (hipOccupancyMaxActiveBlocksPerMultiprocessor(&per_cu, (const void*)mega_fwd, NTHREADS, LDS_BYTES) != hipSuccess || per_cu < 1) { fprintf(stderr, "kernel_launch: occupancy query says %d blocks per CU\n", per_cu); per_cu = 1; }
        (void)hipGetLastError();
        grid = cus;
    }
    if (grid < 0) return;
    Args a{};
    for (int i = 0; i < 12; ++i) a.in[i] = (const float*)d_in[i];
    a.out = (float*)d_out; a.ws = (unsigned char*)d_ws;
    if (hipMemsetAsync((char*)d_ws + WS_CTL, 0, 65536, stream) != hipSuccess) { fprintf(stderr, "kernel_launch: hipMemsetAsync failed\n"); return; }
    if (MK_N_LAUNCHES == 1) {
        a.ph_lo = 0; a.ph_hi = N_PHASES;
        void* args[] = {&a};
        hipError_t e = hipLaunchCooperativeKernel((const void*)mega_fwd, dim3(grid), dim3(NTHREADS), args, LDS_BYTES, stream);
        if (e != hipSuccess) fprintf(stderr, "kernel_launch: cooperative launch failed: %s (grid %d)\n", hipGetErrorString(e), grid);
    } else {
        for (int p = 0; p < N_PHASES; ++p) { a.ph_lo = p; a.ph_hi = p + 1; for (int r = 0; r < (p == PROBE_REPEAT ? 2 : 1); ++r) { a.flags = r ? PROBE_FLAGS : 0; hipLaunchKernelGGL(mega_fwd, dim3(grid), dim3(NTHREADS), LDS_BYTES, stream, a); } }
        if (PROBE_REPEAT == 56) for (int p = 5; p < 7; ++p) { a.ph_lo = p; a.ph_hi = p + 1; hipLaunchKernelGGL(mega_fwd, dim3(grid), dim3(NTHREADS), LDS_BYTES, stream, a); }
    }
}
```

```cpp
#include <hip/hip_runtime.h>
#include <hip/hip_cooperative_groups.h>
#include <cstdio>
#include <cstdint>
namespace cg = cooperative_groups;

constexpr int BATCH = 4, SEQ = 4096, DM = 2048, M_TOK = BATCH * SEQ;
constexpr int NH = 8, HD = 128, DK = 64, CHUNK = 64, NCHUNK = SEQ / CHUNK;
constexpr int IN_COLS = 8216, NMAIN = 8192, NGATE = 32;
constexpr float NORM_EPS = 1e-6f;
constexpr float LOG2E = 1.4426950408889634f;
constexpr float QSCALE = 0.08838834764831845f * 1.4426950408889634f;

constexpr size_t MiB = 1u << 20;
constexpr size_t WS_CTL = 0;
constexpr size_t WS_KNRM = 1 * MiB, WS_KSUF = 1 * MiB + 8192, WS_KBND = 1 * MiB + 16384;
constexpr size_t WS_GATE = 2 * MiB;
constexpr size_t WS_ROWSS = 4 * MiB;
constexpr size_t WS_WGT = 6 * MiB;
constexpr size_t WS_KBIAS = 7 * MiB;
constexpr size_t WS_MST = 9 * MiB;
constexpr size_t WS_NLOC = 10 * MiB;
constexpr size_t WS_NPREV = 11 * MiB;
constexpr size_t WS_GV = 12 * MiB;
constexpr size_t WS_WOUT = 16 * MiB;
constexpr size_t WS_WIN = 32 * MiB;
constexpr size_t WS_QC = 32 * MiB;
constexpr size_t WS_KC = 48 * MiB;
constexpr size_t WS_XN = 64 * MiB;
constexpr size_t WS_Y = 64 * MiB;
constexpr size_t WS_SEC = 128 * MiB;
constexpr size_t SEC_BYTES = 32 * MiB;
constexpr size_t WS_KLOC = 384 * MiB;
constexpr size_t WS_DELTA = 384 * MiB;
constexpr size_t WS_CPREV = 448 * MiB;
constexpr size_t WS_END = 480 * MiB;
enum { SEC_FQ = 0, SEC_FK, SEC_FV, SEC_FZ, SEC_MQK, SEC_MV, SEC_MO, SEC_MZ };

typedef unsigned short bf16;
typedef unsigned v4u __attribute__((ext_vector_type(4)));
typedef unsigned v2u __attribute__((ext_vector_type(2)));
typedef float f32x16 __attribute__((ext_vector_type(16)));
#define LAS __attribute__((address_space(3)))
#define LDS_WAIT() asm volatile("s_waitcnt lgkmcnt(0)" ::: "memory")

__device__ __forceinline__ unsigned f2bf(float f) { unsigned u = __builtin_bit_cast(unsigned, f); return (u + 0x7fffu + ((u >> 16) & 1u)) >> 16; }
typedef float f32x2_t __attribute__((ext_vector_type(2))); typedef __bf16 bf16x2_t __attribute__((ext_vector_type(2)));
__device__ __forceinline__ unsigned pk2(float lo, float hi) { f32x2_t v = {lo, hi}; bf16x2_t b = __builtin_convertvector(v, bf16x2_t); return __builtin_bit_cast(unsigned, b); }
__device__ __forceinline__ float bf2f(unsigned h) { return __builtin_bit_cast(float, (h & 0xffffu) << 16); }
__device__ __forceinline__ float bflo(unsigned w) { return __builtin_bit_cast(float, w << 16); }
__device__ __forceinline__ float bfhi(unsigned w) { return __builtin_bit_cast(float, w & 0xffff0000u); }
__device__ __forceinline__ float wave_sum(float v) {
#pragma unroll
    for (int o = 1; o < 64; o <<= 1) v += __shfl_xor(v, o);
    return v;
}
__device__ __forceinline__ float wave_max(float v) {
#pragma unroll
    for (int o = 1; o < 64; o <<= 1) v = fmaxf(v, __shfl_xor(v, o));
    return v;
}
#define DPP_F(x, old, ctrl, rm, bm) __builtin_bit_cast(float, __builtin_amdgcn_update_dpp(__builtin_bit_cast(int, (float)(old)), __builtin_bit_cast(int, (float)(x)), ctrl, rm, bm, false))
__device__ __forceinline__ float wave_scan_add(float v) {
    float s = v + DPP_F(v, 0.f, 0x111, 0xf, 0xf); s += DPP_F(v, 0.f, 0x112, 0xf, 0xf); s += DPP_F(v, 0.f, 0x113, 0xf, 0xf);
    s += DPP_F(s, 0.f, 0x114, 0xf, 0xe); s += DPP_F(s, 0.f, 0x118, 0xf, 0xc);
    s += DPP_F(s, 0.f, 0x142, 0xa, 0xf); s += DPP_F(s, 0.f, 0x143, 0xc, 0xf);
    return s;
}
__device__ __forceinline__ float wave_scan_max(float v) {
    const float NI = -__builtin_inff();
    float s = fmaxf(v, DPP_F(v, NI, 0x111, 0xf, 0xf)); s = fmaxf(s, DPP_F(v, NI, 0x112, 0xf, 0xf)); s = fmaxf(s, DPP_F(v, NI, 0x113, 0xf, 0xf));
    s = fmaxf(s, DPP_F(s, NI, 0x114, 0xf, 0xe)); s = fmaxf(s, DPP_F(s, NI, 0x118, 0xf, 0xc));
    s = fmaxf(s, DPP_F(s, NI, 0x142, 0xa, 0xf)); s = fmaxf(s, DPP_F(s, NI, 0x143, 0xc, 0xf));
    return s;
}
__device__ __forceinline__ float logsigmoidf(float x) { return fminf(x, 0.f) - log1pf(expf(-fabsf(x))); }
__device__ __forceinline__ float siluf(float x) { return x / (1.f + expf(-x)); }
__device__ __forceinline__ float sigmoidf_(float x) { return 1.f / (1.f + expf(-x)); }

namespace pg8 {
#define PG8_LAS __attribute__((address_space(3)))
typedef unsigned short bf16_t;
typedef short bf16x8 __attribute__((ext_vector_type(8)));
typedef float f32x4 __attribute__((ext_vector_type(4)));
typedef unsigned u32x4 __attribute__((ext_vector_type(4)));
constexpr int BM = 256, BK = 64, HALF = 128, HTB = HALF * BK * 2  , STAGE_BYTES = 8 * HTB, NXCD = 8, WGM = 4;

__host__ __device__ __forceinline__ int lds_byte(int r, int c) { const int st = (r >> 4) * 2 + (c >> 5), rr = r & 15, cc = c & 31, ob = rr * 64 + cc * 2; return st * 1024 + (ob ^ (((ob >> 9) & 1) << 5)); }
__host__ __device__ __forceinline__ void stage_rc(int b, int& R, int& C) { const int st = b / 1024, sb = b % 1024, swz = sb ^ (((sb >> 9) & 1) << 5); R = (st >> 1) * 16 + swz / 64; C = (st & 1) * 32 + (swz % 64) / 2; }
__host__ __device__ __forceinline__ int perm32(int rho) { const int n = rho >> 4, i = rho & 15; return 8 * (i >> 2) + 4 * n + (i & 3); }

struct Unit { int pm, pn; };
struct Gemm { const bf16_t* A; const bf16_t* Bt; int M, N, K; };

struct StaticOrder {
    int nM, nN, nwg, G, c;
    __host__ __device__ void init(int M, int N, int G_, int c_) { nM = M / BM; nN = N / BM; nwg = nM * nN; G = G_; c = c_; }
    __host__ __device__ bool next(int i, Unit& u) const {
        const long L = (long)i * G + c; if (L >= nwg) return false;
        int wgid = (int)L; { const int q = nwg / NXCD, r = nwg % NXCD, xcd = wgid % NXCD, off = wgid / NXCD; wgid = (xcd < r ? xcd * (q + 1) : r * (q + 1) + (xcd - r) * q) + off; }
        const int nig = WGM * nN, gid = wgid / nig, fm = gid * WGM, gsz = (nM - fm) < WGM ? (nM - fm) : WGM;
        u.pm = fm + ((wgid % nig) % gsz); u.pn = (wgid % nig) / gsz; return true;
    }
    __device__ __forceinline__ void a_ready(const Unit&) const {}
    __device__ __forceinline__ void done(const Unit&) const {}
};

__device__ __forceinline__ unsigned cvt_pk_bf16(float lo, float hi) { return pk2(lo, hi); }

struct XcdColOrder {
    int nM, nN, G, c;
    __host__ __device__ void init(int M, int N, int G_, int c_) { nM = M / BM; nN = N / BM; G = G_; c = c_; }
    __host__ __device__ bool next(int i, Unit& u) const {
        const int x = c & 7, j = c >> 3, per = nN >> 3, rows = (G >> 3) / per;
        u.pn = x * per + j / rows; u.pm = i * rows + j % rows; return u.pm < nM;
    }
    __device__ __forceinline__ void a_ready(const Unit&) const {}
    __device__ __forceinline__ void done(const Unit&) const {}
};

struct EpiProj {
    static constexpr bool PERM = true, AFTER_DRAIN = false;
    unsigned char* secbase; float qscale;
    __device__ __forceinline__ void operator()(const f32x4 (&acc)[2][2][4][2], const Unit& u, int wr, int wc, int fr, int fq) const {
        const int sec = u.pn >> 2, t4 = u.pn & 3;
        const int row0 = u.pm * BM + wr * 64 + fr;
        bf16_t* base = (bf16_t*)(secbase + (size_t)sec * (32u << 20));
        const float sc = sec == 0 ? qscale : 1.f;
        size_t rstride, bjstride, off0;
        if (sec < 3) {
            const int b = row0 >> 12, s0 = row0 & 4095;
            rstride = 128; bjstride = (size_t)4096 * 128; off0 = ((size_t)(b * 8 + t4 * 2) * 4096 + s0) * 128 + wc * 32 + 8 * fq;
        } else {
            rstride = 1024; bjstride = 128; off0 = (size_t)row0 * 1024 + t4 * 256 + wc * 32 + 8 * fq;
        }
#pragma unroll
        for (int ai = 0; ai < 2; ++ai)
#pragma unroll
            for (int m = 0; m < 4; ++m) { bf16_t* rowp = base + off0 + (size_t)(ai * HALF + m * 16) * rstride;
#pragma unroll
                for (int bj = 0; bj < 2; ++bj) { f32x4 v0 = acc[ai][bj][m][0] * sc, v1 = acc[ai][bj][m][1] * sc;
                    u32x4 w; w.x = cvt_pk_bf16(v0[0], v0[1]); w.y = cvt_pk_bf16(v0[2], v0[3]); w.z = cvt_pk_bf16(v1[0], v1[1]); w.w = cvt_pk_bf16(v1[2], v1[3]);
                    __builtin_nontemporal_store(w, (u32x4*)(rowp + bj * bjstride)); } }
    }
};
struct EpiOut {
    static constexpr bool PERM = true, AFTER_DRAIN = false;
    bf16_t* delta;
    __device__ __forceinline__ void operator()(const f32x4 (&acc)[2][2][4][2], const Unit& u, int wr, int wc, int fr, int fq) const {
        const int row0 = u.pm * BM + wr * 64 + fr; bf16_t* base = delta + (size_t)row0 * 2048 + u.pn * BM + wc * 32 + 8 * fq;
#pragma unroll
        for (int ai = 0; ai < 2; ++ai)
#pragma unroll
            for (int m = 0; m < 4; ++m) { bf16_t* rowp = base + (size_t)(ai * HALF + m * 16) * 2048;
#pragma unroll
                for (int bj = 0; bj < 2; ++bj) { const f32x4 v0 = acc[ai][bj][m][0], v1 = acc[ai][bj][m][1];
                    u32x4 w; w.x = cvt_pk_bf16(v0[0], v0[1]); w.y = cvt_pk_bf16(v0[2], v0[3]); w.z = cvt_pk_bf16(v1[0], v1[1]); w.w = cvt_pk_bf16(v1[2], v1[3]);
                    *(u32x4*)(rowp + bj * HALF) = w; } }
    }
};

template <class Epi, class Sched, bool ALIGN_EPI = false, bool SP2 = false>
__device__ __forceinline__ void gemm_phase(PG8_LAS unsigned char* lds, const Gemm g, const Sched& S, const Epi& E) {
    const int tid = threadIdx.x, wid = __builtin_amdgcn_readfirstlane(tid >> 6), lane = tid & 63, wr = wid >> 2, wc = wid & 3, fr = lane & 15, fq = lane >> 4;
    const int K = g.K, nt = K / BK;
    unsigned voffA[2], voffB[2];
#pragma unroll
    for (int i = 0; i < 2; ++i) { int R, C; stage_rc(tid * 16 + i * 8192, R, C); const int Rb = Epi::PERM ? ((R & ~31) + perm32(R & 31)) : R;
        voffA[i] = (unsigned)(R * K + C) * 2u; voffB[i] = (unsigned)(Rb * K + C) * 2u; }
    const size_t kstep = (size_t)(BK * 2);
    const size_t hstep = (size_t)HALF * K * 2;
    const size_t tstep = 2 * hstep;
    const unsigned ldsw = (unsigned)wid * 1024u;
    const int aoff = lds_byte(wr * 64 + fr, fq * 8), boff = lds_byte(wc * 32 + fr, fq * 8);
#define PG8_SA(b, h) (((b) * 2 + (h)) * HTB)
#define PG8_SB(b, h) ((4 + (b) * 2 + (h)) * HTB)
#define PG8_STAGE(bufoff, gbase, voff) do { _Pragma("unroll") for (int _i = 0; _i < 2; ++_i) \
        __builtin_amdgcn_global_load_lds((const unsigned*)((const char*)(gbase) + (voff)[_i]), (PG8_LAS unsigned*)(lds + (bufoff) + ldsw + _i * 8192), 16, 0, 0); } while (0)
#define PG8_LDA(dst, b, h) do { _Pragma("unroll") for (int m = 0; m < 4; ++m) _Pragma("unroll") for (int k = 0; k < 2; ++k) dst[m][k] = *(const PG8_LAS bf16x8*)(lds + PG8_SA(b, h) + aoff + m * 2048 + k * 1024); } while (0)
#define PG8_LDB(dst, b, h) do { _Pragma("unroll") for (int n = 0; n < 2; ++n) _Pragma("unroll") for (int k = 0; k < 2; ++k) dst[n][k] = *(const PG8_LAS bf16x8*)(lds + PG8_SB(b, h) + boff + n * 2048 + k * 1024); } while (0)
#define PG8_MMA(ai, bj, At, Bt) do { __builtin_amdgcn_s_setprio(1); _Pragma("unroll") for (int m = 0; m < 4; ++m) _Pragma("unroll") for (int n = 0; n < 2; ++n) _Pragma("unroll") for (int k = 0; k < 2; ++k) \
        acc[ai][bj][m][n] = __builtin_amdgcn_mfma_f32_16x16x32_bf16(Bt[n][k], At[m][k], acc[ai][bj][m][n], 0, 0, 0); __builtin_amdgcn_s_setprio(0); } while (0)
#define PG8_WAIT_V(n) asm volatile("s_waitcnt vmcnt(" #n ")" ::: "memory")
#define PG8_WAIT_L(n) asm volatile("s_waitcnt lgkmcnt(" #n ")" ::: "memory")
#define PG8_BAR __builtin_amdgcn_s_barrier()
#define PG8_SCHED __builtin_amdgcn_sched_barrier(0)
    Unit cur, nxt; int ui = 0;
    if (!S.next(0, cur)) return;
    f32x4 acc[2][2][4][2];
#pragma unroll
    for (int a = 0; a < 2; ++a)
#pragma unroll
        for (int b = 0; b < 2; ++b)
#pragma unroll
            for (int m = 0; m < 4; ++m)
#pragma unroll
                for (int n = 0; n < 2; ++n) acc[a][b][m][n] = (f32x4){0.f, 0.f, 0.f, 0.f};
    bf16x8 At[4][2], B0[2][2], B1[2][2];
    const char* cA = (const char*)g.A + (size_t)cur.pm * tstep; const char* cB = (const char*)g.Bt + (size_t)cur.pn * tstep;
    S.a_ready(cur);
    if constexpr (SP2) {
        PG8_STAGE(PG8_SB(0, 0), cB, voffB); PG8_STAGE(PG8_SB(0, 1), cB + hstep, voffB); PG8_STAGE(PG8_SA(0, 0), cA, voffA); PG8_STAGE(PG8_SA(0, 1), cA + hstep, voffA);
        if (wr == 1) PG8_BAR;
        PG8_WAIT_V(2); PG8_BAR;
        PG8_STAGE(PG8_SB(1, 0), cB + kstep, voffB); PG8_STAGE(PG8_SA(1, 0), cA + kstep, voffA); PG8_STAGE(PG8_SB(1, 1), cB + hstep + kstep, voffB);
        PG8_WAIT_V(6); PG8_BAR;
    } else {
        PG8_STAGE(PG8_SB(0, 0), cB, voffB); PG8_STAGE(PG8_SA(0, 0), cA, voffA); PG8_STAGE(PG8_SB(0, 1), cB + hstep, voffB); PG8_STAGE(PG8_SA(0, 1), cA + hstep, voffA);
        if (wr == 1) PG8_BAR;
        PG8_WAIT_V(4); PG8_BAR;
        PG8_STAGE(PG8_SB(1, 0), cB + kstep, voffB); PG8_STAGE(PG8_SA(1, 0), cA + kstep, voffA); PG8_STAGE(PG8_SB(1, 1), cB + hstep + kstep, voffB);
        PG8_WAIT_V(6); PG8_BAR;
    }
    for (;;) {
        const bool has_next = S.next(ui + 1, nxt);
        const char* nA = has_next ? (const char*)g.A + (size_t)nxt.pm * tstep : cA; const char* nB = has_next ? (const char*)g.Bt + (size_t)nxt.pn * tstep : cB;
        for (int t = 0; t < nt; t += 2) {
            const bool last = (t == nt - 2);
            const char* a1 = cA + (size_t)(t + 1) * kstep;
            const char* a2 = last ? nA : cA + (size_t)(t + 2) * kstep; const char* b2 = last ? nB : cB + (size_t)(t + 2) * kstep;
            const char* a3 = a2 + kstep; const char* b3 = b2 + kstep;
            if (last && has_next) S.a_ready(nxt);
            if constexpr (SP2) {
            PG8_LDB(B0, 0, 0); PG8_LDB(B1, 0, 1); PG8_SCHED; PG8_LDA(At, 0, 0); PG8_STAGE(PG8_SA(1, 1), a1 + hstep, voffA);
            PG8_WAIT_V(8); PG8_WAIT_L(0); PG8_BAR; PG8_MMA(0, 0, At, B0); PG8_MMA(0, 1, At, B1); PG8_BAR; PG8_SCHED;
            PG8_LDA(At, 0, 1); PG8_STAGE(PG8_SB(0, 0), b2, voffB); PG8_STAGE(PG8_SB(0, 1), b2 + hstep, voffB); PG8_STAGE(PG8_SA(0, 0), a2, voffA);
            PG8_WAIT_V(8); PG8_WAIT_L(0); PG8_BAR; PG8_MMA(1, 0, At, B0); PG8_MMA(1, 1, At, B1); PG8_BAR; PG8_SCHED;
            PG8_LDB(B0, 1, 0); PG8_LDB(B1, 1, 1); PG8_SCHED; PG8_LDA(At, 1, 0); PG8_STAGE(PG8_SA(0, 1), a2 + hstep, voffA);
            PG8_WAIT_V(8); PG8_WAIT_L(0); PG8_BAR; PG8_MMA(0, 0, At, B0); PG8_MMA(0, 1, At, B1); PG8_BAR; PG8_SCHED;
            PG8_LDA(At, 1, 1); PG8_STAGE(PG8_SB(1, 0), b3, voffB); PG8_STAGE(PG8_SB(1, 1), b3 + hstep, voffB); PG8_STAGE(PG8_SA(1, 0), a3, voffA);
            PG8_WAIT_V(8); PG8_WAIT_L(0); PG8_BAR; PG8_MMA(1, 0, At, B0); PG8_MMA(1, 1, At, B1); PG8_BAR; PG8_SCHED;
            } else {
            PG8_LDB(B0, 0, 0); PG8_SCHED; PG8_LDA(At, 0, 0); PG8_STAGE(PG8_SA(1, 1), a1 + hstep, voffA);
            PG8_WAIT_L(8); PG8_BAR; PG8_WAIT_L(0); PG8_MMA(0, 0, At, B0); PG8_BAR; PG8_SCHED;
            PG8_LDB(B1, 0, 1); PG8_STAGE(PG8_SB(0, 0), b2, voffB);
            PG8_BAR; PG8_WAIT_L(0); PG8_MMA(0, 1, At, B1); PG8_BAR;
            PG8_LDA(At, 0, 1); PG8_STAGE(PG8_SA(0, 0), a2, voffA);
            PG8_BAR; PG8_WAIT_L(0); PG8_MMA(1, 0, At, B0); PG8_BAR; PG8_SCHED;
            PG8_STAGE(PG8_SB(0, 1), b2 + hstep, voffB);
            PG8_WAIT_V(6); PG8_BAR; PG8_MMA(1, 1, At, B1); PG8_BAR;
            PG8_LDB(B0, 1, 0); PG8_SCHED; PG8_LDA(At, 1, 0); PG8_STAGE(PG8_SA(0, 1), a2 + hstep, voffA);
            PG8_WAIT_L(8); PG8_BAR; PG8_WAIT_L(0); PG8_MMA(0, 0, At, B0); PG8_BAR; PG8_SCHED;
            PG8_LDB(B1, 1, 1); PG8_STAGE(PG8_SB(1, 0), b3, voffB);
            PG8_BAR; PG8_WAIT_L(0); PG8_MMA(0, 1, At, B1); PG8_BAR;
            PG8_LDA(At, 1, 1); PG8_STAGE(PG8_SA(1, 0), a3, voffA);
            PG8_BAR; PG8_WAIT_L(0); PG8_MMA(1, 0, At, B0); PG8_BAR; PG8_SCHED;
            PG8_STAGE(PG8_SB(1, 1), b3 + hstep, voffB);
            PG8_WAIT_V(6); PG8_BAR; PG8_MMA(1, 1, At, B1); PG8_BAR;
            }
        }
        if constexpr (ALIGN_EPI) { if (wr == 0) PG8_BAR; }
        if constexpr (!Epi::AFTER_DRAIN) { E(acc, cur, wr, wc, fr, fq); S.done(cur); }
        if (!has_next) break;
#pragma unroll
        for (int a = 0; a < 2; ++a)
#pragma unroll
            for (int b = 0; b < 2; ++b)
#pragma unroll
                for (int m = 0; m < 4; ++m)
#pragma unroll
                    for (int n = 0; n < 2; ++n) acc[a][b][m][n] = (f32x4){0.f, 0.f, 0.f, 0.f};
        cur = nxt; cA = nA; cB = nB; ++ui;
        if constexpr (ALIGN_EPI) { if (wr == 1) PG8_BAR; }
    }
    PG8_WAIT_V(0);
    if constexpr (!ALIGN_EPI) { if (wr == 0) PG8_BAR; }
    PG8_BAR;
    if constexpr (Epi::AFTER_DRAIN) { E.fused(acc, cur, wr, wc, fr, fq, lds, wid, lane); S.done(cur); }
#undef PG8_SA
#undef PG8_SB
#undef PG8_STAGE
#undef PG8_LDA
#undef PG8_LDB
#undef PG8_MMA
#undef PG8_WAIT_V
#undef PG8_WAIT_L
#undef PG8_BAR
#undef PG8_SCHED
}
}
struct Args { const float* in[12]; float* out; unsigned char* ws; int ph_lo, ph_hi, flags, pad; };
enum { IN_X = 0, IN_NORMW, IN_WIN, IN_FOXFB, IN_CONVW, IN_CONVB, IN_MIB, IN_MFB, IN_FOXNW, IN_MNW, IN_WOUT, IN_FINW };
constexpr int NWAVES = 8, NTHREADS = 512;
constexpr int LDS_BYTES = 147456;

__device__ __forceinline__ void p0_transpose_gate(const float* W, int ldw, int k0, bf16* WT, int K, LAS float* scr, int lane) {
    const int n_ = lane & 31; const int sc = n_ < 8 ? 4096 + n_ : n_ < 16 ? 8200 + (n_ - 8) : n_ < 24 ? 8208 + (n_ - 16) : -1;
#pragma unroll 8
    for (int i = 0; i < 32; ++i) { const int kk = 2 * i + (lane >> 5); scr[kk * 33 + (lane & 31)] = sc >= 0 ? W[(size_t)(k0 + kk) * ldw + sc] : 0.f; }
    LDS_WAIT(); asm volatile("" ::: "memory");
    const int c = lane & 7;
#pragma unroll
    for (int j = 0; j < 4; ++j) { const int n = (lane >> 3) + 8 * j; const LAS float* s = scr + (8 * c) * 33 + n;
        v4u o; o.x = pk2(s[0 * 33], s[1 * 33]); o.y = pk2(s[2 * 33], s[3 * 33]); o.z = pk2(s[4 * 33], s[5 * 33]); o.w = pk2(s[6 * 33], s[7 * 33]);
        *(v4u*)(WT + (size_t)n * K + k0 + 8 * c) = o; }
    LDS_WAIT(); asm volatile("" ::: "memory");
}
struct XRow { pg8::f32x4 v[8]; };
__device__ __forceinline__ void xrow_load(XRow& R, const float* x, int m, int lane) {
    const pg8::f32x4* xr = (const pg8::f32x4*)(x + (size_t)m * DM) + 2 * lane;
#pragma unroll
    for (int j = 0; j < 4; ++j) { R.v[2 * j] = xr[128 * j]; R.v[2 * j + 1] = xr[128 * j + 1]; }
}
__device__ __forceinline__ void xrow_store(const XRow& R, const pg8::f32x4 (&g)[8], bf16* XN, int m, int lane) {
    float s = 0.f;
#pragma unroll
    for (int j = 0; j < 8; ++j) s += (R.v[j][0] * R.v[j][0] + R.v[j][1] * R.v[j][1]) + (R.v[j][2] * R.v[j][2] + R.v[j][3] * R.v[j][3]);
    const float rstd = 1.0f / sqrtf(wave_sum(s) * (1.f / DM) + NORM_EPS);
    v4u* o = (v4u*)(XN + (size_t)m * DM) + lane;
#pragma unroll
    for (int j = 0; j < 4; ++j) { const pg8::f32x4 a0 = R.v[2 * j] * rstd * g[2 * j], a1 = R.v[2 * j + 1] * rstd * g[2 * j + 1];
        v4u w; w.x = pk2(a0[0], a0[1]); w.y = pk2(a0[2], a0[3]); w.z = pk2(a1[0], a1[1]); w.w = pk2(a1[2], a1[3]); o[64 * j] = w; }
}
struct TTile { const float* src; bf16* dst; int ldw; };
__device__ __forceinline__ void ttile_load(const TTile& t, pg8::f32x4 (&r)[8], int wave, int lane) {
#pragma unroll
    for (int i = 0; i < 8; ++i) r[i] = *(const pg8::f32x4*)(t.src + (size_t)(8 * i + wave) * t.ldw + 4 * lane);
}
__device__ __forceinline__ void phase_prep(const Args& a, LAS unsigned char* lds, int nblk, int blk) {
    const int tid = threadIdx.x, lane = tid & 63, wave = tid >> 6;
    const int gw = blk * NWAVES + wave, NGW = nblk * NWAVES;
    const float* win = a.in[IN_WIN]; const float* wout = a.in[IN_WOUT];
    bf16* WIN_T = (bf16*)(a.ws + WS_WIN); bf16* WG_T = (bf16*)(a.ws + WS_WGT); bf16* WOUT_T = (bf16*)(a.ws + WS_WOUT);
    constexpr int T_MAIN = 32 * 32, T_OUT = 32 * 8, NTILES = T_MAIN + T_OUT, TP = 260;
    LAS float* tile = (LAS float*)lds;
#define P0_DECODE(it_, T_) do { int r_ = (it_); if (r_ < T_MAIN) { const int kb = r_ >> 5, n0 = 256 * (r_ & 31); T_.src = win + (size_t)(64 * kb) * IN_COLS + (n0 < 4096 ? n0 : n0 + 8); T_.dst = WIN_T + (size_t)n0 * DM + 64 * kb; T_.ldw = IN_COLS; } \
        else { r_ -= T_MAIN; const int kb = r_ >> 3, n0 = 256 * (r_ & 7); T_.src = wout + (size_t)(64 * kb) * DM + n0; T_.dst = WOUT_T + (size_t)n0 * DM + 64 * kb; T_.ldw = DM; } } while (0)
    if (!(a.flags & 1)) {
        TTile T; pg8::f32x4 r[8];
        int it = blk; if (it < NTILES) { P0_DECODE(it, T); ttile_load(T, r, wave, lane); }
        for (; it < NTILES; it += nblk) {
#pragma unroll
            for (int i = 0; i < 8; ++i) { const int k = 8 * i + wave; *(LAS pg8::f32x4*)(tile + k * TP + ((4 * lane + 4 * i) & 255)) = r[i]; }
            const bf16* dummy = nullptr; (void)dummy;
            bf16* dst = T.dst;
            const int itn = it + nblk; { const int itc = itn < NTILES ? itn : it; P0_DECODE(itc, T); ttile_load(T, r, wave, lane); } __builtin_amdgcn_sched_barrier(0);
            __syncthreads();
            const int c = lane & 7;
#pragma unroll
            for (int j = 0; j < 4; ++j) { const int n = 32 * wave + 8 * j + (lane >> 3); const LAS float* s = tile + (8 * c) * TP + ((n + 4 * c) & 255);
                v4u o; o.x = pk2(s[0 * TP], s[1 * TP]); o.y = pk2(s[2 * TP], s[3 * TP]); o.z = pk2(s[4 * TP], s[5 * TP]); o.w = pk2(s[6 * TP], s[7 * TP]);
                *(v4u*)(dst + (size_t)n * DM + 8 * c) = o; }
            __syncthreads();
        }
        if (gw < 32) p0_transpose_gate(win, IN_COLS, 64 * gw, WG_T, DM, (LAS float*)(lds + wave * 16384), lane);
        __syncthreads();
    }
#undef P0_DECODE
    const float* x = a.in[IN_X]; bf16* XN = (bf16*)(a.ws + WS_XN);
    pg8::f32x4 g[8];
    { const pg8::f32x4* wr = (const pg8::f32x4*)a.in[IN_NORMW] + 2 * lane;
#pragma unroll
      for (int j = 0; j < 4; ++j) { g[2 * j] = wr[128 * j]; g[2 * j + 1] = wr[128 * j + 1]; } }
    XRow R0, R1, R2, R3;
    int m = (a.flags & 2) ? M_TOK : gw;
#define XLD(R_, m_) do { xrow_load(R_, x, (m_) < M_TOK ? (m_) : M_TOK - 1, lane); __builtin_amdgcn_sched_barrier(0); } while (0)
#define XST(R_, m_) do { if ((m_) < M_TOK) xrow_store(R_, g, XN, (m_), lane); __builtin_amdgcn_sched_barrier(0); } while (0)
    XLD(R0, m); XLD(R1, m + NGW); XLD(R2, m + 2 * NGW);
    for (; m < M_TOK; m += 4 * NGW) {
        XLD(R3, m + 3 * NGW); XST(R0, m);
        XLD(R0, m + 4 * NGW); XST(R1, m + NGW);
        XLD(R1, m + 5 * NGW); XST(R2, m + 2 * NGW);
        XLD(R2, m + 6 * NGW); XST(R3, m + 3 * NGW);
    }
#undef XLD
#undef XST
}

__device__ __forceinline__ void gate_unit(const Args& a, LAS unsigned char* lds, int c) {
    const int tid = threadIdx.x, lane = tid & 63, wave = tid >> 6, r32 = lane & 31, hi = lane >> 5;
    const bf16* XN = (const bf16*)(a.ws + WS_XN); const bf16* WG_T = (const bf16*)(a.ws + WS_WGT);
    f32x16 acc0 = {}, acc1 = {};
    const bf16* a0 = XN + (size_t)(64 * c + r32) * DM + 256 * wave + 8 * hi; const bf16* a1 = a0 + (size_t)32 * DM;
    const bf16* bp = WG_T + (size_t)r32 * DM + 256 * wave + 8 * hi;
#pragma unroll 8
    for (int ks = 0; ks < 16; ++ks) {
        const pg8::bf16x8 A0 = *(const pg8::bf16x8*)(a0 + 16 * ks), A1 = *(const pg8::bf16x8*)(a1 + 16 * ks), Bf = *(const pg8::bf16x8*)(bp + 16 * ks);
        acc0 = __builtin_amdgcn_mfma_f32_32x32x16_bf16(A0, Bf, acc0, 0, 0, 0);
        acc1 = __builtin_amdgcn_mfma_f32_32x32x16_bf16(A1, Bf, acc1, 0, 0, 0);
    }
    LAS float* part = (LAS float*)lds;
#pragma unroll
    for (int r = 0; r < 16; ++r) { const int row = (r & 3) + 8 * (r >> 2) + 4 * hi;
        part[(wave * 64 + row) * 32 + r32] = acc0[r]; part[(wave * 64 + 32 + row) * 32 + r32] = acc1[r]; }
    __syncthreads();
    float* G = (float*)(a.ws + WS_GATE);
    for (int e = tid; e < 64 * 32; e += NTHREADS) { const int row = e >> 5, j = e & 31; float s = 0.f;
#pragma unroll
        for (int w = 0; w < 8; ++w) s += part[(w * 64 + row) * 32 + j];
        float v;
        if (j < 8) v = logsigmoidf(s + a.in[IN_FOXFB][j]); else if (j < 16) v = s + a.in[IN_MIB][j - 8]; else if (j < 24) v = logsigmoidf(s + a.in[IN_MFB][j - 16]); else v = 0.f;
        G[(size_t)(64 * c + row) * 32 + j] = v; }
    __syncthreads();
}

__device__ __forceinline__ void fox_cumsum_item(const Args& a, LAS unsigned char* lds, int it) {
    const int tid = threadIdx.x, lane = tid & 63, wave = tid >> 6; const int bh = it >> 3, part = it & 7, b = bh >> 3, h = bh & 7;
    const float* G = (const float*)(a.ws + WS_GATE) + (size_t)b * SEQ * 32 + h; bf16* KB = (bf16*)(a.ws + WS_KBIAS);
    LAS float* wtot = (LAS float*)lds;
    const int s = part * 512 + tid;
    const float v = G[(size_t)s * 32];
    float pre = 0.f;
    for (int j = 0; j < part; ++j) pre += G[(size_t)(j * 512 + tid) * 32];
    const float incl = wave_scan_add(v);
    pre = wave_sum(pre);
    if (lane == 63) wtot[wave] = incl;
    if (lane == 0) wtot[8 + wave] = pre;
    __syncthreads();
    float base = 0.f;
#pragma unroll
    for (int w = 0; w < 8; ++w) { base += wtot[8 + w]; if (w < wave) base += wtot[w]; }
    const float kb2 = -(base + incl) * LOG2E;
    const unsigned h1 = f2bf(kb2); const float r1 = kb2 - bf2f(h1); const unsigned h2 = f2bf(r1); const float r2 = r1 - bf2f(h2); const unsigned h3 = f2bf(r2);
    v4u o; o.x = h1 | (h2 << 16); o.y = h3; o.z = 0u; o.w = 0u;
    *(v4u*)(KB + ((size_t)bh * SEQ + s) * 8) = o;
    if ((s & 63) == 63) ((float*)(a.ws + WS_KBND))[bh * 64 + (s >> 6)] = kb2 + 0.01f;
    __syncthreads();
}

struct ORow { pg8::f32x4 v[8]; v4u d[4]; };
__device__ __forceinline__ void orow_load(ORow& R, const float* x, const bf16* delta, int m, int lane) {
    const pg8::f32x4* xr = (const pg8::f32x4*)(x + (size_t)m * DM) + 2 * lane; const v4u* dr = (const v4u*)(delta + (size_t)m * DM) + lane;
#pragma unroll
    for (int j = 0; j < 4; ++j) { R.v[2 * j] = xr[128 * j]; R.v[2 * j + 1] = xr[128 * j + 1]; R.d[j] = dr[64 * j]; }
}
__device__ __forceinline__ void orow_store(ORow& R, const pg8::f32x4 (&g)[8], float* out, int m, int lane) {
    float s = 0.f;
#pragma unroll
    for (int j = 0; j < 4; ++j) { const v4u d = R.d[j];
        R.v[2 * j] += (pg8::f32x4){bflo(d.x), bfhi(d.x), bflo(d.y), bfhi(d.y)}; R.v[2 * j + 1] += (pg8::f32x4){bflo(d.z), bfhi(d.z), bflo(d.w), bfhi(d.w)};
        const pg8::f32x4 a0 = R.v[2 * j], a1 = R.v[2 * j + 1];
        s += ((a0[0] * a0[0] + a0[1] * a0[1]) + (a0[2] * a0[2] + a0[3] * a0[3])) + ((a1[0] * a1[0] + a1[1] * a1[1]) + (a1[2] * a1[2] + a1[3] * a1[3])); }
    const float rstd = 1.0f / sqrtf(wave_sum(s) * (1.f / DM) + NORM_EPS);
    pg8::f32x4* o = (pg8::f32x4*)(out + (size_t)m * DM) + 2 * lane;
#pragma unroll
    for (int j = 0; j < 4; ++j) { o[128 * j] = R.v[2 * j] * rstd * g[2 * j]; o[128 * j + 1] = R.v[2 * j + 1] * rstd * g[2 * j + 1]; }
}
__device__ __forceinline__ void phase_final(const Args& a, int nblk, int blk) {
    const int tid = threadIdx.x, lane = tid & 63, wave = tid >> 6; const int gw = blk * NWAVES + wave, NGW = nblk * NWAVES;
    const bf16* delta = (const bf16*)(a.ws + WS_DELTA); const float* x = a.in[IN_X];
    pg8::f32x4 g[8];
    { const pg8::f32x4* wr = (const pg8::f32x4*)a.in[IN_FINW] + 2 * lane;
#pragma unroll
      for (int j = 0; j < 4; ++j) { g[2 * j] = wr[128 * j]; g[2 * j + 1] = wr[128 * j + 1]; } }
    ORow RA, RB;
    int m = gw; orow_load(RA, x, delta, m < M_TOK ? m : M_TOK - 1, lane);
    for (; m < M_TOK; m += 2 * NGW) {
        const int mb = m + NGW, mc = m + 2 * NGW;
        orow_load(RB, x, delta, mb < M_TOK ? mb : M_TOK - 1, lane); __builtin_amdgcn_sched_barrier(0);
        orow_store(RA, g, a.out, m, lane); __builtin_amdgcn_sched_barrier(0);
        orow_load(RA, x, delta, mc < M_TOK ? mc : M_TOK - 1, lane); __builtin_amdgcn_sched_barrier(0);
        if (mb < M_TOK) orow_store(RB, g, a.out, mb, lane);
        __builtin_amdgcn_sched_barrier(0);
    }
}

namespace fox {
typedef short bf16x8 __attribute__((ext_vector_type(8)));
typedef short s16x4 __attribute__((ext_vector_type(4)));
typedef float f32x16 __attribute__((ext_vector_type(16)));
typedef unsigned u32x4 __attribute__((ext_vector_type(4)));
typedef LAS char* lptr;
constexpr int D = 128, NW = 8, QBLK = 32, KVBLK = 64, QB = NW * QBLK;
constexpr int SHM_V = KVBLK * D * 2, SHM_K = KVBLK * D * 2;
constexpr int OFF_V = 0, OFF_K = 2 * SHM_V, OFF_WS = 2 * SHM_V + 2 * SHM_K, OFF_KB = OFF_WS + NW * 64 * 4, OFF_VOTE = OFF_KB + 2 * 1024, LDS_NEED = OFF_VOTE + 64;
constexpr int OFF_KSUF = 73728;
constexpr float THR2 = 11.5f;
#define KSWZ(row, colB) ((row) * 256 + ((colB) ^ (((row) & 7) << 4)))
#define SBAR() __builtin_amdgcn_sched_barrier(0)
__device__ __forceinline__ int v_st(int k, int c) { const int kk = (k & ~0xC) | ((k & 4) << 1) | ((k & 8) >> 1); return ((kk >> 3) * 4 + (c >> 5)) * 512 + ((kk & 7) * 32 + (c & 31)) * 2; }
__device__ __forceinline__ int v_rd_base(int lane) { return ((lane & 3) << 3) | (((lane >> 2) & 3) << 6) | (((lane >> 4) & 1) << 5) | (((lane >> 5) & 1) << 8); }
constexpr int v_rd_off(int d0, int ks, int half) { return d0 * 512 + ks * 4096 + half * 2048; }
__device__ __forceinline__ int crow(int r, int hi) { return (r & 3) + 8 * (r >> 2) + 4 * hi; }
__device__ __forceinline__ unsigned cvtpk(float lo, float hi) { return pk2(lo, hi); }
__device__ __forceinline__ void mask_tile(f32x16& p0, f32x16& p1, int dq) {
    const float NEG = -__builtin_inff();
#pragma unroll
    for (int r = 0; r < 16; ++r) { const int c = (r & 3) + 8 * (r >> 2);
        if (dq - c < 0) p0[r] = NEG;
        if (dq - c - 32 < 0) p1[r] = NEG; }
}
__device__ __forceinline__ void partialSM(f32x16& p0, f32x16& p1, float& m_reg, float& mn, float& alpha) {
    float pmax = p0[0];
#pragma unroll
    for (int r = 1; r < 16; ++r) pmax = fmaxf(pmax, p0[r]);
#pragma unroll
    for (int r = 0; r < 16; ++r) pmax = fmaxf(pmax, p1[r]);
    { auto rr = __builtin_amdgcn_permlane32_swap(__float_as_uint(pmax), __float_as_uint(pmax), false, false);
      pmax = fmaxf(__uint_as_float(rr[0]), __uint_as_float(rr[1])); }
    if (__builtin_expect(__all((pmax - m_reg) <= THR2), 1)) { mn = m_reg; alpha = 1.f; }
    else { mn = fmaxf(m_reg, pmax); alpha = __builtin_amdgcn_exp2f(m_reg - mn); m_reg = mn; }
#pragma unroll
    for (int r = 0; r < 16; ++r) p0[r] = p0[r] - mn;
#pragma unroll
    for (int r = 0; r < 16; ++r) p1[r] = p1[r] - mn;
#pragma unroll
    for (int r = 0; r < 16; ++r) p0[r] = __builtin_amdgcn_exp2f(p0[r]);
}
__device__ __forceinline__ void finishSM(f32x16& p0, f32x16& p1, float alpha, float& l_reg, bf16x8& pa0, bf16x8& pa1, bf16x8& pa2, bf16x8& pa3) {
#pragma unroll
    for (int r = 0; r < 16; ++r) p1[r] = __builtin_amdgcn_exp2f(p1[r]);
    float ps = 0;
#pragma unroll
    for (int r = 0; r < 16; ++r) ps += p0[r];
#pragma unroll
    for (int r = 0; r < 16; ++r) ps += p1[r];
    { auto rr = __builtin_amdgcn_permlane32_swap(__float_as_uint(ps), __float_as_uint(ps), false, false);
      ps = __uint_as_float(rr[0]) + __uint_as_float(rr[1]); }
    l_reg = l_reg * alpha + ps;
#define PK4(P, B_, OUT) do { unsigned a0 = cvtpk(P[B_+0], P[B_+1]), a1 = cvtpk(P[B_+2], P[B_+3]);                          \
        unsigned b0 = cvtpk(P[B_+4], P[B_+5]), b1 = cvtpk(P[B_+6], P[B_+7]);                                             \
        auto r0 = __builtin_amdgcn_permlane32_swap(a0, b0, false, false); auto r1 = __builtin_amdgcn_permlane32_swap(a1, b1, false, false); \
        u32x4 w = {r0[0], r1[0], r0[1], r1[1]}; OUT = __builtin_bit_cast(bf16x8, w); } while (0)
    PK4(p0, 0, pa0); PK4(p0, 8, pa1); PK4(p1, 0, pa2); PK4(p1, 8, pa3);
#undef PK4
}
template <int KB>
__device__ __forceinline__ void qkt(f32x16& p0, f32x16& p1, lptr lds, int r32, int hi, const bf16x8* qr, bf16x8 qone) {
    p0 = f32x16{}; p1 = f32x16{};
    __builtin_amdgcn_s_setprio(1);
    lptr kb[4];
#pragma unroll
    for (int dd = 0; dd < 4; ++dd) kb[dd] = lds + OFF_K + KB * SHM_K + KSWZ(r32, (dd * 16 + hi * 8) * 2);
#pragma unroll
    for (int d0 = 0; d0 < 8; ++d0) { lptr a = kb[d0 & 3] + (d0 >> 2) * 128;
        bf16x8 b0 = *(const LAS bf16x8*)(a);
        bf16x8 b1 = *(const LAS bf16x8*)(a + 32 * 256);
        p0 = __builtin_amdgcn_mfma_f32_32x32x16_bf16(b0, qr[d0], p0, 0, 0, 0);
        p1 = __builtin_amdgcn_mfma_f32_32x32x16_bf16(b1, qr[d0], p1, 0, 0, 0); }
    { lptr a = lds + OFF_KB + KB * 1024 + r32 * 16;
        bf16x8 b0 = *(const LAS bf16x8*)(a);
        bf16x8 b1 = *(const LAS bf16x8*)(a + 512);
        p0 = __builtin_amdgcn_mfma_f32_32x32x16_bf16(b0, qone, p0, 0, 0, 0);
        p1 = __builtin_amdgcn_mfma_f32_32x32x16_bf16(b1, qone, p1, 0, 0, 0); }
    __builtin_amdgcn_s_setprio(0);
}
template <int VB>
__device__ __forceinline__ void pv_tile(f32x16* o, int vb0, bf16x8 pa0, bf16x8 pa1, bf16x8 pa2, bf16x8 pa3) {
#define TRRD(dst, off) asm volatile("ds_read_b64_tr_b16 %0, %1 offset:%2" : "=&v"(dst) : "v"(vb0), "i"(off) : "memory")
#define PV_D0(d0) do { s16x4 l0, l1, l2, l3, h0, h1, h2, h3; constexpr int b_ = OFF_V + VB * SHM_V + v_rd_off(d0, 0, 0); \
        TRRD(l0, b_); TRRD(h0, b_ + 2048); TRRD(l1, b_ + 4096); TRRD(h1, b_ + 6144); TRRD(l2, b_ + 8192); TRRD(h2, b_ + 10240); TRRD(l3, b_ + 12288); TRRD(h3, b_ + 14336); \
        asm volatile("s_waitcnt lgkmcnt(0)" ::: "memory"); SBAR();   \
        o[d0] = __builtin_amdgcn_mfma_f32_32x32x16_bf16(pa0, (bf16x8){l0[0], l0[1], l0[2], l0[3], h0[0], h0[1], h0[2], h0[3]}, o[d0], 0, 0, 0);   \
        o[d0] = __builtin_amdgcn_mfma_f32_32x32x16_bf16(pa1, (bf16x8){l1[0], l1[1], l1[2], l1[3], h1[0], h1[1], h1[2], h1[3]}, o[d0], 0, 0, 0);   \
        o[d0] = __builtin_amdgcn_mfma_f32_32x32x16_bf16(pa2, (bf16x8){l2[0], l2[1], l2[2], l2[3], h2[0], h2[1], h2[2], h2[3]}, o[d0], 0, 0, 0);   \
        o[d0] = __builtin_amdgcn_mfma_f32_32x32x16_bf16(pa3, (bf16x8){l3[0], l3[1], l3[2], l3[3], h3[0], h3[1], h3[2], h3[3]}, o[d0], 0, 0, 0); } while (0)
    __builtin_amdgcn_s_setprio(1); PV_D0(0); PV_D0(1); PV_D0(2); PV_D0(3); __builtin_amdgcn_s_setprio(0);
#undef PV_D0
#undef TRRD
}
struct BlockRef { const bf16* Q; const bf16* K; const bf16* V; const bf16* KB; const LAS float* ksuf; const float* kbnd; int P0; int tok0; int h; };
struct Seam { bf16x8 qr[8]; bf16x8 st_v0, st_v1, st_k0, st_k1; u32x4 st_kb; };
#define VMW() asm volatile("s_waitcnt vmcnt(0)" ::: "memory")
#define BL128(rs, vo, so) __builtin_bit_cast(bf16x8, __builtin_amdgcn_raw_buffer_load_b128(rs, (int)(vo), (int)(so), 0))
#define SLOAD_H(k0) do { const int so_ = (k0) * 256; S.st_v0 = BL128(rsV, voffKV, so_); S.st_v1 = BL128(rsV, voffKV, so_ + 8192);              \
                         S.st_k0 = BL128(rsK, voffKV, so_); S.st_k1 = BL128(rsK, voffKV, so_ + 8192); \
                         S.st_kb = __builtin_amdgcn_raw_buffer_load_b128(rsB, lane * 16, (k0) * 16, 0); } while (0)
#define SWRITE_HK(bf) do { *(LAS bf16x8*)(lds + OFF_K + (bf) * SHM_K + kws) = S.st_k0; *(LAS bf16x8*)(lds + OFF_K + (bf) * SHM_K + kws + 32 * 256) = S.st_k1; \
                         if (wid == 0) *(LAS u32x4*)(lds + OFF_KB + (bf) * 1024 + lane * 16) = S.st_kb; } while (0)
#define SWRITE_HV(bf) do { *(LAS bf16x8*)(lds + OFF_V + (bf) * SHM_V + vst0) = S.st_v0; *(LAS bf16x8*)(lds + OFF_V + (bf) * SHM_V + vst1) = S.st_v1; } while (0)
#define SWRITE_H(bf) do { SWRITE_HV(bf); SWRITE_HK(bf); } while (0)
__device__ __forceinline__ __amdgpu_buffer_rsrc_t mk_rsrc(const void* p, unsigned bytes) {
    const unsigned long long v = (unsigned long long)p; const unsigned lo = __builtin_amdgcn_readfirstlane((unsigned)v), hi = __builtin_amdgcn_readfirstlane((unsigned)(v >> 32));
    return __builtin_amdgcn_make_buffer_rsrc((void*)(((unsigned long long)hi << 32) | lo), 0, bytes, 0x00020000);
}
struct EpiParams { const float* g; const bf16* FZ; bf16* Y; };
__device__ __forceinline__ void block(const BlockRef& cur, lptr lds, const EpiParams& E, unsigned* ctr, int blk, LAS int* slot) {
    Seam S;
    const int tid = threadIdx.x, wid = __builtin_amdgcn_readfirstlane(tid >> 6), lane = tid & 63, r32 = lane & 31, hi = lane >> 5;
    const int NT = (cur.P0 + QB) / KVBLK;
    int NTe = NT;
    LAS int* vote = (LAS int*)(lds + OFF_VOTE);
    const int qlo = cur.P0 + wid * QBLK, qm = qlo + r32 - 4 * hi;
    LAS float* ws = (LAS float*)(lds + OFF_WS) + wid * 64; LAS float* li_l = ws; LAS float* al_l = ws + 32;
    float m_reg = -1e30f, l_reg = 0; f32x16 o[4] = {};
    const int sr = tid >> 4, sc = (tid & 15) * 8, vst0 = v_st(sr, sc), vst1 = v_st(32 + sr, sc), kws = KSWZ(sr, sc * 2);
    const int vb0 = (int)(uintptr_t)(lds) + v_rd_base(lane);
    const __amdgpu_buffer_rsrc_t rsK = mk_rsrc(cur.K, SEQ * 256), rsV = mk_rsrc(cur.V, SEQ * 256), rsB = mk_rsrc(cur.KB, SEQ * 16), rsQ = mk_rsrc(cur.Q, QB * 256);
    const int voffKV = (sr * D + sc) * 2;
    bf16x8 qone; { u32x4 w = {hi ? 0u : 0x3F803F80u, hi ? 0u : 0x00003F80u, 0u, 0u}; qone = __builtin_bit_cast(bf16x8, w); }
#define RESC(a) do { if (__any((a) < 1.f)) { if (hi == 0) al_l[r32] = (a); asm volatile("s_waitcnt lgkmcnt(0)" ::: "memory");              \
                     _Pragma("unroll") for (int d_ = 0; d_ < 4; ++d_) _Pragma("unroll") for (int r = 0; r < 16; ++r) o[d_][r] *= al_l[crow(r, hi)]; } } while (0)
#define KBASE(t) ((NT - 1 - (t)) * KVBLK)
#define MASKT(P0_, P1_, t) do { const int kb_ = KBASE(t); if (kb_ + KVBLK - 1 > qlo) mask_tile(P0_, P1_, qm - kb_); } while (0)
    f32x16 pA0, pA1, pB0, pB1; float mnA, mnB, alA, alB; bf16x8 pa0, pa1, pa2, pa3;
    { const int voffQ = ((wid * QBLK + r32) * D + hi * 8) * 2;
#pragma unroll
      for (int d0 = 0; d0 < 8; ++d0) S.qr[d0] = BL128(rsQ, voffQ, d0 * 32); }
    float qn;
    { float ssq = 0.f;
#pragma unroll
      for (int d0 = 0; d0 < 8; ++d0) { const u32x4 w = __builtin_bit_cast(u32x4, S.qr[d0]);
          ssq += (bflo(w.x) * bflo(w.x) + bfhi(w.x) * bfhi(w.x)) + (bflo(w.y) * bflo(w.y) + bfhi(w.y) * bfhi(w.y)) + (bflo(w.z) * bflo(w.z) + bfhi(w.z) * bfhi(w.z)) + (bflo(w.w) * bflo(w.w) + bfhi(w.w) * bfhi(w.w)); }
      auto rr = __builtin_amdgcn_permlane32_swap(__float_as_uint(ssq), __float_as_uint(ssq), false, false);
      qn = sqrtf(__uint_as_float(rr[0]) + __uint_as_float(rr[1])) * 1.001f; }
    SLOAD_H(KBASE(0)); VMW(); SWRITE_HK(0);
    __syncthreads();
    SWRITE_HV(0); SBAR();
    SLOAD_H(KBASE(1));
    SBAR(); qkt<0>(pA0, pA1, lds, r32, hi, S.qr, qone);
    MASKT(pA0, pA1, 0); partialSM(pA0, pA1, m_reg, mnA, alA);
    VMW(); SWRITE_H(1);
    __syncthreads();
#define HALF_STEP(PX0, PX1, mnX, alX, PY0, PY1, alY, t, KB, VB, SB, VOTE) do {                                                      \
        SBAR(); qkt<KB>(PX0, PX1, lds, r32, hi, S.qr, qone);                                             \
        finishSM(PY0, PY1, alY, l_reg, pa0, pa1, pa2, pa3); SBAR();                                                           \
        if ((t) + 1 < NTe) { SLOAD_H(KBASE((t) + 1)); SBAR(); }                                               \
        pv_tile<VB>(o, vb0, pa0, pa1, pa2, pa3); MASKT(PX0, PX1, (t)); partialSM(PX0, PX1, m_reg, mnX, alX);                                        \
        const int jj_ = NT - 1 - ((t) + 2);                                                                                   \
        if (VOTE && jj_ >= 0) { const bool sk_ = __all(qn * cur.ksuf[jj_] + cur.kbnd[jj_] - m_reg < -152.f); if (lane == 0) vote[wid] = sk_ ? 1 : 0; }                      \
        __syncthreads();                                                                                                      \
        if ((t) + 1 < NTe) { VMW(); SWRITE_H(SB); }                                                                          \
        if (VOTE && jj_ >= 0) { const int v_ = vote[lane & 7]; if (__all(v_ != 0)) NTe = (t) + 2; }                                          \
        RESC(alX); __syncthreads(); } while (0)
    for (int t = 1; t + 1 < NTe; t += 2) {
        HALF_STEP(pB0, pB1, mnB, alB, pA0, pA1, alA, t, 1, 0, 0, false);
        HALF_STEP(pA0, pA1, mnA, alA, pB0, pB1, alB, t + 1, 0, 1, 1, true);
    }
    SBAR(); qkt<1>(pB0, pB1, lds, r32, hi, S.qr, qone); SBAR();
    finishSM(pA0, pA1, alA, l_reg, pa0, pa1, pa2, pa3); SBAR();
    pv_tile<0>(o, vb0, pa0, pa1, pa2, pa3);
    MASKT(pB0, pB1, NTe - 1); partialSM(pB0, pB1, m_reg, mnB, alB); __syncthreads(); RESC(alB);
    finishSM(pB0, pB1, alB, l_reg, pa0, pa1, pa2, pa3); SBAR(); pv_tile<1>(o, vb0, pa0, pa1, pa2, pa3);
    SBAR();
    if (tid == 0) { int it_ = -1;
        for (int k_ = 0; k_ < 8; ++k_) { const int q_ = (blk + k_) & 7; const unsigned i_ = atomicAdd(&ctr[q_ * 64], 1u); if (i_ < 64u) { it_ = q_ * 64 + (int)i_; break; } }
        *slot = it_; }
    if (hi == 0) li_l[r32] = l_reg; asm volatile("s_waitcnt lgkmcnt(0)" ::: "memory");
    {
        LAS float* stg = (LAS float*)(lds + OFF_K) + wid * 1024;
        int lane_o = lane; asm volatile("" : "+v"(lane_o));
        const int erow = lane_o >> 3, seg = lane_o & 7;
        const float* gp = E.g + cur.h * 128 + seg * 16;
        pg8::f32x4 g4[4];
#pragma unroll
        for (int j = 0; j < 4; ++j) g4[j] = *(const pg8::f32x4*)(gp + 4 * j);
        const unsigned trow = (unsigned)(cur.tok0 + wid * QBLK);
#pragma unroll
        for (int p = 0; p < 4; ++p) {
            const unsigned tokr = trow + 8u * p + (unsigned)erow;
            const bf16* zp = E.FZ + (tokr * 1024u + (unsigned)(cur.h * 128 + seg * 16));
            const u32x4 z0 = *(const u32x4*)zp, z1 = *(const u32x4*)(zp + 8);
#pragma unroll
            for (int rr = 0; rr < 4; ++rr) { const int r = 4 * p + rr; const float rl = __builtin_amdgcn_rcpf(li_l[crow(r, hi)]);
#pragma unroll
                for (int d0 = 0; d0 < 4; ++d0) stg[(rr + 4 * hi) * 128 + d0 * 32 + r32] = o[d0][r] * rl; }
            asm volatile("s_waitcnt lgkmcnt(0)" ::: "memory");
            float x[16]; float ss = 0.f;
#pragma unroll
            for (int j = 0; j < 4; ++j) { const pg8::f32x4 v = *(const LAS pg8::f32x4*)(stg + erow * 128 + seg * 16 + 4 * j); x[4 * j] = v[0]; x[4 * j + 1] = v[1]; x[4 * j + 2] = v[2]; x[4 * j + 3] = v[3];
                ss += (v[0] * v[0] + v[1] * v[1]) + (v[2] * v[2] + v[3] * v[3]); }
            asm volatile("s_waitcnt lgkmcnt(0)" ::: "memory");
            ss += __shfl_xor(ss, 1); ss += __shfl_xor(ss, 2); ss += __shfl_xor(ss, 4);
            const float rs = 1.0f / sqrtf(ss * (1.f / 128.f) + NORM_EPS);
            float zf[16]; zf[0] = bflo(z0.x); zf[1] = bfhi(z0.x); zf[2] = bflo(z0.y); zf[3] = bfhi(z0.y); zf[4] = bflo(z0.z); zf[5] = bfhi(z0.z); zf[6] = bflo(z0.w); zf[7] = bfhi(z0.w);
            zf[8] = bflo(z1.x); zf[9] = bfhi(z1.x); zf[10] = bflo(z1.y); zf[11] = bfhi(z1.y); zf[12] = bflo(z1.z); zf[13] = bfhi(z1.z); zf[14] = bflo(z1.w); zf[15] = bfhi(z1.w);
            float y[16];
#pragma unroll
            for (int e = 0; e < 16; ++e) y[e] = x[e] * rs * g4[e >> 2][e & 3] * (zf[e] * __builtin_amdgcn_rcpf(1.f + __builtin_amdgcn_exp2f(-zf[e] * LOG2E)));
            u32x4 o0, o1; o0.x = cvtpk(y[0], y[1]); o0.y = cvtpk(y[2], y[3]); o0.z = cvtpk(y[4], y[5]); o0.w = cvtpk(y[6], y[7]);
            o1.x = cvtpk(y[8], y[9]); o1.y = cvtpk(y[10], y[11]); o1.z = cvtpk(y[12], y[13]); o1.w = cvtpk(y[14], y[15]);
            bf16* yp = E.Y + (tokr * 2048u + (unsigned)(cur.h * 128 + seg * 16));
            *(u32x4*)yp = o0; *(u32x4*)(yp + 8) = o1;
        }
    }
    __syncthreads();
#undef RESC
#undef KBASE
#undef MASKT
#undef HALF_STEP
}
#undef VMW
#undef BL128
#undef SLOAD_H
#undef SWRITE_HK
#undef SWRITE_HV
#undef SWRITE_H
#undef KSWZ
#undef SBAR
__device__ __forceinline__ BlockRef make_ref(const Args& a, lptr lds, int bh, int qb) {
    BlockRef r; const size_t hb = (size_t)bh * SEQ * 128;
    r.Q = (const bf16*)(a.ws + WS_SEC + SEC_FQ * SEC_BYTES) + hb + (size_t)qb * QB * 128;
    r.K = (const bf16*)(a.ws + WS_SEC + SEC_FK * SEC_BYTES) + hb; r.V = (const bf16*)(a.ws + WS_SEC + SEC_FV * SEC_BYTES) + hb;
    r.KB = (const bf16*)(a.ws + WS_KBIAS) + (size_t)bh * SEQ * 8;
    r.ksuf = (const LAS float*)(lds + OFF_KSUF) + bh * 64; r.kbnd = (const float*)(a.ws + WS_KBND) + bh * 64;
    r.P0 = qb * QB; r.tok0 = (bh >> 3) * SEQ + qb * QB; r.h = bh & 7; return r;
}
__device__ __forceinline__ void phase(const Args& a, lptr lds, int nblk, int blk) {
    const EpiParams E{a.in[IN_FOXNW], (const bf16*)(a.ws + WS_SEC + SEC_FZ * SEC_BYTES), (bf16*)(a.ws + WS_Y)};
    unsigned* ctr = (unsigned*)(a.ws + WS_CTL) + 1024; LAS int* slot = (LAS int*)(lds + OFF_VOTE + 32);
    {
        const int lane = threadIdx.x & 63, w4 = (threadIdx.x >> 6) * 4; float v[4];
#pragma unroll
        for (int k = 0; k < 4; ++k) v[k] = ((const float*)(a.ws + WS_KNRM))[(w4 + k) * 64 + lane];
#pragma unroll
        for (int k = 0; k < 4; ++k) ((LAS float*)(lds + OFF_KSUF))[(w4 + k) * 64 + lane] = wave_scan_max(v[k]);
    }
    if (threadIdx.x == 0) { int item = -1;
        for (int k = 0; k < 8; ++k) { const int q = (blk + k) & 7; const unsigned i = atomicAdd(&ctr[q * 64], 1u); if (i < 64u) { item = q * 64 + (int)i; break; } }
        *slot = item; }
    __syncthreads();
    for (;;) {
        const int item = __builtin_amdgcn_readfirstlane(*slot);
        if (item < 0) break;
        const int q = item >> 6, i = item & 63, qb = 15 - (i >> 2), sl = i & 3;
        const int h = (((q & 1) ? 0x7421 : 0x6530) >> (4 * sl)) & 0xF, bh = (q >> 1) * 8 + h;
        const BlockRef cur = make_ref(a, lds, bh, qb);
        block(cur, lds, E, ctr, blk, slot);
    }
    __syncthreads();
}
__device__ __forceinline__ void knorm_pass(const Args& a, int nblk, int blk) {
    const int tid = threadIdx.x, lane = tid & 63, wave = tid >> 6; const int gw = blk * NW + wave, NGW = nblk * NW;
    const bf16* FK = (const bf16*)(a.ws + WS_SEC + SEC_FK * SEC_BYTES); float* KN = (float*)(a.ws + WS_KNRM);
    for (int it = gw; it < BATCH * NH * 64; it += NGW) {
        const u32x4* kr = (const u32x4*)(FK + (size_t)it * 64 * 128) + lane;
        u32x4 w[16];
#pragma unroll
        for (int c = 0; c < 16; ++c) w[c] = kr[64 * c];
        float mx = 0.f;
#pragma unroll
        for (int c = 0; c < 16; ++c) { const u32x4 v = w[c];
            float ss = (bflo(v.x) * bflo(v.x) + bfhi(v.x) * bfhi(v.x)) + (bflo(v.y) * bflo(v.y) + bfhi(v.y) * bfhi(v.y)) + (bflo(v.z) * bflo(v.z) + bfhi(v.z) * bfhi(v.z)) + (bflo(v.w) * bflo(v.w) + bfhi(v.w) * bfhi(v.w));
            ss += __shfl_xor(ss, 1); ss += __shfl_xor(ss, 2); ss += __shfl_xor(ss, 4); ss += __shfl_xor(ss, 8);
            mx = fmaxf(mx, ss); }
        mx = fmaxf(mx, __shfl_xor(mx, 16)); mx = fmaxf(mx, __shfl_xor(mx, 32));
        if (lane == 0) KN[it] = sqrtf(mx) * 1.001f;
    }
}
}

namespace ml {
typedef short bf16x8 __attribute__((ext_vector_type(8)));
typedef short s16x4 __attribute__((ext_vector_type(4)));
typedef float f32x16 __attribute__((ext_vector_type(16)));
typedef unsigned u32x4 __attribute__((ext_vector_type(4)));
typedef LAS char* lptr;
constexpr int ROWP = 144;
__device__ __forceinline__ int crow(int r, int hi) { return (r & 3) + 8 * (r >> 2) + 4 * hi; }
__device__ __forceinline__ int t_st(int k, int c) { const int kk = (k & ~0xC) | ((k & 4) << 1) | ((k & 8) >> 1); return ((kk >> 3) * 4 + (c >> 5)) * 512 + ((kk & 7) * 32 + (c & 31)) * 2; }
__device__ __forceinline__ int t_rd_base(int lane) { return ((lane & 3) << 3) | (((lane >> 2) & 3) << 6) | (((lane >> 4) & 1) << 5) | (((lane >> 5) & 1) << 8); }
#define TRFRAG(dst, addr, ks) do { s16x4 l_, h_; asm volatile("ds_read_b64_tr_b16 %0, %1 offset:%2" : "=&v"(l_) : "v"(addr), "i"((ks) * 4096) : "memory"); \
        asm volatile("ds_read_b64_tr_b16 %0, %1 offset:%2" : "=&v"(h_) : "v"(addr), "i"((ks) * 4096 + 2048) : "memory"); \
        asm volatile("s_waitcnt lgkmcnt(0)" ::: "memory"); __builtin_amdgcn_sched_barrier(0); \
        dst = (bf16x8){l_[0], l_[1], l_[2], l_[3], h_[0], h_[1], h_[2], h_[3]}; } while (0)
__device__ __forceinline__ void unpack8(const u32x4 r, float* f) { f[0] = bflo(r.x); f[1] = bfhi(r.x); f[2] = bflo(r.y); f[3] = bfhi(r.y); f[4] = bflo(r.z); f[5] = bfhi(r.z); f[6] = bflo(r.w); f[7] = bfhi(r.w); }

__device__ __forceinline__ float fexp(float x) { return __builtin_amdgcn_exp2f(x * LOG2E); }
__device__ __forceinline__ float fsigmoid(float x) { return __builtin_amdgcn_rcpf(1.f + fexp(-x)); }
__device__ __forceinline__ float rdlane63(float v) { return __builtin_bit_cast(float, __builtin_amdgcn_readlane(__builtin_bit_cast(int, v), 63)); }
struct M1Pre { u32x4 raw[5]; u32x4 vr[2]; pg8::f32x4 cw[8]; pg8::f32x4 cb[2]; float lf, ig; };
__device__ __forceinline__ void m1_load(const Args& a, int g, M1Pre& P) {
    const int tid = threadIdx.x; const int bh = g >> 6, c = g & 63, b = bh >> 3, h = bh & 7; const int s0 = c * 64, tok0 = b * SEQ + s0;
    const int cgp = tid & 15, trow = tid >> 4, tA = 2 * trow; const int ch = (cgp >= 8 ? 512 : 0) + h * 64 + (cgp & 7) * 8;
    const bf16* MQK = (const bf16*)(a.ws + WS_SEC + SEC_MQK * SEC_BYTES);
#pragma unroll
    for (int j = 0; j < 5; ++j) { const int s = s0 + tA - 3 + j; P.raw[j] = *(const u32x4*)(MQK + (size_t)(tok0 + tA - 3 + j + (s < 0 ? 3 : 0)) * 1024 + ch); }
    const bf16* MV = (const bf16*)(a.ws + WS_SEC + SEC_MV * SEC_BYTES);
#pragma unroll
    for (int i = 0; i < 2; ++i) { const int ci = tid + 512 * i, s = ci >> 4, vc = (ci & 15) * 8; P.vr[i] = *(const u32x4*)(MV + (size_t)(tok0 + s) * 1024 + h * 128 + vc); }
    const float* cw = a.in[IN_CONVW] + ch; const float* cb = a.in[IN_CONVB] + ch;
#pragma unroll
    for (int j = 0; j < 4; ++j) { P.cw[2 * j] = *(const pg8::f32x4*)(cw + j * 1024); P.cw[2 * j + 1] = *(const pg8::f32x4*)(cw + j * 1024 + 4); }
    P.cb[0] = *(const pg8::f32x4*)cb; P.cb[1] = *(const pg8::f32x4*)(cb + 4);
    if (tid < 64) { const float* G = (const float*)(a.ws + WS_GATE); P.lf = G[(size_t)(tok0 + tid) * 32 + 16 + h]; P.ig = G[(size_t)(tok0 + tid) * 32 + 8 + h]; }
}
__device__ __forceinline__ void m1_phase(const Args& a, lptr lds, int nblk, int blk) {
    const int tid = threadIdx.x, lane = tid & 63, wid = __builtin_amdgcn_readfirstlane(tid >> 6), r32 = lane & 31, hi = lane >> 5;
    constexpr int NITEM = BATCH * NH * NCHUNK;
    LAS float* wgt = (LAS float*)(lds + 49152); LAS float* npart = (LAS float*)(lds + 49408);
    int g = blk; if (g >= NITEM) return;
    M1Pre P; m1_load(a, g, P);
    const int cgp = tid & 15, trow = tid >> 4, tA = 2 * trow; const bool isk = cgp >= 8; const int d0 = (cgp & 7) * 8;
    int par = 0;
    for (;;) {
        const int bh = g >> 6, c = g & 63, b = bh >> 3, h = bh & 7; const int s0 = c * 64; (void)b; (void)h;
        const int KOFF = 16384 + par * 16384;
        if (wid == 0) {
            const float bc = wave_scan_add(P.lf);
            const float bl = rdlane63(bc), w = bl - bc + P.ig, amax = rdlane63(wave_scan_max(w));
            wgt[lane] = fexp(w - amax);
            float* MST = (float*)(a.ws + WS_MST);
            if (lane == 0) { MST[(size_t)g * 4 + 0] = amax; MST[(size_t)g * 4 + 1] = bl; }
            const float u = P.ig - bc; const float gm = wave_scan_max(u);
            float* GV = (float*)(a.ws + WS_GV) + (size_t)g * 192; GV[lane] = bc; GV[64 + lane] = gm; GV[128 + lane] = u;
        }
        float yA[8], yB[8];
        {
            float u[5][8];
#pragma unroll
            for (int j = 0; j < 5; ++j) { unpack8(P.raw[j], u[j]); if (s0 + tA - 3 + j < 0) {
#pragma unroll
                for (int e = 0; e < 8; ++e) u[j][e] = 0.f; } }
            const float osc = isk ? 0.125f : 1.f;
#pragma unroll
            for (int e = 0; e < 8; ++e) { const float w0 = P.cw[e >> 2][e & 3], w1 = P.cw[2 + (e >> 2)][e & 3], w2 = P.cw[4 + (e >> 2)][e & 3], w3 = P.cw[6 + (e >> 2)][e & 3], bb = P.cb[e >> 2][e & 3];
                float sA = u[0][e] * w0; sA += u[1][e] * w1; sA += u[2][e] * w2; sA += u[3][e] * w3; sA += bb;
                float sB = u[1][e] * w0; sB += u[2][e] * w1; sB += u[3][e] * w2; sB += u[4][e] * w3; sB += bb;
                yA[e] = sA * fsigmoid(sA) * osc; yB[e] = sB * fsigmoid(sB) * osc; }
            u32x4 oA, oB; oA.x = pk2(yA[0], yA[1]); oA.y = pk2(yA[2], yA[3]); oA.z = pk2(yA[4], yA[5]); oA.w = pk2(yA[6], yA[7]);
            oB.x = pk2(yB[0], yB[1]); oB.y = pk2(yB[2], yB[3]); oB.z = pk2(yB[4], yB[5]); oB.w = pk2(yB[6], yB[7]);
            bf16* dst = (bf16*)(a.ws + (isk ? WS_KC : WS_QC)) + ((size_t)bh * SEQ + s0 + tA) * 64 + d0;
            *(u32x4*)dst = oA; *(u32x4*)(dst + 64) = oB;
            if (isk) { *(LAS u32x4*)(lds + KOFF + t_st(tA, d0)) = oA; *(LAS u32x4*)(lds + KOFF + t_st(tA + 1, d0)) = oB;
                float fa[8], fb[8]; unpack8(oA, fa); unpack8(oB, fb);
#pragma unroll
                for (int e = 0; e < 8; ++e) { yA[e] = fa[e]; yB[e] = fb[e]; } }
        }
        const u32x4 vr0 = P.vr[0], vr1 = P.vr[1];
        const int gnext = g + nblk; const bool more = gnext < NITEM;
        m1_load(a, more ? gnext : g, P);
        __syncthreads();
        {   const float wA = wgt[tA], wB = wgt[tA + 1];
#pragma unroll
            for (int e = 0; e < 8; ++e) { float p = isk ? (wA * yA[e] + wB * yB[e]) : 0.f; p += __shfl_xor(p, 16); p += __shfl_xor(p, 32); if (lane >= 8 && lane < 16) npart[wid * 64 + d0 + e] = p; }
#pragma unroll
            for (int i = 0; i < 2; ++i) { const int ci = tid + 512 * i, s = ci >> 4, vc = (ci & 15) * 8; const float ws_ = wgt[s]; float f[8]; unpack8(i ? vr1 : vr0, f);
                u32x4 o; o.x = pk2(f[0] * ws_, f[1] * ws_); o.y = pk2(f[2] * ws_, f[3] * ws_); o.z = pk2(f[4] * ws_, f[5] * ws_); o.w = pk2(f[6] * ws_, f[7] * ws_);
                *(LAS u32x4*)(lds + t_st(s, vc)) = o; } }
        __syncthreads();
        {
            const int vb = wid & 3, db = wid >> 2;
            const int va = (int)(uintptr_t)lds + t_rd_base(lane) + vb * 512, ka = (int)(uintptr_t)lds + KOFF + t_rd_base(lane) + db * 512;
            f32x16 acc = {};
            bf16x8 A, Bf;
            TRFRAG(A, va, 0); TRFRAG(Bf, ka, 0); acc = __builtin_amdgcn_mfma_f32_32x32x16_bf16(A, Bf, acc, 0, 0, 0);
            TRFRAG(A, va, 1); TRFRAG(Bf, ka, 1); acc = __builtin_amdgcn_mfma_f32_32x32x16_bf16(A, Bf, acc, 0, 0, 0);
            TRFRAG(A, va, 2); TRFRAG(Bf, ka, 2); acc = __builtin_amdgcn_mfma_f32_32x32x16_bf16(A, Bf, acc, 0, 0, 0);
            TRFRAG(A, va, 3); TRFRAG(Bf, ka, 3); acc = __builtin_amdgcn_mfma_f32_32x32x16_bf16(A, Bf, acc, 0, 0, 0);
            bf16* KL = (bf16*)(a.ws + WS_KLOC) + (size_t)g * 8192;
#pragma unroll
            for (int r = 0; r < 16; ++r) { const float nb = __shfl_xor(acc[r], 1); if ((r32 & 1) == 0) *(unsigned*)(KL + (vb * 32 + crow(r, hi)) * 64 + db * 32 + r32) = pk2(acc[r], nb); }
        }
        if (tid < 64) { float n = 0.f;
#pragma unroll
            for (int w = 0; w < 8; ++w) n += npart[w * 64 + tid];
            ((float*)(a.ws + WS_NLOC))[(size_t)g * 64 + tid] = n; }
        if (!more) break;
        g = gnext; par ^= 1;
    }
    __syncthreads();
}

__device__ __forceinline__ float rdlane(float v, int l) { return __builtin_bit_cast(float, __builtin_amdgcn_readlane(__builtin_bit_cast(int, v), l)); }
template <bool NST> __device__ __forceinline__ void m2_item_t(const Args& a, int vb) {
    const int tid = threadIdx.x, lane = tid & 63;
    const int bh = vb >> 3, e0 = ((vb & 7) * 512 + tid) * 2;
    const unsigned* KL = (const unsigned*)((const bf16*)(a.ws + WS_KLOC) + (size_t)bh * 64 * 8192 + e0); unsigned* CP = (unsigned*)((bf16*)(a.ws + WS_CPREV) + (size_t)bh * 64 * 8192 + e0);
    float* MST = (float*)(a.ws + WS_MST) + (size_t)bh * 64 * 4;
    const float2 ab = *(const float2*)(MST + lane * 4);
    unsigned kl[64]; float nl[NST ? 64 : 1];
#pragma unroll
    for (int j = 0; j < 64; ++j) kl[j] = KL[(size_t)j * 4096];
    if (NST) { const float* NL = (const float*)(a.ws + WS_NLOC) + (size_t)bh * 64 * 64 + lane;
#pragma unroll
        for (int j = 0; j < 64; ++j) nl[j] = NL[j * 64]; }
    float B = ab.y, A = ab.x;
#pragma unroll
    for (int o = 1; o < 64; o <<= 1) { const float Bp = __shfl_up(B, o), Ap = __shfl_up(A, o); if (lane >= o) { A = fmaxf(Ap + B, A); B = Bp + B; } }
    const float mc = fmaxf(B, A);
    float mp = __shfl_up(mc, 1); if (lane == 0) mp = 0.f;
    const float fCv = __builtin_amdgcn_exp2f((ab.y + mp - mc) * LOG2E), fKv = __builtin_amdgcn_exp2f((ab.x - mc) * LOG2E);
    if (NST) MST[lane * 4 + 2] = mp;
    float* NP = (float*)(a.ws + WS_NPREV) + (size_t)bh * 64 * 64 + lane;
    float c0 = 0.f, c1 = 0.f, n0 = 0.f;
#pragma unroll
    for (int j = 0; j < 64; ++j) {
        const float fC = rdlane(fCv, j), fK = rdlane(fKv, j);
        CP[(size_t)j * 4096] = pk2(c0, c1);
        c0 = fC * c0 + fK * bflo(kl[j]); c1 = fC * c1 + fK * bfhi(kl[j]);
        if (NST) { NP[j * 64] = n0; n0 = fC * n0 + fK * nl[j]; }
    }
}
__device__ __forceinline__ void m2_item(const Args& a, int vb) {
    if ((vb & 7) == 0 && __builtin_amdgcn_readfirstlane(threadIdx.x >> 6) == 0) m2_item_t<true>(a, vb); else m2_item_t<false>(a, vb);
}
#ifndef M2_MASK
#define M2_MASK 7
#endif
constexpr int M2_CTR_DONE = 2176;
__device__ __forceinline__ void m2_worker(const Args& a, int nblk, int blk) {
    unsigned n = 0;
    if (nblk == 256) {
        if (((blk >> 3) & M2_MASK) != 0) return;
        constexpr int NWK = 256 / (M2_MASK + 1);
        const int w = ((blk >> 3) / (M2_MASK + 1)) * 8 + (blk & 7);
        for (int vb = w; vb < 256; vb += NWK) { m2_item(a, vb); ++n; }
    } else for (int vb = blk; vb < 256; vb += nblk) { m2_item(a, vb); ++n; }
    asm volatile("s_waitcnt vmcnt(0)" ::: "memory");
    __syncthreads();
    if (threadIdx.x == 0 && n) {
        __builtin_amdgcn_fence(__ATOMIC_RELEASE, "agent");
        asm volatile("s_waitcnt vmcnt(0)" ::: "memory");
        (void)__hip_atomic_fetch_add((unsigned*)(a.ws + WS_CTL) + M2_CTR_DONE, n, __ATOMIC_RELAXED, __HIP_MEMORY_SCOPE_AGENT);
    }
}
__device__ __forceinline__ void m2_wait_all(const Args& a) {
    unsigned* done = (unsigned*)(a.ws + WS_CTL) + M2_CTR_DONE; unsigned sp = 0;
    while (__hip_atomic_load(done, __ATOMIC_RELAXED, __HIP_MEMORY_SCOPE_AGENT) < 256u) { __builtin_amdgcn_s_sleep(2); if (++sp > (1u << 22)) break; }
#ifndef M2_NOACQ
    __builtin_amdgcn_fence(__ATOMIC_ACQUIRE, "agent");
    asm volatile("s_waitcnt vmcnt(0)" ::: "memory");
#endif
}

struct M3Pre { u32x4 qv, kv, vr[2], cp[2]; float gmrow, mprev, bc, gm, u, np; };
__device__ __forceinline__ void m3_load_front(const Args& a, int g, M3Pre& P) {
    const int tid = threadIdx.x; const int bh = g >> 6, c = g & 63, b = bh >> 3, h = bh & 7; const int s0 = c * 64, tok0 = b * SEQ + s0;
    const int prow = tid >> 3, pc = (tid & 7) * 8;
    P.qv = *(const u32x4*)((const bf16*)(a.ws + WS_QC) + ((size_t)bh * SEQ + s0 + prow) * 64 + pc);
    P.kv = *(const u32x4*)((const bf16*)(a.ws + WS_KC) + ((size_t)bh * SEQ + s0 + prow) * 64 + pc);
    const bf16* MV = (const bf16*)(a.ws + WS_SEC + SEC_MV * SEC_BYTES); const bf16* CP = (const bf16*)(a.ws + WS_CPREV) + (size_t)g * 8192;
#pragma unroll
    for (int i = 0; i < 2; ++i) { const int ci = tid + 512 * i, s = ci >> 4, vc = (ci & 15) * 8; P.vr[i] = *(const u32x4*)(MV + (size_t)(tok0 + s) * 1024 + h * 128 + vc);
        P.cp[i] = *(const u32x4*)(CP + (size_t)ci * 8); }
    const float* GV = (const float*)(a.ws + WS_GV) + (size_t)g * 192;
    P.gmrow = GV[64 + prow]; P.mprev = ((const float*)(a.ws + WS_MST))[(size_t)g * 4 + 2];
    if (tid < 64) { P.bc = GV[tid]; P.gm = GV[64 + tid]; P.u = GV[128 + tid]; P.np = ((const float*)(a.ws + WS_NPREV))[(size_t)g * 64 + tid]; }
}
__device__ __forceinline__ void m3_phase(const Args& a, lptr lds, int nblk, int blk) {
    const int tid = threadIdx.x, lane = tid & 63, wid = __builtin_amdgcn_readfirstlane(tid >> 6), r32 = lane & 31, hi = lane >> 5;
    constexpr int QIMG = 16384, KIMG = 25600, SIMG = 34816, QPIMG = 44032, CPIMG = 53248, FARR = 71680, GNOFF = 74240, HIMG = 78336, HP = 132;
    LAS float* fu = (LAS float*)(lds + FARR); LAS float* fMt = fu + 64; LAS float* fwi = fu + 128; LAS float* fmt = fu + 192; LAS float* fnp = fu + 256; LAS float* fqn = fu + 320; LAS float* fdsp = fu + 384;
    LAS float* gn = (LAS float*)(lds + GNOFF); LAS float* himg = (LAS float*)(lds + HIMG); LAS float* fhd = (LAS float*)(lds + 112128 + 64);
    constexpr int NITEM = BATCH * NH * NCHUNK;
    unsigned* ctr = (unsigned*)(a.ws + WS_CTL) + 2048; LAS int* qslot = (LAS int*)(lds + 112128);
    if (tid == 0) { qslot[0] = (int)atomicAdd(ctr, 1u); qslot[1] = (int)atomicAdd(ctr, 1u); m2_wait_all(a); }
    for (int i = tid; i < 1024; i += NTHREADS) gn[i] = a.in[IN_MNW][i];
    __syncthreads();
    int g = __builtin_amdgcn_readfirstlane(qslot[0]), gnext = __builtin_amdgcn_readfirstlane(qslot[1]);
    __syncthreads();
    if (g >= NITEM) return;
    M3Pre P; m3_load_front(a, g, P);
    const int prow = tid >> 3, pc = (tid & 7) * 8, seg = tid & 7; int qpar = 0;
    for (;;) {
        const int bh = g >> 6, c = g & 63, b = bh >> 3, h = bh & 7; const int tok0 = b * SEQ + c * 64;
        if (tid == 0) qslot[qpar] = (int)atomicAdd(ctr, 1u);
        { const float Mtr = fmaxf(P.mprev, P.gmrow), wi = fexp(P.mprev - Mtr);
#pragma unroll
          for (int i = 0; i < 2; ++i) { const int ci = tid + 512 * i, s = ci >> 4, vc = (ci & 15) * 8; *(LAS u32x4*)(lds + t_st(s, vc)) = P.vr[i];
              const int v = ci >> 3, dc = (ci & 7) * 8; *(LAS u32x4*)(lds + CPIMG + v * ROWP + dc * 2) = P.cp[i]; }
          *(LAS u32x4*)(lds + QIMG + prow * ROWP + pc * 2) = P.qv; *(LAS u32x4*)(lds + KIMG + prow * ROWP + pc * 2) = P.kv;
          float f[8]; unpack8(P.qv, f); u32x4 o; o.x = pk2(f[0] * wi, f[1] * wi); o.y = pk2(f[2] * wi, f[3] * wi); o.z = pk2(f[4] * wi, f[5] * wi); o.w = pk2(f[6] * wi, f[7] * wi);
          *(LAS u32x4*)(lds + QPIMG + prow * ROWP + pc * 2) = o;
          if (tid < 64) { const float Mt = fmaxf(P.mprev, P.gm); fu[tid] = P.u; fMt[tid] = Mt; fwi[tid] = fexp(P.mprev - Mt); fmt[tid] = P.bc + Mt; fnp[tid] = P.np; } }
        const bf16* MO = (const bf16*)(a.ws + WS_SEC + SEC_MO * SEC_BYTES) + (size_t)(tok0 + prow) * 1024 + h * 128 + seg * 16;
        const bf16* MZ = (const bf16*)(a.ws + WS_SEC + SEC_MZ * SEC_BYTES) + (size_t)(tok0 + prow) * 1024 + h * 128 + seg * 16;
        const u32x4 mo0 = *(const u32x4*)MO, mo1 = *(const u32x4*)(MO + 8), mz0 = *(const u32x4*)MZ, mz1 = *(const u32x4*)(MZ + 8);
        const bool more = gnext < NITEM;
        M3Pre Pn; m3_load_front(a, more ? gnext : g, Pn);
        __syncthreads();
        if (wid < 4) {
            const int sb = wid & 1, tb = wid >> 1;
            f32x16 acc = {};
            if (sb <= tb) {
#pragma unroll
                for (int k0 = 0; k0 < 4; ++k0) { const bf16x8 Kf = *(const LAS bf16x8*)(lds + KIMG + (sb * 32 + r32) * ROWP + (k0 * 16 + hi * 8) * 2);
                    const bf16x8 Qf = *(const LAS bf16x8*)(lds + QIMG + (tb * 32 + r32) * ROWP + (k0 * 16 + hi * 8) * 2);
                    acc = __builtin_amdgcn_mfma_f32_32x32x16_bf16(Kf, Qf, acc, 0, 0, 0); }
            }
            const int t = tb * 32 + r32; const float Mt = fMt[t]; float rsum = 0.f;
#pragma unroll
            for (int gq = 0; gq < 4; ++gq) { float v[4];
#pragma unroll
                for (int e = 0; e < 4; ++e) { const int s = sb * 32 + 8 * gq + 4 * hi + e; const float d = fexp(fu[s] - Mt); v[e] = (s <= t) ? acc[4 * gq + e] * d : 0.f; rsum += v[e]; }
                v2u o; o.x = pk2(v[0], v[1]); o.y = pk2(v[2], v[3]);
                *(LAS v2u*)(lds + SIMG + t * ROWP + (sb * 32 + 8 * gq + 4 * hi) * 2) = o; }
            fdsp[t * 4 + sb * 2 + hi] = rsum;
        } else {
            const int tq = tid - 256, row = tq >> 2, part = tq & 3;
            const u32x4 q0 = *(const LAS u32x4*)(lds + QIMG + row * ROWP + part * 32), q1 = *(const LAS u32x4*)(lds + QIMG + row * ROWP + part * 32 + 16);
            float f[16]; unpack8(q0, f); unpack8(q1, f + 8); float s = 0.f;
#pragma unroll
            for (int e = 0; e < 16; ++e) s += f[e] * fnp[part * 16 + e];
            s += __shfl_xor(s, 1); s += __shfl_xor(s, 2);
            if (part == 0) fqn[row] = s;
        }
        __syncthreads();
        if (tid < 64) {
            const int t = tid; const float den = ((fdsp[t * 4 + 0] + fdsp[t * 4 + 1]) + (fdsp[t * 4 + 2] + fdsp[t * 4 + 3])) + fwi[t] * fqn[t];
            fhd[t] = __builtin_amdgcn_rcpf(fmaxf(fabsf(den), fexp(-fmt[t]))); }
        {
            const int tb = wid >> 2, vb = wid & 3;
            f32x16 acc = {};
            const int va = (int)(uintptr_t)lds + t_rd_base(lane) + vb * 512;
            bf16x8 Af, Bf;
#define M3_STEP(ks) do { Af = *(const LAS bf16x8*)(lds + SIMG + (tb * 32 + r32) * ROWP + ((ks) * 16 + hi * 8) * 2); TRFRAG(Bf, va, ks); acc = __builtin_amdgcn_mfma_f32_32x32x16_bf16(Af, Bf, acc, 0, 0, 0); } while (0)
            M3_STEP(0); M3_STEP(1); M3_STEP(2); M3_STEP(3);
#undef M3_STEP
#pragma unroll
            for (int k0 = 0; k0 < 4; ++k0) { const bf16x8 Aq = *(const LAS bf16x8*)(lds + QPIMG + (tb * 32 + r32) * ROWP + (k0 * 16 + hi * 8) * 2);
                const bf16x8 Cf = *(const LAS bf16x8*)(lds + CPIMG + (vb * 32 + r32) * ROWP + (k0 * 16 + hi * 8) * 2);
                acc = __builtin_amdgcn_mfma_f32_32x32x16_bf16(Aq, Cf, acc, 0, 0, 0); }
#pragma unroll
            for (int r = 0; r < 16; ++r) himg[(tb * 32 + crow(r, hi)) * HP + vb * 32 + r32] = acc[r];
        }
        __syncthreads();
        {
            float hv[16], of[16], zf[16];
#pragma unroll
            for (int j = 0; j < 4; ++j) { const pg8::f32x4 x = *(const LAS pg8::f32x4*)(himg + prow * HP + seg * 16 + 4 * j); hv[4 * j] = x[0]; hv[4 * j + 1] = x[1]; hv[4 * j + 2] = x[2]; hv[4 * j + 3] = x[3]; }
            unpack8(mo0, of); unpack8(mo1, of + 8); unpack8(mz0, zf); unpack8(mz1, zf + 8);
            float ss = 0.f; const float hdr = fhd[prow];
#pragma unroll
            for (int e = 0; e < 16; ++e) { hv[e] *= hdr * fsigmoid(of[e]); ss += hv[e] * hv[e]; }
            ss += __shfl_xor(ss, 1); ss += __shfl_xor(ss, 2); ss += __shfl_xor(ss, 4);
            const float rs = 1.0f / sqrtf(ss * (1.f / 128.f) + NORM_EPS);
            float y[16];
#pragma unroll
            for (int e = 0; e < 16; ++e) y[e] = hv[e] * rs * gn[h * 128 + seg * 16 + e] * (zf[e] * fsigmoid(zf[e]));
            u32x4 o0, o1; o0.x = pk2(y[0], y[1]); o0.y = pk2(y[2], y[3]); o0.z = pk2(y[4], y[5]); o0.w = pk2(y[6], y[7]);
            o1.x = pk2(y[8], y[9]); o1.y = pk2(y[10], y[11]); o1.z = pk2(y[12], y[13]); o1.w = pk2(y[14], y[15]);
            bf16* Y = (bf16*)(a.ws + WS_Y) + (size_t)(tok0 + prow) * 2048 + 1024 + h * 128 + seg * 16;
            *(u32x4*)Y = o0; *(u32x4*)(Y + 8) = o1;
        }
        if (!more) break;
        g = gnext; P = Pn; gnext = __builtin_amdgcn_readfirstlane(qslot[qpar]); qpar ^= 1;
    }
    __syncthreads();
}
#undef TRFRAG
}

#define XB_TMO      128
#define XB_XCNT(j)  (256  + 64 * (j))
#define XB_XSUB(j)  (1280 + 64 * (j))
#define XB_XGEN(j)  (2304 + 64 * (j))
#define XB_TOP      3328
#define XB_TOPGEN   3392
#define XCD_BAR_WORDS 3456
#define XB_SPIN_CAP (1u << 18)

__device__ __forceinline__ unsigned xb_ld(unsigned* p)              { return __hip_atomic_load(p, __ATOMIC_RELAXED, __HIP_MEMORY_SCOPE_AGENT); }
__device__ __forceinline__ unsigned xb_add(unsigned* p, unsigned v) { return __hip_atomic_fetch_add(p, v, __ATOMIC_RELAXED, __HIP_MEMORY_SCOPE_AGENT); }
__device__ __forceinline__ unsigned xb_xcc_id() { return (unsigned)__builtin_amdgcn_s_getreg((3 << 11) | 20) & 0xFu; }
#define XB_SPIN(cond, bar) do { unsigned _sp = 0; while (cond) { __builtin_amdgcn_s_sleep(1); \
    if ((++_sp & 255u) == 0u) { if (xb_ld(&(bar)[XB_TMO])) break; if (_sp > XB_SPIN_CAP) { atomicAdd(&(bar)[XB_TMO], 1u); break; } } } } while (0)

struct XcdBarrier {
    unsigned* bar; unsigned x;
    volatile LAS unsigned* st;
};

__device__ __forceinline__ XcdBarrier xcd_barrier_post(unsigned* bar, volatile LAS unsigned* st) {
    XcdBarrier b; b.bar = bar; b.x = xb_xcc_id(); b.st = st;
    if (threadIdx.x == 0) (void)xb_add(&bar[XB_XCNT(b.x)], 1u);
    return b;
}
__device__ __forceinline__ void xcd_barrier_complete(unsigned* bar, unsigned x, unsigned& nloc, unsigned& nx) {
    const unsigned G = gridDim.x * gridDim.y * gridDim.z;
    unsigned sum, cnt, mine, sp = 0u;
    for (;;) {
        sum = 0u; cnt = 0u; mine = 0u;
#pragma unroll
        for (unsigned j = 0; j < 16; ++j) { const unsigned c = xb_ld(&bar[XB_XCNT(j)]); sum += c; cnt += (c > 0u) ? 1u : 0u; mine = (j == x) ? c : mine; }
        if (sum == G) break;
        __builtin_amdgcn_s_sleep(1);
        if ((++sp & 255u) == 0u) { if (xb_ld(&bar[XB_TMO])) break; if (sp > XB_SPIN_CAP) { atomicAdd(&bar[XB_TMO], 1u); break; } }
    }
    nloc = mine > 0u ? mine : 1u; nx = cnt > 0u ? cnt : 1u;
}

__device__ __forceinline__ void xcd_barrier(const XcdBarrier& b) {
    asm volatile("s_waitcnt vmcnt(0)" ::: "memory");
    __syncthreads();
    if (threadIdx.x == 0) {
        unsigned* bar = b.bar;
        __builtin_amdgcn_s_waitcnt(0);
        unsigned nloc = b.st[0], nx = b.st[1];
        if (nloc == 0u) { xcd_barrier_complete(bar, b.x, nloc, nx); b.st[0] = nloc; b.st[1] = nx; }
        const unsigned old = xb_add(&bar[XB_XSUB(b.x)], 1u);
        const unsigned gen = old / nloc;
        if (old + 1u == (gen + 1u) * nloc) {
            __builtin_amdgcn_fence(__ATOMIC_RELEASE, "agent");
            asm volatile("s_waitcnt vmcnt(0)" ::: "memory");
            const unsigned og = xb_add(&bar[XB_TOP], 1u);
            const unsigned tg = og / nx;
            if (og + 1u == (tg + 1u) * nx) xb_add(&bar[XB_TOPGEN], 1u);
            else XB_SPIN(xb_ld(&bar[XB_TOPGEN]) == tg, bar);
            __builtin_amdgcn_fence(__ATOMIC_ACQUIRE, "agent");
            xb_add(&bar[XB_XGEN(b.x)], 1u);
            asm volatile("s_waitcnt vmcnt(0)" ::: "memory");
        } else {
            XB_SPIN(xb_ld(&bar[XB_XGEN(b.x)]) == gen, bar);
            __builtin_amdgcn_fence(__ATOMIC_ACQUIRE, "agent");
            asm volatile("s_waitcnt vmcnt(0)" ::: "memory");
        }
    }
    __syncthreads();
}

constexpr int N_PHASES = 7;
__global__ void __launch_bounds__(NTHREADS, 2) mega_fwd(Args a) {
    extern __shared__ __attribute__((aligned(16))) unsigned char lds_raw[];
    LAS unsigned char* lds = (LAS unsigned char*)lds_raw;
    const int blk = blockIdx.x, nblk = gridDim.x;
    const int lo = a.ph_lo, hi = a.ph_hi;
    volatile LAS unsigned* MISC = (volatile LAS unsigned*)(lds + LDS_BYTES - 64);
    if (threadIdx.x < 16) MISC[threadIdx.x] = 0u;
    __syncthreads();
    XcdBarrier bar = xcd_barrier_post((unsigned*)(a.ws + WS_CTL) + 4096, MISC + 8);
#ifndef PROBE_REPEAT
#define PROBE_REPEAT -1
#endif
#ifndef PROBE_FLAGS
#define PROBE_FLAGS 0
#endif
#define REP(k)
#define IN(k) (lo <= (k) && (k) < hi)
#define SEAM(k) do { if (IN(k) && IN((k) + 1)) xcd_barrier(bar); } while (0)
    if (IN(0)) { REP(0) phase_prep(a, lds, nblk, blk); }
    SEAM(0);
    if (IN(1)) REP(1) {
        for (int c = blk; c < M_TOK / 64; c += nblk) gate_unit(a, lds, c);
        pg8::Gemm g{(const pg8::bf16_t*)(a.ws + WS_XN), (const pg8::bf16_t*)(a.ws + WS_WIN), M_TOK, NMAIN, DM};
        pg8::EpiProj E{a.ws + WS_SEC, QSCALE};
        if (nblk == 256) { pg8::XcdColOrder S; S.init(M_TOK, NMAIN, nblk, blk); pg8::gemm_phase<pg8::EpiProj, pg8::XcdColOrder, true, true>(lds, g, S, E); }
        else { pg8::StaticOrder S; S.init(M_TOK, NMAIN, nblk, blk); pg8::gemm_phase<pg8::EpiProj, pg8::StaticOrder, true, true>(lds, g, S, E); }
    }
    SEAM(1);
    if (IN(2)) {
        for (int it = blk; it < BATCH * NH * 8; it += nblk) fox_cumsum_item(a, lds, it);
        fox::knorm_pass(a, nblk, blk);
        ml::m1_phase(a, (ml::lptr)lds, nblk, blk);
    }
    SEAM(2);
    if (IN(4)) {
        ml::m2_worker(a, nblk, blk);
        REP(4) fox::phase(a, (fox::lptr)lds, nblk, blk);
        REP(41) ml::m3_phase(a, (ml::lptr)lds, nblk, blk);
    }
    SEAM(4);
    if (IN(5)) REP(5) {
        pg8::Gemm g{(const pg8::bf16_t*)(a.ws + WS_Y), (const pg8::bf16_t*)(a.ws + WS_WOUT), M_TOK, DM, DM};
        pg8::StaticOrder S; S.init(M_TOK, DM, nblk, blk);
        pg8::EpiOut E{(pg8::bf16_t*)(a.ws + WS_DELTA)};
        pg8::gemm_phase<pg8::EpiOut, pg8::StaticOrder, true, true>(lds, g, S, E);
    }
    SEAM(5);
    if (IN(6)) { REP(6) phase_final(a, nblk, blk); }
#undef IN
#undef SEAM
}

#ifndef MK_N_LAUNCHES
#define MK_N_LAUNCHES 1
#endif
extern "C" void kernel_launch(void* const* d_in, const int* in_sizes, int n_in, void* d_out, int out_size, void* d_ws, size_t ws_size, hipStream_t stream) {
    static int grid = 0;
    if (grid == 0) {
        if (n_in != 12 || in_sizes[0] != M_TOK * DM || in_sizes[2] != DM * IN_COLS || out_size != M_TOK * DM || ws_size < WS_END) {
            fprintf(stderr, "kernel_launch: shape mismatch n_in %d in0 %d in2 %d out %d ws %zu\n", n_in, n_in > 0 ? in_sizes[0] : -1, n_in > 2 ? in_sizes[2] : -1, out_size, ws_size); grid = -1; return; }
        int dev = 0, cus = 0, per_cu = 0;
        if (hipGetDevice(&dev) != hipSuccess || hipDeviceGetAttribute(&cus, hipDeviceAttributeMultiprocessorCount, dev) != hipSuccess) { grid = -1; return; }
        if (hipFuncSetAttribute((const void*)mega_fwd, hipFuncAttributeMaxDynamicSharedMemorySize, LDS_BYTES) != hipSuccess) { fprintf(stderr, "kernel_launch: hipFuncSetAttribute failed\n"); grid = -1; return; }
        if (hipOccupancyMaxActiveBlocksPerMultiprocessor(&per_cu, (const void*)mega_fwd, NTHREADS, LDS_BYTES) != hipSuccess || per_cu < 1) { fprintf(stderr, "kernel_launch: occupancy query says %d blocks per CU\n", per_cu); per_cu = 1; }
        (void)hipGetLastError();
        grid = cus;
    }
    if (grid < 0) return;
    Args a{};
    for (int i = 0; i < 12; ++i) a.in[i] = (const float*)d_in[i];
    a.out = (float*)d_out; a.ws = (unsigned char*)d_ws;
    if (hipMemsetAsync((char*)d_ws + WS_CTL, 0, 65536, stream) != hipSuccess) { fprintf(stderr, "kernel_launch: hipMemsetAsync failed\n"); return; }
    if (MK_N_LAUNCHES == 1) {
        a.ph_lo = 0; a.ph_hi = N_PHASES;
        void* args[] = {&a};
        hipError_t e = hipLaunchCooperativeKernel((const void*)mega_fwd, dim3(grid), dim3(NTHREADS), args, LDS_BYTES, stream);
        if (e != hipSuccess) fprintf(stderr, "kernel_launch: cooperative launch failed: %s (grid %d)\n", hipGetErrorString(e), grid);
    } else {
        for (int p = 0; p < N_PHASES; ++p) { a.ph_lo = p; a.ph_hi = p + 1; for (int r = 0; r < (p == PROBE_REPEAT ? 2 : 1); ++r) { a.flags = r ? PROBE_FLAGS : 0; hipLaunchKernelGGL(mega_fwd, dim3(grid), dim3(NTHREADS), LDS_BYTES, stream, a); } }
        if (PROBE_REPEAT == 56) for (int p = 5; p < 7; ++p) { a.ph_lo = p; a.ph_hi = p + 1; hipLaunchKernelGGL(mega_fwd, dim3(grid), dim3(NTHREADS), LDS_BYTES, stream, a); }
    }
}
```

```cpp
#include <hip/hip_runtime.h>
#include <hip/hip_cooperative_groups.h>
#include <cstdio>
#include <cstdint>
namespace cg = cooperative_groups;

constexpr int BATCH = 4, SEQ = 4096, DM = 2048, M_TOK = BATCH * SEQ;
constexpr int NH = 8, HD = 128, DK = 64, CHUNK = 64, NCHUNK = SEQ / CHUNK;
constexpr int IN_COLS = 8216, NMAIN = 8192, NGATE = 32;
constexpr float NORM_EPS = 1e-6f;
constexpr float LOG2E = 1.4426950408889634f;
constexpr float QSCALE = 0.08838834764831845f * 1.4426950408889634f;

constexpr size_t MiB = 1u << 20;
constexpr size_t WS_CTL = 0;
constexpr size_t WS_KNRM = 1 * MiB, WS_KSUF = 1 * MiB + 8192, WS_KBND = 1 * MiB + 16384;
constexpr size_t WS_GATE = 2 * MiB;
constexpr size_t WS_ROWSS = 4 * MiB;
constexpr size_t WS_WGT = 6 * MiB;
constexpr size_t WS_KBIAS = 7 * MiB;
constexpr size_t WS_MST = 9 * MiB;
constexpr size_t WS_NLOC = 10 * MiB;
constexpr size_t WS_NPREV = 11 * MiB;
constexpr size_t WS_GV = 12 * MiB;
constexpr size_t WS_WOUT = 16 * MiB;
constexpr size_t WS_WIN = 32 * MiB;
constexpr size_t WS_QC = 32 * MiB;
constexpr size_t WS_KC = 48 * MiB;
constexpr size_t WS_XN = 64 * MiB;
constexpr size_t WS_Y = 64 * MiB;
constexpr size_t WS_SEC = 128 * MiB;
constexpr size_t SEC_BYTES = 32 * MiB;
constexpr size_t WS_KLOC = 384 * MiB;
constexpr size_t WS_DELTA = 384 * MiB;
constexpr size_t WS_CPREV = 448 * MiB;
constexpr size_t WS_END = 480 * MiB;
enum { SEC_FQ = 0, SEC_FK, SEC_FV, SEC_FZ, SEC_MQK, SEC_MV, SEC_MO, SEC_MZ };
__host__ __device__ __forceinline__ constexpr unsigned hm_off(unsigned s, unsigned d) { return (s >> 1) * 256u + (d >> 5) * 64u + (s & 1u) * 32u + (d & 31u); }
__host__ __device__ __forceinline__ constexpr unsigned tm_off(unsigned row, unsigned c) { return (row >> 1) * 2048u + (c >> 5) * 64u + (row & 1u) * 32u + (c & 31u); }
__host__ __device__ __forceinline__ constexpr unsigned dm_off(unsigned row, unsigned c) { return (row >> 1) * 4096u + (c >> 5) * 64u + (row & 1u) * 32u + (c & 31u); }

typedef unsigned short bf16;
typedef unsigned v4u __attribute__((ext_vector_type(4)));
typedef unsigned v2u __attribute__((ext_vector_type(2)));
typedef float f32x16 __attribute__((ext_vector_type(16)));
#define LAS __attribute__((address_space(3)))
#define LDS_WAIT() asm volatile("s_waitcnt lgkmcnt(0)" ::: "memory")

__device__ __forceinline__ unsigned f2bf(float f) { unsigned u = __builtin_bit_cast(unsigned, f); return (u + 0x7fffu + ((u >> 16) & 1u)) >> 16; }
typedef float f32x2_t __attribute__((ext_vector_type(2))); typedef __bf16 bf16x2_t __attribute__((ext_vector_type(2)));
__device__ __forceinline__ unsigned pk2(float lo, float hi) { f32x2_t v = {lo, hi}; bf16x2_t b = __builtin_convertvector(v, bf16x2_t); return __builtin_bit_cast(unsigned, b); }
__device__ __forceinline__ float bf2f(unsigned h) { return __builtin_bit_cast(float, (h & 0xffffu) << 16); }
__device__ __forceinline__ float bflo(unsigned w) { return __builtin_bit_cast(float, w << 16); }
__device__ __forceinline__ float bfhi(unsigned w) { return __builtin_bit_cast(float, w & 0xffff0000u); }
__device__ __forceinline__ float wave_sum(float v) {
#pragma unroll
    for (int o = 1; o < 64; o <<= 1) v += __shfl_xor(v, o);
    return v;
}
__device__ __forceinline__ float wave_max(float v) {
#pragma unroll
    for (int o = 1; o < 64; o <<= 1) v = fmaxf(v, __shfl_xor(v, o));
    return v;
}
#define DPP_F(x, old, ctrl, rm, bm) __builtin_bit_cast(float, __builtin_amdgcn_update_dpp(__builtin_bit_cast(int, (float)(old)), __builtin_bit_cast(int, (float)(x)), ctrl, rm, bm, false))
__device__ __forceinline__ float wave_scan_add(float v) {
    float s = v + DPP_F(v, 0.f, 0x111, 0xf, 0xf); s += DPP_F(v, 0.f, 0x112, 0xf, 0xf); s += DPP_F(v, 0.f, 0x113, 0xf, 0xf);
    s += DPP_F(s, 0.f, 0x114, 0xf, 0xe); s += DPP_F(s, 0.f, 0x118, 0xf, 0xc);
    s += DPP_F(s, 0.f, 0x142, 0xa, 0xf); s += DPP_F(s, 0.f, 0x143, 0xc, 0xf);
    return s;
}
__device__ __forceinline__ float wave_scan_max(float v) {
    const float NI = -__builtin_inff();
    float s = fmaxf(v, DPP_F(v, NI, 0x111, 0xf, 0xf)); s = fmaxf(s, DPP_F(v, NI, 0x112, 0xf, 0xf)); s = fmaxf(s, DPP_F(v, NI, 0x113, 0xf, 0xf));
    s = fmaxf(s, DPP_F(s, NI, 0x114, 0xf, 0xe)); s = fmaxf(s, DPP_F(s, NI, 0x118, 0xf, 0xc));
    s = fmaxf(s, DPP_F(s, NI, 0x142, 0xa, 0xf)); s = fmaxf(s, DPP_F(s, NI, 0x143, 0xc, 0xf));
    return s;
}
__device__ __forceinline__ float logsigmoidf(float x) { return fminf(x, 0.f) - log1pf(expf(-fabsf(x))); }
__device__ __forceinline__ float siluf(float x) { return x / (1.f + expf(-x)); }
__device__ __forceinline__ float sigmoidf_(float x) { return 1.f / (1.f + expf(-x)); }

namespace pg8 {
#define PG8_LAS __attribute__((address_space(3)))
typedef unsigned short bf16_t;
typedef short bf16x8 __attribute__((ext_vector_type(8)));
typedef float f32x4 __attribute__((ext_vector_type(4)));
typedef unsigned u32x4 __attribute__((ext_vector_type(4)));
constexpr int BM = 256, BK = 64, HALF = 128, HTB = HALF * BK * 2  , STAGE_BYTES = 8 * HTB, NXCD = 8, WGM = 8;

__host__ __device__ __forceinline__ int lds_byte(int r, int c) { const int st = (r >> 4) * 2 + (c >> 5), rr = r & 15, cc = c & 31, ob = rr * 64 + cc * 2; return st * 1024 + (ob ^ (((ob >> 9) & 1) << 5)); }
__host__ __device__ __forceinline__ void stage_rc(int b, int& R, int& C) { const int st = b / 1024, sb = b % 1024, swz = sb ^ (((sb >> 9) & 1) << 5); R = (st >> 1) * 16 + swz / 64; C = (st & 1) * 32 + (swz % 64) / 2; }
__host__ __device__ __forceinline__ int perm32(int rho) { const int n = rho >> 4, i = rho & 15; return 8 * (i >> 2) + 4 * n + (i & 3); }

struct Unit { int pm, pn; };
struct Gemm { const bf16_t* A; const bf16_t* Bt; int M, N, K; };

struct StaticOrder {
    int nM, nN, nwg, G, c;
    __host__ __device__ void init(int M, int N, int G_, int c_) { nM = M / BM; nN = N / BM; nwg = nM * nN; G = G_; c = c_; }
    __host__ __device__ bool next(int i, Unit& u) const {
        const long L = (long)i * G + c; if (L >= nwg) return false;
        int wgid = (int)L; { const int q = nwg / NXCD, r = nwg % NXCD, xcd = wgid % NXCD, off = wgid / NXCD; wgid = (xcd < r ? xcd * (q + 1) : r * (q + 1) + (xcd - r) * q) + off; }
        const int nig = WGM * nN, gid = wgid / nig, fm = gid * WGM, gsz = (nM - fm) < WGM ? (nM - fm) : WGM;
        u.pm = fm + ((wgid % nig) % gsz); u.pn = (wgid % nig) / gsz; return true;
    }
    __device__ __forceinline__ void a_ready(const Unit&) const {}
    __device__ __forceinline__ void done(const Unit&) const {}
};

__device__ __forceinline__ unsigned cvt_pk_bf16(float lo, float hi) { return pk2(lo, hi); }

struct XcdColOrder {
    int nM, nN, G, c;
    __host__ __device__ void init(int M, int N, int G_, int c_) { nM = M / BM; nN = N / BM; G = G_; c = c_; }
    __host__ __device__ bool next(int i, Unit& u) const {
        const int x = c & 7, j = c >> 3, per = nN >> 3, rows = (G >> 3) / per;
        u.pn = x * per + j / rows; u.pm = i * rows + j % rows; return u.pm < nM;
    }
    __device__ __forceinline__ void a_ready(const Unit&) const {}
    __device__ __forceinline__ void done(const Unit&) const {}
};

struct EpiProj {
    static constexpr bool PERM = true, AFTER_DRAIN = false;
    unsigned char* secbase; float qscale;
    __device__ __forceinline__ void operator()(const f32x4 (&acc)[2][2][4][2], const Unit& u, int wr, int wc, int fr, int fq) const {
        const int sec = u.pn >> 2, t4 = u.pn & 3;
        const int row0 = u.pm * BM + wr * 64 + fr;
        bf16_t* base = (bf16_t*)(secbase + (size_t)sec * (32u << 20));
        const float sc = sec == 0 ? qscale : 1.f;
#pragma unroll
        for (int ai = 0; ai < 2; ++ai)
#pragma unroll
            for (int m = 0; m < 4; ++m) { const int row = row0 + ai * HALF + m * 16;
#pragma unroll
                for (int bj = 0; bj < 2; ++bj) { f32x4 v0 = acc[ai][bj][m][0] * sc, v1 = acc[ai][bj][m][1] * sc;
                    u32x4 w; w.x = cvt_pk_bf16(v0[0], v0[1]); w.y = cvt_pk_bf16(v0[2], v0[3]); w.z = cvt_pk_bf16(v1[0], v1[1]); w.w = cvt_pk_bf16(v1[2], v1[3]);
                    size_t off;
                    if (sec < 3) off = (size_t)((row >> 12) * 8 + t4 * 2 + bj) * (4096u * 128u) + hm_off((unsigned)(row & 4095), (unsigned)(wc * 32 + 8 * fq));
                    else         off = tm_off((unsigned)row, (unsigned)(t4 * 256 + bj * 128 + wc * 32 + 8 * fq));
                    __builtin_nontemporal_store(w, (u32x4*)(base + off)); } }
    }
};
struct EpiOut {
    static constexpr bool PERM = true, AFTER_DRAIN = false;
    bf16_t* delta;
    __device__ __forceinline__ void operator()(const f32x4 (&acc)[2][2][4][2], const Unit& u, int wr, int wc, int fr, int fq) const {
        const int row0 = u.pm * BM + wr * 64 + fr;
#pragma unroll
        for (int ai = 0; ai < 2; ++ai)
#pragma unroll
            for (int m = 0; m < 4; ++m) { const int row = row0 + ai * HALF + m * 16;
#pragma unroll
                for (int bj = 0; bj < 2; ++bj) { const f32x4 v0 = acc[ai][bj][m][0], v1 = acc[ai][bj][m][1];
                    u32x4 w; w.x = cvt_pk_bf16(v0[0], v0[1]); w.y = cvt_pk_bf16(v0[2], v0[3]); w.z = cvt_pk_bf16(v1[0], v1[1]); w.w = cvt_pk_bf16(v1[2], v1[3]);
                    *(u32x4*)(delta + dm_off((unsigned)row, (unsigned)(u.pn * BM + bj * HALF + wc * 32 + 8 * fq))) = w; } }
    }
};

template <class Epi, class Sched, bool ALIGN_EPI = false, bool SP2 = false>
__device__ __forceinline__ void gemm_phase(PG8_LAS unsigned char* lds, const Gemm g, const Sched& S, const Epi& E) {
    const int tid = threadIdx.x, wid = __builtin_amdgcn_readfirstlane(tid >> 6), lane = tid & 63, wr = wid >> 2, wc = wid & 3, fr = lane & 15, fq = lane >> 4;
    const int K = g.K, nt = K / BK;
    unsigned voffA[2], voffB[2];
#pragma unroll
    for (int i = 0; i < 2; ++i) { int R, C; stage_rc(tid * 16 + i * 8192, R, C); const int Rb = Epi::PERM ? ((R & ~31) + perm32(R & 31)) : R;
        voffA[i] = (unsigned)(R * K + C) * 2u; voffB[i] = (unsigned)(Rb * K + C) * 2u; }
    const size_t kstep = (size_t)(BK * 2);
    const size_t hstep = (size_t)HALF * K * 2;
    const size_t tstep = 2 * hstep;
    const unsigned ldsw = (unsigned)wid * 1024u;
    const int aoff = lds_byte(wr * 64 + fr, fq * 8), boff = lds_byte(wc * 32 + fr, fq * 8);
#define PG8_SA(b, h) (((b) * 2 + (h)) * HTB)
#define PG8_SB(b, h) ((4 + (b) * 2 + (h)) * HTB)
#define PG8_STAGE(bufoff, gbase, voff) do { _Pragma("unroll") for (int _i = 0; _i < 2; ++_i) \
        __builtin_amdgcn_global_load_lds((const unsigned*)((const char*)(gbase) + (voff)[_i]), (PG8_LAS unsigned*)(lds + (bufoff) + ldsw + _i * 8192), 16, 0, 0); } while (0)
#define PG8_LDA(dst, b, h) do { _Pragma("unroll") for (int m = 0; m < 4; ++m) _Pragma("unroll") for (int k = 0; k < 2; ++k) dst[m][k] = *(const PG8_LAS bf16x8*)(lds + PG8_SA(b, h) + aoff + m * 2048 + k * 1024); } while (0)
#define PG8_LDB(dst, b, h) do { _Pragma("unroll") for (int n = 0; n < 2; ++n) _Pragma("unroll") for (int k = 0; k < 2; ++k) dst[n][k] = *(const PG8_LAS bf16x8*)(lds + PG8_SB(b, h) + boff + n * 2048 + k * 1024); } while (0)
#define PG8_MMA(ai, bj, At, Bt) do { __builtin_amdgcn_s_setprio(1); _Pragma("unroll") for (int m = 0; m < 4; ++m) _Pragma("unroll") for (int n = 0; n < 2; ++n) _Pragma("unroll") for (int k = 0; k < 2; ++k) \
        acc[ai][bj][m][n] = __builtin_amdgcn_mfma_f32_16x16x32_bf16(Bt[n][k], At[m][k], acc[ai][bj][m][n], 0, 0, 0); __builtin_amdgcn_s_setprio(0); } while (0)
#define PG8_WAIT_V(n) asm volatile("s_waitcnt vmcnt(" #n ")" ::: "memory")
#define PG8_WAIT_L(n) asm volatile("s_waitcnt lgkmcnt(" #n ")" ::: "memory")
#define PG8_BAR __builtin_amdgcn_s_barrier()
#define PG8_SCHED __builtin_amdgcn_sched_barrier(0)
    Unit cur, nxt; int ui = 0;
    if (!S.next(0, cur)) return;
    f32x4 acc[2][2][4][2];
#pragma unroll
    for (int a = 0; a < 2; ++a)
#pragma unroll
        for (int b = 0; b < 2; ++b)
#pragma unroll
            for (int m = 0; m < 4; ++m)
#pragma unroll
                for (int n = 0; n < 2; ++n) acc[a][b][m][n] = (f32x4){0.f, 0.f, 0.f, 0.f};
    bf16x8 At[4][2], B0[2][2], B1[2][2];
    const char* cA = (const char*)g.A + (size_t)cur.pm * tstep; const char* cB = (const char*)g.Bt + (size_t)cur.pn * tstep;
    S.a_ready(cur);
    if constexpr (SP2) {
        PG8_STAGE(PG8_SB(0, 0), cB, voffB); PG8_STAGE(PG8_SB(0, 1), cB + hstep, voffB); PG8_STAGE(PG8_SA(0, 0), cA, voffA); PG8_STAGE(PG8_SA(0, 1), cA + hstep, voffA);
        if (wr == 1) PG8_BAR;
        PG8_WAIT_V(2); PG8_BAR;
        PG8_STAGE(PG8_SB(1, 0), cB + kstep, voffB); PG8_STAGE(PG8_SA(1, 0), cA + kstep, voffA); PG8_STAGE(PG8_SB(1, 1), cB + hstep + kstep, voffB);
        PG8_WAIT_V(6); PG8_BAR;
    } else {
        PG8_STAGE(PG8_SB(0, 0), cB, voffB); PG8_STAGE(PG8_SA(0, 0), cA, voffA); PG8_STAGE(PG8_SB(0, 1), cB + hstep, voffB); PG8_STAGE(PG8_SA(0, 1), cA + hstep, voffA);
        if (wr == 1) PG8_BAR;
        PG8_WAIT_V(4); PG8_BAR;
        PG8_STAGE(PG8_SB(1, 0), cB + kstep, voffB); PG8_STAGE(PG8_SA(1, 0), cA + kstep, voffA); PG8_STAGE(PG8_SB(1, 1), cB + hstep + kstep, voffB);
        PG8_WAIT_V(6); PG8_BAR;
    }
    for (;;) {
        const bool has_next = S.next(ui + 1, nxt);
        const char* nA = has_next ? (const char*)g.A + (size_t)nxt.pm * tstep : cA; const char* nB = has_next ? (const char*)g.Bt + (size_t)nxt.pn * tstep : cB;
        for (int t = 0; t < nt; t += 2) {
            const bool last = (t == nt - 2);
            const char* a1 = cA + (size_t)(t + 1) * kstep;
            const char* a2 = last ? nA : cA + (size_t)(t + 2) * kstep; const char* b2 = last ? nB : cB + (size_t)(t + 2) * kstep;
            const char* a3 = a2 + kstep; const char* b3 = b2 + kstep;
            if (last && has_next) S.a_ready(nxt);
            if constexpr (SP2) {
            PG8_LDB(B0, 0, 0); PG8_LDB(B1, 0, 1); PG8_SCHED; PG8_LDA(At, 0, 0); PG8_STAGE(PG8_SA(1, 1), a1 + hstep, voffA);
            PG8_WAIT_V(8); PG8_WAIT_L(0); PG8_BAR; PG8_MMA(0, 0, At, B0); PG8_MMA(0, 1, At, B1); PG8_BAR; PG8_SCHED;
            PG8_LDA(At, 0, 1); PG8_STAGE(PG8_SB(0, 0), b2, voffB); PG8_STAGE(PG8_SB(0, 1), b2 + hstep, voffB); PG8_STAGE(PG8_SA(0, 0), a2, voffA);
            PG8_WAIT_V(8); PG8_WAIT_L(0); PG8_BAR; PG8_MMA(1, 0, At, B0); PG8_MMA(1, 1, At, B1); PG8_BAR; PG8_SCHED;
            PG8_LDB(B0, 1, 0); PG8_LDB(B1, 1, 1); PG8_SCHED; PG8_LDA(At, 1, 0); PG8_STAGE(PG8_SA(0, 1), a2 + hstep, voffA);
            PG8_WAIT_V(8); PG8_WAIT_L(0); PG8_BAR; PG8_MMA(0, 0, At, B0); PG8_MMA(0, 1, At, B1); PG8_BAR; PG8_SCHED;
            PG8_LDA(At, 1, 1); PG8_STAGE(PG8_SB(1, 0), b3, voffB); PG8_STAGE(PG8_SB(1, 1), b3 + hstep, voffB); PG8_STAGE(PG8_SA(1, 0), a3, voffA);
            PG8_WAIT_V(8); PG8_WAIT_L(0); PG8_BAR; PG8_MMA(1, 0, At, B0); PG8_MMA(1, 1, At, B1); PG8_BAR; PG8_SCHED;
            } else {
            PG8_LDB(B0, 0, 0); PG8_SCHED; PG8_LDA(At, 0, 0); PG8_STAGE(PG8_SA(1, 1), a1 + hstep, voffA);
            PG8_WAIT_L(8); PG8_BAR; PG8_WAIT_L(0); PG8_MMA(0, 0, At, B0); PG8_BAR; PG8_SCHED;
            PG8_LDB(B1, 0, 1); PG8_STAGE(PG8_SB(0, 0), b2, voffB);
            PG8_BAR; PG8_WAIT_L(0); PG8_MMA(0, 1, At, B1); PG8_BAR;
            PG8_LDA(At, 0, 1); PG8_STAGE(PG8_SA(0, 0), a2, voffA);
            PG8_BAR; PG8_WAIT_L(0); PG8_MMA(1, 0, At, B0); PG8_BAR; PG8_SCHED;
            PG8_STAGE(PG8_SB(0, 1), b2 + hstep, voffB);
            PG8_WAIT_V(6); PG8_BAR; PG8_MMA(1, 1, At, B1); PG8_BAR;
            PG8_LDB(B0, 1, 0); PG8_SCHED; PG8_LDA(At, 1, 0); PG8_STAGE(PG8_SA(0, 1), a2 + hstep, voffA);
            PG8_WAIT_L(8); PG8_BAR; PG8_WAIT_L(0); PG8_MMA(0, 0, At, B0); PG8_BAR; PG8_SCHED;
            PG8_LDB(B1, 1, 1); PG8_STAGE(PG8_SB(1, 0), b3, voffB);
            PG8_BAR; PG8_WAIT_L(0); PG8_MMA(0, 1, At, B1); PG8_BAR;
            PG8_LDA(At, 1, 1); PG8_STAGE(PG8_SA(1, 0), a3, voffA);
            PG8_BAR; PG8_WAIT_L(0); PG8_MMA(1, 0, At, B0); PG8_BAR; PG8_SCHED;
            PG8_STAGE(PG8_SB(1, 1), b3 + hstep, voffB);
            PG8_WAIT_V(6); PG8_BAR; PG8_MMA(1, 1, At, B1); PG8_BAR;
            }
        }
        if constexpr (ALIGN_EPI) { if (wr == 0) PG8_BAR; }
        if constexpr (!Epi::AFTER_DRAIN) { E(acc, cur, wr, wc, fr, fq); S.done(cur); }
        if (!has_next) break;
#pragma unroll
        for (int a = 0; a < 2; ++a)
#pragma unroll
            for (int b = 0; b < 2; ++b)
#pragma unroll
                for (int m = 0; m < 4; ++m)
#pragma unroll
                    for (int n = 0; n < 2; ++n) acc[a][b][m][n] = (f32x4){0.f, 0.f, 0.f, 0.f};
        cur = nxt; cA = nA; cB = nB; ++ui;
        if constexpr (ALIGN_EPI) { if (wr == 1) PG8_BAR; }
    }
    PG8_WAIT_V(0);
    if constexpr (!ALIGN_EPI) { if (wr == 0) PG8_BAR; }
    PG8_BAR;
    if constexpr (Epi::AFTER_DRAIN) { E.fused(acc, cur, wr, wc, fr, fq, lds, wid, lane); S.done(cur); }
#undef PG8_SA
#undef PG8_SB
#undef PG8_STAGE
#undef PG8_LDA
#undef PG8_LDB
#undef PG8_MMA
#undef PG8_WAIT_V
#undef PG8_WAIT_L
#undef PG8_BAR
#undef PG8_SCHED
}
}
struct Args { const float* in[12]; float* out; unsigned char* ws; int ph_lo, ph_hi, flags, pad; };
enum { IN_X = 0, IN_NORMW, IN_WIN, IN_FOXFB, IN_CONVW, IN_CONVB, IN_MIB, IN_MFB, IN_FOXNW, IN_MNW, IN_WOUT, IN_FINW };
constexpr int NWAVES = 8, NTHREADS = 512;
constexpr int LDS_BYTES = 147456;

__device__ __forceinline__ void p0_transpose_gate(const float* W, int ldw, int k0, bf16* WT, int K, LAS float* scr, int lane) {
    const int n_ = lane & 31; const int sc = n_ < 8 ? 4096 + n_ : n_ < 16 ? 8200 + (n_ - 8) : n_ < 24 ? 8208 + (n_ - 16) : -1;
#pragma unroll 8
    for (int i = 0; i < 32; ++i) { const int kk = 2 * i + (lane >> 5); scr[kk * 33 + (lane & 31)] = sc >= 0 ? W[(size_t)(k0 + kk) * ldw + sc] : 0.f; }
    LDS_WAIT(); asm volatile("" ::: "memory");
    const int c = lane & 7;
#pragma unroll
    for (int j = 0; j < 4; ++j) { const int n = (lane >> 3) + 8 * j; const LAS float* s = scr + (8 * c) * 33 + n;
        v4u o; o.x = pk2(s[0 * 33], s[1 * 33]); o.y = pk2(s[2 * 33], s[3 * 33]); o.z = pk2(s[4 * 33], s[5 * 33]); o.w = pk2(s[6 * 33], s[7 * 33]);
        *(v4u*)(WT + (size_t)n * K + k0 + 8 * c) = o; }
    LDS_WAIT(); asm volatile("" ::: "memory");
}
struct XRow { pg8::f32x4 v[8]; };
__device__ __forceinline__ void xrow_load(XRow& R, const float* x, int m, int lane) {
    const pg8::f32x4* xr = (const pg8::f32x4*)(x + (size_t)m * DM) + lane;
#pragma unroll
    for (int j = 0; j < 8; ++j) R.v[j] = __builtin_nontemporal_load(xr + 64 * j);
}
__device__ __forceinline__ void xrow_store(const XRow& R, const pg8::f32x4 (&g)[8], bf16* XN, int m, int lane) {
    float s = 0.f;
#pragma unroll
    for (int j = 0; j < 8; ++j) s += (R.v[j][0] * R.v[j][0] + R.v[j][1] * R.v[j][1]) + (R.v[j][2] * R.v[j][2] + R.v[j][3] * R.v[j][3]);
    const float rstd = 1.0f / sqrtf(wave_sum(s) * (1.f / DM) + NORM_EPS);
    const bool odd = lane & 1;
    v4u* o = (v4u*)(XN + (size_t)m * DM) + (odd ? 32 : 0) + (lane >> 1);
#pragma unroll
    for (int jj = 0; jj < 4; ++jj) { const pg8::f32x4 a0 = R.v[2 * jj] * rstd * g[2 * jj], a1 = R.v[2 * jj + 1] * rstd * g[2 * jj + 1];
        const unsigned p0x = pk2(a0[0], a0[1]), p0y = pk2(a0[2], a0[3]), p1x = pk2(a1[0], a1[1]), p1y = pk2(a1[2], a1[3]);
        const unsigned rx = (unsigned)__shfl_xor((int)(odd ? p0x : p1x), 1), ry = (unsigned)__shfl_xor((int)(odd ? p0y : p1y), 1);
        v4u w; w.x = odd ? rx : p0x; w.y = odd ? ry : p0y; w.z = odd ? p1x : rx; w.w = odd ? p1y : ry; o[64 * jj] = w; }
}
struct TTile { const float* src; bf16* dst; int ldw; };
__device__ __forceinline__ void ttile_load(const TTile& t, pg8::f32x4 (&r)[8], int wave, int lane) {
#pragma unroll
    for (int i = 0; i < 8; ++i) r[i] = *(const pg8::f32x4*)(t.src + (size_t)(8 * i + wave) * t.ldw + 4 * lane);
}
constexpr int T_MAIN = 32 * 32, T_OUT = 32 * 8, NTILES = T_MAIN + T_OUT;
__device__ __forceinline__ void transpose_tiles(const Args& a, LAS unsigned char* lds, int first, int step, int end) {
    const int tid = threadIdx.x, lane = tid & 63, wave = tid >> 6;
    const float* win = a.in[IN_WIN]; const float* wout = a.in[IN_WOUT];
    bf16* WIN_T = (bf16*)(a.ws + WS_WIN); bf16* WOUT_T = (bf16*)(a.ws + WS_WOUT);
    constexpr int TP = 260;
    LAS float* tile = (LAS float*)lds;
#define P0_DECODE(it_, T_) do { int r_ = (it_); if (r_ < T_MAIN) { const int kb = r_ >> 5, n0 = 256 * (r_ & 31); T_.src = win + (size_t)(64 * kb) * IN_COLS + (n0 < 4096 ? n0 : n0 + 8); T_.dst = WIN_T + (size_t)n0 * DM + 64 * kb; T_.ldw = IN_COLS; } \
        else { r_ -= T_MAIN; const int kb = r_ >> 3, n0 = 256 * (r_ & 7); T_.src = wout + (size_t)(64 * kb) * DM + n0; T_.dst = WOUT_T + (size_t)n0 * DM + 64 * kb; T_.ldw = DM; } } while (0)
    TTile T; pg8::f32x4 r[8];
    int it = first; if (it < end) { P0_DECODE(it, T); ttile_load(T, r, wave, lane); }
    for (; it < end; it += step) {
#pragma unroll
        for (int i = 0; i < 8; ++i) { const int k = 8 * i + wave; *(LAS pg8::f32x4*)(tile + k * TP + ((4 * lane + 4 * i) & 255)) = r[i]; }
        bf16* dst = T.dst;
        const int itn = it + step; { const int itc = itn < end ? itn : it; P0_DECODE(itc, T); ttile_load(T, r, wave, lane); } __builtin_amdgcn_sched_barrier(0);
        __syncthreads();
        const int c = lane & 7;
#pragma unroll
        for (int j = 0; j < 4; ++j) { const int n = 32 * wave + 8 * j + (lane >> 3); const LAS float* s = tile + (8 * c) * TP + ((n + 4 * c) & 255);
            v4u o; o.x = pk2(s[0 * TP], s[1 * TP]); o.y = pk2(s[2 * TP], s[3 * TP]); o.z = pk2(s[4 * TP], s[5 * TP]); o.w = pk2(s[6 * TP], s[7 * TP]);
            *(v4u*)(dst + (size_t)n * DM + 8 * c) = o; }
        __syncthreads();
    }
#undef P0_DECODE
}
__device__ __forceinline__ void phase_prep(const Args& a, LAS unsigned char* lds, int nblk, int blk) {
    const int tid = threadIdx.x, lane = tid & 63, wave = tid >> 6;
    const int gw = blk * NWAVES + wave, NGW = nblk * NWAVES;
    const float* win = a.in[IN_WIN]; bf16* WG_T = (bf16*)(a.ws + WS_WGT);
    if (!(a.flags & 1)) {
        transpose_tiles(a, lds, blk, nblk, T_MAIN);
        if (gw < 32) p0_transpose_gate(win, IN_COLS, 64 * gw, WG_T, DM, (LAS float*)(lds + wave * 16384), lane);
        __syncthreads();
    }
    const float* x = a.in[IN_X]; bf16* XN = (bf16*)(a.ws + WS_XN);
    pg8::f32x4 g[8];
    { const pg8::f32x4* wr = (const pg8::f32x4*)a.in[IN_NORMW] + lane;
#pragma unroll
      for (int j = 0; j < 8; ++j) g[j] = wr[64 * j]; }
    XRow R0, R1, R2, R3;
    int m = (a.flags & 2) ? M_TOK : gw;
#define XLD(R_, m_) do { xrow_load(R_, x, (m_) < M_TOK ? (m_) : M_TOK - 1, lane); __builtin_amdgcn_sched_barrier(0); } while (0)
#define XST(R_, m_) do { if ((m_) < M_TOK) xrow_store(R_, g, XN, (m_), lane); __builtin_amdgcn_sched_barrier(0); } while (0)
    if (NGW * 8 == M_TOK && !(a.flags & 2)) {
#define XK(k_) (gw + (k_) * NGW)
        XLD(R0, XK(0)); XLD(R1, XK(1)); XLD(R2, XK(2));
        XLD(R3, XK(3)); XST(R0, XK(0)); XLD(R0, XK(4)); XST(R1, XK(1)); XLD(R1, XK(5)); XST(R2, XK(2)); XLD(R2, XK(6)); XST(R3, XK(3));
        XLD(R3, XK(7)); XST(R0, XK(4)); XST(R1, XK(5)); XST(R2, XK(6)); XST(R3, XK(7));
#undef XK
    } else {
    XLD(R0, m); XLD(R1, m + NGW); XLD(R2, m + 2 * NGW);
    for (; m < M_TOK; m += 4 * NGW) {
        XLD(R3, m + 3 * NGW); XST(R0, m);
        XLD(R0, m + 4 * NGW); XST(R1, m + NGW);
        XLD(R1, m + 5 * NGW); XST(R2, m + 2 * NGW);
        XLD(R2, m + 6 * NGW); XST(R3, m + 3 * NGW);
    }
    }
#undef XLD
#undef XST
}

__device__ __forceinline__ void gate_unit(const Args& a, LAS unsigned char* lds, int c) {
    const int tid = threadIdx.x, lane = tid & 63, wave = tid >> 6, r32 = lane & 31, hi = lane >> 5;
    const bf16* XN = (const bf16*)(a.ws + WS_XN); const bf16* WG_T = (const bf16*)(a.ws + WS_WGT);
    f32x16 acc0 = {}, acc1 = {};
    constexpr int GP = 144;
    LAS unsigned char* img = lds + wave * (96 * GP); LAS unsigned char* imgb = img + 64 * GP;
    const bf16* ag = XN + (size_t)(64 * c + (lane >> 3)) * DM + 256 * wave + 8 * (lane & 7);
    const bf16* bg = WG_T + (size_t)(lane >> 3) * DM + 256 * wave + 8 * (lane & 7);
    pg8::u32x4 sa[4][8], sb[4][4];
#pragma unroll
    for (int q = 0; q < 4; ++q) {
#pragma unroll
        for (int i = 0; i < 8; ++i) sa[q][i] = *(const pg8::u32x4*)(ag + (size_t)(8 * i) * DM + 64 * q);
#pragma unroll
        for (int i = 0; i < 4; ++i) sb[q][i] = *(const pg8::u32x4*)(bg + (size_t)(8 * i) * DM + 64 * q); }
#pragma unroll
    for (int q = 0; q < 4; ++q) {
#pragma unroll
        for (int i = 0; i < 8; ++i) *(LAS pg8::u32x4*)(img + (8 * i + (lane >> 3)) * GP + (lane & 7) * 16) = sa[q][i];
#pragma unroll
        for (int i = 0; i < 4; ++i) *(LAS pg8::u32x4*)(imgb + (8 * i + (lane >> 3)) * GP + (lane & 7) * 16) = sb[q][i];
#pragma unroll
        for (int ks = 0; ks < 4; ++ks) {
            const pg8::bf16x8 A0 = *(const LAS pg8::bf16x8*)(img + r32 * GP + (16 * ks + 8 * hi) * 2), A1 = *(const LAS pg8::bf16x8*)(img + (32 + r32) * GP + (16 * ks + 8 * hi) * 2);
            const pg8::bf16x8 Bf = *(const LAS pg8::bf16x8*)(imgb + r32 * GP + (16 * ks + 8 * hi) * 2);
            acc0 = __builtin_amdgcn_mfma_f32_32x32x16_bf16(A0, Bf, acc0, 0, 0, 0);
            acc1 = __builtin_amdgcn_mfma_f32_32x32x16_bf16(A1, Bf, acc1, 0, 0, 0);
        }
    }
    __syncthreads();
    LAS float* part = (LAS float*)lds;
#pragma unroll
    for (int r = 0; r < 16; ++r) { const int row = (r & 3) + 8 * (r >> 2) + 4 * hi;
        part[(wave * 64 + row) * 32 + r32] = acc0[r]; part[(wave * 64 + 32 + row) * 32 + r32] = acc1[r]; }
    __syncthreads();
    float* G = (float*)(a.ws + WS_GATE);
    float csum = 0.f;
    for (int e = tid; e < 64 * 32; e += NTHREADS) { const int row = e >> 5, j = e & 31; float s = 0.f;
#pragma unroll
        for (int w = 0; w < 8; ++w) s += part[(w * 64 + row) * 32 + j];
        float v;
        if (j < 8) v = logsigmoidf(s + a.in[IN_FOXFB][j]); else if (j < 16) v = s + a.in[IN_MIB][j - 8]; else if (j < 24) v = logsigmoidf(s + a.in[IN_MFB][j - 16]); else v = 0.f;
        G[(size_t)(64 * c + row) * 32 + j] = v; csum += v; }
    csum += __shfl_xor(csum, 32);
    LAS float* cpart = (LAS float*)(lds + 65536);
    if (lane < 32) cpart[wave * 32 + lane] = csum;
    __syncthreads();
    if (tid < 32) { float s = 0.f;
#pragma unroll
        for (int w = 0; w < 8; ++w) s += cpart[w * 32 + tid];
        ((float*)(a.ws + WS_ROWSS))[(size_t)c * 32 + tid] = s; }
    __syncthreads();
}

__device__ __forceinline__ void fox_cumsum_item(const Args& a, int it) {
    const int tid = threadIdx.x, lane = tid & 63, h = tid >> 6; const int b = it >> 6, jb = it & 63, bh = b * 8 + h, s = jb * 64 + lane;
    const float v = ((const float*)(a.ws + WS_GATE))[((size_t)b * SEQ + s) * 32 + h];
    const float bs = lane < jb ? ((const float*)(a.ws + WS_ROWSS))[(size_t)(b * 64 + lane) * 32 + h] : 0.f;
    const float incl = wave_scan_add(v), base = wave_sum(bs);
    const float kb2 = -(base + incl) * LOG2E;
    const unsigned h1 = f2bf(kb2); const float r1 = kb2 - bf2f(h1); const unsigned h2 = f2bf(r1); const float r2 = r1 - bf2f(h2); const unsigned h3 = f2bf(r2);
    v4u o; o.x = h1 | (h2 << 16); o.y = h3; o.z = 0u; o.w = 0u;
    *(v4u*)((bf16*)(a.ws + WS_KBIAS) + ((size_t)bh * SEQ + s) * 8) = o;
    if (lane == 63) ((float*)(a.ws + WS_KBND))[bh * 64 + jb] = kb2 + 0.01f;
}

struct ORow { pg8::f32x4 v[8]; v4u d[4]; };
__device__ __forceinline__ void orow_load_x(ORow& R, const float* x, int m, int lane) {
    const pg8::f32x4* xr = (const pg8::f32x4*)(x + (size_t)m * DM) + lane;
#pragma unroll
    for (int j = 0; j < 8; ++j) R.v[j] = __builtin_nontemporal_load(xr + 64 * j);
}
__device__ __forceinline__ void orow_load_d(ORow& R, const bf16* delta, int m, int lane) {
    const int p0 = ((lane & 1) ? 32 : 0) + (lane >> 1);
    const v4u* dr = (const v4u*)delta + (size_t)(m >> 1) * 512 + (m & 1) * 4 + (p0 >> 2) * 8 + (p0 & 3);
#pragma unroll
    for (int jj = 0; jj < 4; ++jj) R.d[jj] = dr[128 * jj];
}
__device__ __forceinline__ void orow_load(ORow& R, const float* x, const bf16* delta, int m, int lane) { orow_load_x(R, x, m, lane); orow_load_d(R, delta, m, lane); }
__device__ __forceinline__ void orow_store(ORow& R, const pg8::f32x4 (&g)[8], float* out, int m, int lane) {
    float s = 0.f; const bool odd = lane & 1;
#pragma unroll
    for (int jj = 0; jj < 4; ++jj) { const v4u d = R.d[jj];
        const unsigned rx = (unsigned)__shfl_xor((int)(odd ? d.x : d.z), 1), ry = (unsigned)__shfl_xor((int)(odd ? d.y : d.w), 1);
        const unsigned e0x = odd ? rx : d.x, e0y = odd ? ry : d.y, e1x = odd ? d.z : rx, e1y = odd ? d.w : ry;
        R.v[2 * jj] += (pg8::f32x4){bflo(e0x), bfhi(e0x), bflo(e0y), bfhi(e0y)}; R.v[2 * jj + 1] += (pg8::f32x4){bflo(e1x), bfhi(e1x), bflo(e1y), bfhi(e1y)};
        const pg8::f32x4 a0 = R.v[2 * jj], a1 = R.v[2 * jj + 1];
        s += ((a0[0] * a0[0] + a0[1] * a0[1]) + (a0[2] * a0[2] + a0[3] * a0[3])) + ((a1[0] * a1[0] + a1[1] * a1[1]) + (a1[2] * a1[2] + a1[3] * a1[3])); }
    const float rstd = 1.0f / sqrtf(wave_sum(s) * (1.f / DM) + NORM_EPS);
    pg8::f32x4* o = (pg8::f32x4*)(out + (size_t)m * DM) + lane;
#pragma unroll
    for (int j = 0; j < 8; ++j) o[64 * j] = R.v[j] * rstd * g[j];
}
__device__ __forceinline__ void final_prefetch(const Args& a, int nblk, int blk, ORow& RA, pg8::f32x4 (&g)[8]) {
    const int tid = threadIdx.x, lane = tid & 63, wave = tid >> 6; const int gw = blk * NWAVES + wave;
    { const pg8::f32x4* wr = (const pg8::f32x4*)a.in[IN_FINW] + lane;
#pragma unroll
      for (int j = 0; j < 8; ++j) g[j] = wr[64 * j]; }
    orow_load_x(RA, a.in[IN_X], gw < M_TOK ? gw : M_TOK - 1, lane);
}
__device__ __forceinline__ void phase_final(const Args& a, int nblk, int blk, ORow& RA, const pg8::f32x4 (&g)[8]) {
    const int tid = threadIdx.x, lane = tid & 63, wave = tid >> 6; const int gw = blk * NWAVES + wave, NGW = nblk * NWAVES;
    const bf16* delta = (const bf16*)(a.ws + WS_DELTA); const float* x = a.in[IN_X];
    ORow RB;
    if (NGW * 8 == M_TOK) {
#define OL(R_, k_) do { orow_load(R_, x, delta, gw + (k_) * NGW, lane); __builtin_amdgcn_sched_barrier(0); } while (0)
#define OS(R_, k_) do { orow_store(R_, g, a.out, gw + (k_) * NGW, lane); __builtin_amdgcn_sched_barrier(0); } while (0)
        orow_load_d(RA, delta, gw, lane); __builtin_amdgcn_sched_barrier(0);
        OL(RB, 1); OS(RA, 0); OL(RA, 2); OS(RB, 1); OL(RB, 3); OS(RA, 2); OL(RA, 4); OS(RB, 3); OL(RB, 5); OS(RA, 4); OL(RA, 6); OS(RB, 5); OL(RB, 7); OS(RA, 6); OS(RB, 7);
#undef OL
#undef OS
        return;
    }
    int m = gw; orow_load_d(RA, delta, m < M_TOK ? m : M_TOK - 1, lane);
    for (; m < M_TOK; m += 2 * NGW) {
        const int mb = m + NGW, mc = m + 2 * NGW;
        orow_load(RB, x, delta, mb < M_TOK ? mb : M_TOK - 1, lane); __builtin_amdgcn_sched_barrier(0);
        orow_store(RA, g, a.out, m, lane); __builtin_amdgcn_sched_barrier(0);
        orow_load(RA, x, delta, mc < M_TOK ? mc : M_TOK - 1, lane); __builtin_amdgcn_sched_barrier(0);
        if (mb < M_TOK) orow_store(RB, g, a.out, mb, lane);
        __builtin_amdgcn_sched_barrier(0);
    }
}

namespace fox {
typedef short bf16x8 __attribute__((ext_vector_type(8)));
typedef short s16x4 __attribute__((ext_vector_type(4)));
typedef float f32x16 __attribute__((ext_vector_type(16)));
typedef unsigned u32x4 __attribute__((ext_vector_type(4)));
typedef LAS char* lptr;
constexpr int D = 128, NW = 8, QBLK = 32, KVBLK = 64, QB = NW * QBLK;
constexpr int SHM_V = KVBLK * D * 2, SHM_K = KVBLK * D * 2;
constexpr int OFF_V = 0, OFF_K = 2 * SHM_V, OFF_WS = 2 * SHM_V + 2 * SHM_K, OFF_KB = OFF_WS + NW * 64 * 4, OFF_VOTE = OFF_KB + 2 * 1024, LDS_NEED = OFF_VOTE + 64;
constexpr int OFF_KSUF = 73728;
constexpr float THR2 = 11.5f;
#define KSWZ(row, colB) ((row) * 256 + ((colB) ^ (((row) & 7) << 4)))
#define SBAR() __builtin_amdgcn_sched_barrier(0)
__device__ __forceinline__ int v_st(int k, int c) { const int kk = (k & ~0xC) | ((k & 4) << 1) | ((k & 8) >> 1); return ((kk >> 3) * 4 + (c >> 5)) * 512 + ((kk & 7) * 32 + (c & 31)) * 2; }
__device__ __forceinline__ int v_rd_base(int lane) { return ((lane & 3) << 3) | (((lane >> 2) & 3) << 6) | (((lane >> 4) & 1) << 5) | (((lane >> 5) & 1) << 8); }
constexpr int v_rd_off(int d0, int ks, int half) { return d0 * 512 + ks * 4096 + half * 2048; }
__device__ __forceinline__ int crow(int r, int hi) { return (r & 3) + 8 * (r >> 2) + 4 * hi; }
__device__ __forceinline__ unsigned cvtpk(float lo, float hi) { return pk2(lo, hi); }
__device__ __forceinline__ void mask_tile(f32x16& p0, f32x16& p1, int dq) {
    const float NEG = -__builtin_inff();
#pragma unroll
    for (int r = 0; r < 16; ++r) { const int c = (r & 3) + 8 * (r >> 2);
        if (dq - c < 0) p0[r] = NEG;
        if (dq - c - 32 < 0) p1[r] = NEG; }
}
__device__ __forceinline__ void partialSM(f32x16& p0, f32x16& p1, float& m_reg, float& mn, float& alpha) {
    float pmax = p0[0];
#pragma unroll
    for (int r = 1; r < 16; ++r) pmax = fmaxf(pmax, p0[r]);
#pragma unroll
    for (int r = 0; r < 16; ++r) pmax = fmaxf(pmax, p1[r]);
    { auto rr = __builtin_amdgcn_permlane32_swap(__float_as_uint(pmax), __float_as_uint(pmax), false, false);
      pmax = fmaxf(__uint_as_float(rr[0]), __uint_as_float(rr[1])); }
    if (__builtin_expect(__all((pmax - m_reg) <= THR2), 1)) { mn = m_reg; alpha = 1.f; }
    else { mn = fmaxf(m_reg, pmax); alpha = __builtin_amdgcn_exp2f(m_reg - mn); m_reg = mn; }
#pragma unroll
    for (int r = 0; r < 16; ++r) p0[r] = p0[r] - mn;
#pragma unroll
    for (int r = 0; r < 16; ++r) p1[r] = p1[r] - mn;
#pragma unroll
    for (int r = 0; r < 16; ++r) p0[r] = __builtin_amdgcn_exp2f(p0[r]);
}
__device__ __forceinline__ void finishSM(f32x16& p0, f32x16& p1, float alpha, float& l_reg, bf16x8& pa0, bf16x8& pa1, bf16x8& pa2, bf16x8& pa3) {
#pragma unroll
    for (int r = 0; r < 16; ++r) p1[r] = __builtin_amdgcn_exp2f(p1[r]);
    float ps = 0;
#pragma unroll
    for (int r = 0; r < 16; ++r) ps += p0[r];
#pragma unroll
    for (int r = 0; r < 16; ++r) ps += p1[r];
    { auto rr = __builtin_amdgcn_permlane32_swap(__float_as_uint(ps), __float_as_uint(ps), false, false);
      ps = __uint_as_float(rr[0]) + __uint_as_float(rr[1]); }
    l_reg = l_reg * alpha + ps;
#define PK4(P, B_, OUT) do { unsigned a0 = cvtpk(P[B_+0], P[B_+1]), a1 = cvtpk(P[B_+2], P[B_+3]);                          \
        unsigned b0 = cvtpk(P[B_+4], P[B_+5]), b1 = cvtpk(P[B_+6], P[B_+7]);                                             \
        auto r0 = __builtin_amdgcn_permlane32_swap(a0, b0, false, false); auto r1 = __builtin_amdgcn_permlane32_swap(a1, b1, false, false); \
        u32x4 w = {r0[0], r1[0], r0[1], r1[1]}; OUT = __builtin_bit_cast(bf16x8, w); } while (0)
    PK4(p0, 0, pa0); PK4(p0, 8, pa1); PK4(p1, 0, pa2); PK4(p1, 8, pa3);
#undef PK4
}
template <int N> __device__ __forceinline__ void lgkm_wait(bf16x8& f) { asm volatile("s_waitcnt lgkmcnt(%1)" : "+v"(f) : "i"(N) : "memory"); }
template <int KB, int I> __device__ __forceinline__ void qkt_rd(bf16x8& f, const int (&ka)[4], int kbb) {
    if constexpr (I < 16) { constexpr int d0 = I >> 1; asm volatile("ds_read_b128 %0, %1 offset:%2" : "=&v"(f) : "v"(ka[d0 & 3]), "i"(OFF_K + KB * SHM_K + (d0 >> 2) * 128 + (I & 1) * 8192) : "memory"); }
    else asm volatile("ds_read_b128 %0, %1 offset:%2" : "=&v"(f) : "v"(kbb), "i"(KB * 1024 + (I & 1) * 512) : "memory");
}
template <int KB, int I> __device__ __forceinline__ void qkt_step(f32x16& p0, f32x16& p1, bf16x8 (&f)[4], const int (&ka)[4], int kbb, const bf16x8* qr, bf16x8 qone) {
    constexpr int last = I + 3 < 17 ? I + 3 : 17;
    lgkm_wait<last - I>(f[I & 3]);
    const bf16x8 qb = I < 16 ? qr[I >> 1] : qone;
    if constexpr (I & 1) p1 = __builtin_amdgcn_mfma_f32_32x32x16_bf16(f[I & 3], qb, p1, 0, 0, 0);
    else                 p0 = __builtin_amdgcn_mfma_f32_32x32x16_bf16(f[I & 3], qb, p0, 0, 0, 0);
    if constexpr (I + 4 < 18) qkt_rd<KB, I + 4>(f[I & 3], ka, kbb);
    if constexpr (I + 1 < 18) qkt_step<KB, I + 1>(p0, p1, f, ka, kbb, qr, qone);
}
template <int KB>
__device__ __forceinline__ void qkt(f32x16& p0, f32x16& p1, lptr lds, int r32, int hi, const bf16x8* qr, bf16x8 qone) {
    p0 = f32x16{}; p1 = f32x16{};
    __builtin_amdgcn_s_setprio(1);
    int ka[4];
#pragma unroll
    for (int dd = 0; dd < 4; ++dd) ka[dd] = (int)(uintptr_t)lds + KSWZ(r32, (dd * 16 + hi * 8) * 2);
    const int kbb = (int)(uintptr_t)lds + OFF_KB + r32 * 16;
    bf16x8 f[4];
    qkt_rd<KB, 0>(f[0], ka, kbb); qkt_rd<KB, 1>(f[1], ka, kbb); qkt_rd<KB, 2>(f[2], ka, kbb); qkt_rd<KB, 3>(f[3], ka, kbb);
    qkt_step<KB, 0>(p0, p1, f, ka, kbb, qr, qone);
    __builtin_amdgcn_s_setprio(0);
}
template <int VB>
__device__ __forceinline__ void pv_tile(f32x16* o, int vb0, bf16x8 pa0, bf16x8 pa1, bf16x8 pa2, bf16x8 pa3) {
#define TRRD(dst, off) asm volatile("ds_read_b64_tr_b16 %0, %1 offset:%2" : "=&v"(dst) : "v"(vb0), "i"(off) : "memory")
#define PV_D0(d0) do { s16x4 l0, l1, l2, l3, h0, h1, h2, h3; constexpr int b_ = OFF_V + VB * SHM_V + v_rd_off(d0, 0, 0); \
        TRRD(l0, b_); TRRD(h0, b_ + 2048); TRRD(l1, b_ + 4096); TRRD(h1, b_ + 6144); TRRD(l2, b_ + 8192); TRRD(h2, b_ + 10240); TRRD(l3, b_ + 12288); TRRD(h3, b_ + 14336); \
        asm volatile("s_waitcnt lgkmcnt(0)" ::: "memory"); SBAR();   \
        o[d0] = __builtin_amdgcn_mfma_f32_32x32x16_bf16(pa0, (bf16x8){l0[0], l0[1], l0[2], l0[3], h0[0], h0[1], h0[2], h0[3]}, o[d0], 0, 0, 0);   \
        o[d0] = __builtin_amdgcn_mfma_f32_32x32x16_bf16(pa1, (bf16x8){l1[0], l1[1], l1[2], l1[3], h1[0], h1[1], h1[2], h1[3]}, o[d0], 0, 0, 0);   \
        o[d0] = __builtin_amdgcn_mfma_f32_32x32x16_bf16(pa2, (bf16x8){l2[0], l2[1], l2[2], l2[3], h2[0], h2[1], h2[2], h2[3]}, o[d0], 0, 0, 0);   \
        o[d0] = __builtin_amdgcn_mfma_f32_32x32x16_bf16(pa3, (bf16x8){l3[0], l3[1], l3[2], l3[3], h3[0], h3[1], h3[2], h3[3]}, o[d0], 0, 0, 0); } while (0)
    __builtin_amdgcn_s_setprio(1); PV_D0(0); PV_D0(1); PV_D0(2); PV_D0(3); __builtin_amdgcn_s_setprio(0);
#undef PV_D0
#undef TRRD
}
struct BlockRef { const bf16* Q; const bf16* K; const bf16* V; const bf16* KB; const LAS float* ksuf; const float* kbnd; int P0; int tok0; int h; };
struct Seam { bf16x8 qr[8]; bf16x8 st_v0, st_v1, st_k0, st_k1; u32x4 st_kb; };
#define VMW() asm volatile("s_waitcnt vmcnt(0)" ::: "memory")
#define BL128(rs, vo, so) __builtin_bit_cast(bf16x8, __builtin_amdgcn_raw_buffer_load_b128(rs, (int)(vo), (int)(so), 0))
#define SLOAD_H(k0) do { const int so_ = (k0) * 256; S.st_v0 = BL128(rsV, voffKV, so_); S.st_v1 = BL128(rsV, voffKV, so_ + 8192);              \
                         S.st_k0 = BL128(rsK, voffKV, so_); S.st_k1 = BL128(rsK, voffKV, so_ + 8192); \
                         S.st_kb = __builtin_amdgcn_raw_buffer_load_b128(rsB, lane * 16, (k0) * 16, 0); } while (0)
#define SWRITE_HK(bf) do { *(LAS bf16x8*)(lds + OFF_K + (bf) * SHM_K + kws) = S.st_k0; *(LAS bf16x8*)(lds + OFF_K + (bf) * SHM_K + kws + 32 * 256) = S.st_k1; \
                         if (wid == 0) *(LAS u32x4*)(lds + OFF_KB + (bf) * 1024 + lane * 16) = S.st_kb; } while (0)
#define SWRITE_HV(bf) do { *(LAS bf16x8*)(lds + OFF_V + (bf) * SHM_V + vst0) = S.st_v0; *(LAS bf16x8*)(lds + OFF_V + (bf) * SHM_V + vst1) = S.st_v1; } while (0)
#define SWRITE_H(bf) do { SWRITE_HV(bf); SWRITE_HK(bf); } while (0)
__device__ __forceinline__ __amdgpu_buffer_rsrc_t mk_rsrc(const void* p, unsigned bytes) {
    const unsigned long long v = (unsigned long long)p; const unsigned lo = __builtin_amdgcn_readfirstlane((unsigned)v), hi = __builtin_amdgcn_readfirstlane((unsigned)(v >> 32));
    return __builtin_amdgcn_make_buffer_rsrc((void*)(((unsigned long long)hi << 32) | lo), 0, bytes, 0x00020000);
}
struct EpiParams { const float* g; const bf16* FZ; bf16* Y; };
template <int ORD> __device__ __forceinline__ void block(const BlockRef& cur, lptr lds, const EpiParams& E, unsigned* ctr, int blk, LAS int* slot) {
    Seam S;
    const int tid = threadIdx.x, wid = __builtin_amdgcn_readfirstlane(tid >> 6), lane = tid & 63, r32 = lane & 31, hi = lane >> 5;
    const int NT = (cur.P0 + QB) / KVBLK;
    int NTe = NT;
    LAS int* vote = (LAS int*)(lds + OFF_VOTE);
    const int qlo = cur.P0 + wid * QBLK, qm = qlo + r32 - 4 * hi;
    LAS float* ws = (LAS float*)(lds + OFF_WS) + wid * 64; LAS float* li_l = ws; LAS float* al_l = ws + 32;
    float m_reg = -1e30f, l_reg = 0; f32x16 o[4] = {};
    const int sr = tid >> 4, sc = (tid & 15) * 8, vst0 = v_st(sr, sc), vst1 = v_st(32 + sr, sc), kws = KSWZ(sr, sc * 2);
    const int vb0 = (int)(uintptr_t)(lds) + v_rd_base(lane);
    const __amdgpu_buffer_rsrc_t rsK = mk_rsrc(cur.K, SEQ * 256), rsV = mk_rsrc(cur.V, SEQ * 256), rsB = mk_rsrc(cur.KB, SEQ * 16), rsQ = mk_rsrc(cur.Q, QB * 256);
    const int voffKV = (int)hm_off((unsigned)sr, (unsigned)sc) * 2;
    bf16x8 qone; { u32x4 w = {hi ? 0u : 0x3F803F80u, hi ? 0u : 0x00003F80u, 0u, 0u}; qone = __builtin_bit_cast(bf16x8, w); }
#define RESC(a) do { if (__any((a) < 1.f)) { if (hi == 0) al_l[r32] = (a); asm volatile("s_waitcnt lgkmcnt(0)" ::: "memory");              \
                     _Pragma("unroll") for (int d_ = 0; d_ < 4; ++d_) _Pragma("unroll") for (int r = 0; r < 16; ++r) o[d_][r] *= al_l[crow(r, hi)]; } } while (0)
#define KBASE(t) ((NT - 1 - (t)) * KVBLK)
#define MASKT(P0_, P1_, t) do { const int kb_ = KBASE(t); if (kb_ + KVBLK - 1 > qlo) mask_tile(P0_, P1_, qm - kb_); } while (0)
    f32x16 pA0, pA1, pB0, pB1; float mnA, mnB, alA, alB; bf16x8 pa0, pa1, pa2, pa3;
    { const int voffQ = (int)hm_off((unsigned)(wid * QBLK + r32), (unsigned)(hi * 8)) * 2;
#pragma unroll
      for (int d0 = 0; d0 < 8; ++d0) S.qr[d0] = BL128(rsQ, voffQ, (d0 >> 1) * 128 + (d0 & 1) * 32); }
    SLOAD_H(KBASE(0)); SBAR();
    float qn;
    { float ssq = 0.f;
#pragma unroll
      for (int d0 = 0; d0 < 8; ++d0) { const u32x4 w = __builtin_bit_cast(u32x4, S.qr[d0]);
          ssq += (bflo(w.x) * bflo(w.x) + bfhi(w.x) * bfhi(w.x)) + (bflo(w.y) * bflo(w.y) + bfhi(w.y) * bfhi(w.y)) + (bflo(w.z) * bflo(w.z) + bfhi(w.z) * bfhi(w.z)) + (bflo(w.w) * bflo(w.w) + bfhi(w.w) * bfhi(w.w)); }
      auto rr = __builtin_amdgcn_permlane32_swap(__float_as_uint(ssq), __float_as_uint(ssq), false, false);
      qn = sqrtf(__uint_as_float(rr[0]) + __uint_as_float(rr[1])) * 1.001f; }
    VMW(); SWRITE_HK(0);
    __syncthreads();
    SWRITE_HV(0); SBAR();
    SLOAD_H(KBASE(1));
    SBAR(); qkt<0>(pA0, pA1, lds, r32, hi, S.qr, qone);
    MASKT(pA0, pA1, 0); partialSM(pA0, pA1, m_reg, mnA, alA);
    VMW(); SWRITE_H(1);
    __syncthreads();
#define HALF_TAIL(alX, t, SB, VOTE)                                                                                           \
        const int jj_ = NT - 1 - ((t) + 2);                                                                                   \
        if (VOTE && jj_ >= 0) { const bool sk_ = __all(qn * cur.ksuf[jj_] + cur.kbnd[jj_] - m_reg < -152.f); if (lane == 0) vote[wid] = sk_ ? 1 : 0; }                      \
        __syncthreads();                                                                                                      \
        if ((t) + 1 < NTe) { VMW(); SWRITE_H(SB); }                                                                          \
        if (VOTE && jj_ >= 0) { const int v_ = vote[lane & 7]; if (__all(v_ != 0)) NTe = (t) + 2; }                                          \
        RESC(alX); __syncthreads();
#define HALF_STEP_A(PX0, PX1, mnX, alX, PY0, PY1, alY, t, KB, VB, SB, VOTE) do {                                                    \
        SBAR(); qkt<KB>(PX0, PX1, lds, r32, hi, S.qr, qone); SBAR();                                                          \
        finishSM(PY0, PY1, alY, l_reg, pa0, pa1, pa2, pa3); SBAR();                                                           \
        if ((t) + 1 < NTe) { SLOAD_H(KBASE((t) + 1)); SBAR(); }                                               \
        pv_tile<VB>(o, vb0, pa0, pa1, pa2, pa3); SBAR(); MASKT(PX0, PX1, (t)); partialSM(PX0, PX1, m_reg, mnX, alX);           \
        HALF_TAIL(alX, t, SB, VOTE) } while (0)
#define HALF_STEP_B(PX0, PX1, mnX, alX, PY0, PY1, alY, t, KB, VB, SB, VOTE) do {                                                    \
        SBAR(); finishSM(PY0, PY1, alY, l_reg, pa0, pa1, pa2, pa3); SBAR();                                                   \
        qkt<KB>(PX0, PX1, lds, r32, hi, S.qr, qone); SBAR();                                                                  \
        if ((t) + 1 < NTe) { SLOAD_H(KBASE((t) + 1)); SBAR(); }                                               \
        MASKT(PX0, PX1, (t)); partialSM(PX0, PX1, m_reg, mnX, alX); SBAR(); pv_tile<VB>(o, vb0, pa0, pa1, pa2, pa3);           \
        HALF_TAIL(alX, t, SB, VOTE) } while (0)
    if constexpr (ORD == 0) {
        for (int t = 1; t + 1 < NTe; t += 2) {
            HALF_STEP_A(pB0, pB1, mnB, alB, pA0, pA1, alA, t, 1, 0, 0, false);
            HALF_STEP_A(pA0, pA1, mnA, alA, pB0, pB1, alB, t + 1, 0, 1, 1, true);
        }
    } else {
        for (int t = 1; t + 1 < NTe; t += 2) {
            HALF_STEP_B(pB0, pB1, mnB, alB, pA0, pA1, alA, t, 1, 0, 0, false);
            HALF_STEP_B(pA0, pA1, mnA, alA, pB0, pB1, alB, t + 1, 0, 1, 1, true);
        }
    }
    SBAR(); qkt<1>(pB0, pB1, lds, r32, hi, S.qr, qone); SBAR();
    finishSM(pA0, pA1, alA, l_reg, pa0, pa1, pa2, pa3); SBAR();
    pv_tile<0>(o, vb0, pa0, pa1, pa2, pa3);
    MASKT(pB0, pB1, NTe - 1); partialSM(pB0, pB1, m_reg, mnB, alB); __syncthreads(); RESC(alB);
    finishSM(pB0, pB1, alB, l_reg, pa0, pa1, pa2, pa3); SBAR(); pv_tile<1>(o, vb0, pa0, pa1, pa2, pa3);
    SBAR();
    if (tid == 0) { int it_ = -1;
        for (int k_ = 0; k_ < 8; ++k_) { const int q_ = (blk + k_) & 7; const unsigned i_ = atomicAdd(&ctr[q_ * 64], 1u); if (i_ < 64u) { it_ = q_ * 64 + (int)i_; break; } }
        *slot = it_; }
    if (hi == 0) li_l[r32] = l_reg; asm volatile("s_waitcnt lgkmcnt(0)" ::: "memory");
    {
        LAS float* stg = (LAS float*)(lds + OFF_K) + wid * 1024;
        int lane_o = lane; asm volatile("" : "+v"(lane_o));
        const int erow = lane_o >> 3, seg = lane_o & 7;
        const float* gp = E.g + cur.h * 128 + seg * 8;
        pg8::f32x4 g4[4];
#pragma unroll
        for (int j = 0; j < 4; ++j) g4[j] = *(const pg8::f32x4*)(gp + (j >> 1) * 64 + (j & 1) * 4);
        const unsigned trow = (unsigned)(cur.tok0 + wid * QBLK);
#pragma unroll
        for (int p = 0; p < 4; ++p) {
            const unsigned tokr = trow + 8u * p + (unsigned)erow;
            const bf16* zp = E.FZ + tm_off(tokr, (unsigned)(cur.h * 128 + seg * 8));
            const u32x4 z0 = __builtin_nontemporal_load((const u32x4*)zp), z1 = __builtin_nontemporal_load((const u32x4*)(zp + 128));
#pragma unroll
            for (int rr = 0; rr < 4; ++rr) { const int r = 4 * p + rr; const float rl = __builtin_amdgcn_rcpf(li_l[crow(r, hi)]);
#pragma unroll
                for (int d0 = 0; d0 < 4; ++d0) stg[(rr + 4 * hi) * 128 + d0 * 32 + r32] = o[d0][r] * rl; }
            asm volatile("s_waitcnt lgkmcnt(0)" ::: "memory");
            float x[16]; float ss = 0.f;
#pragma unroll
            for (int j = 0; j < 4; ++j) { const pg8::f32x4 v = *(const LAS pg8::f32x4*)(stg + erow * 128 + seg * 8 + (j >> 1) * 64 + (j & 1) * 4); x[4 * j] = v[0]; x[4 * j + 1] = v[1]; x[4 * j + 2] = v[2]; x[4 * j + 3] = v[3];
                ss += (v[0] * v[0] + v[1] * v[1]) + (v[2] * v[2] + v[3] * v[3]); }
            asm volatile("s_waitcnt lgkmcnt(0)" ::: "memory");
            ss += __shfl_xor(ss, 1); ss += __shfl_xor(ss, 2); ss += __shfl_xor(ss, 4);
            const float rs = 1.0f / sqrtf(ss * (1.f / 128.f) + NORM_EPS);
            float zf[16]; zf[0] = bflo(z0.x); zf[1] = bfhi(z0.x); zf[2] = bflo(z0.y); zf[3] = bfhi(z0.y); zf[4] = bflo(z0.z); zf[5] = bfhi(z0.z); zf[6] = bflo(z0.w); zf[7] = bfhi(z0.w);
            zf[8] = bflo(z1.x); zf[9] = bfhi(z1.x); zf[10] = bflo(z1.y); zf[11] = bfhi(z1.y); zf[12] = bflo(z1.z); zf[13] = bfhi(z1.z); zf[14] = bflo(z1.w); zf[15] = bfhi(z1.w);
            float y[16];
#pragma unroll
            for (int e = 0; e < 16; ++e) y[e] = x[e] * rs * g4[e >> 2][e & 3] * (zf[e] * __builtin_amdgcn_rcpf(1.f + __builtin_amdgcn_exp2f(-zf[e] * LOG2E)));
            u32x4 o0, o1; o0.x = cvtpk(y[0], y[1]); o0.y = cvtpk(y[2], y[3]); o0.z = cvtpk(y[4], y[5]); o0.w = cvtpk(y[6], y[7]);
            o1.x = cvtpk(y[8], y[9]); o1.y = cvtpk(y[10], y[11]); o1.z = cvtpk(y[12], y[13]); o1.w = cvtpk(y[14], y[15]);
            bf16* yp = E.Y + (tokr * 2048u + (unsigned)(cur.h * 128 + seg * 8));
            *(u32x4*)yp = o0; *(u32x4*)(yp + 64) = o1;
        }
    }
    __syncthreads();
#undef RESC
#undef KBASE
#undef MASKT
#undef HALF_STEP
}
#undef VMW
#undef BL128
#undef SLOAD_H
#undef SWRITE_HK
#undef SWRITE_HV
#undef SWRITE_H
#undef KSWZ
#undef SBAR
__device__ __forceinline__ BlockRef make_ref(const Args& a, lptr lds, int bh, int qb) {
    BlockRef r; const size_t hb = (size_t)bh * SEQ * 128;
    r.Q = (const bf16*)(a.ws + WS_SEC + SEC_FQ * SEC_BYTES) + hb + (size_t)qb * QB * 128;
    r.K = (const bf16*)(a.ws + WS_SEC + SEC_FK * SEC_BYTES) + hb; r.V = (const bf16*)(a.ws + WS_SEC + SEC_FV * SEC_BYTES) + hb;
    r.KB = (const bf16*)(a.ws + WS_KBIAS) + (size_t)bh * SEQ * 8;
    r.ksuf = (const LAS float*)(lds + OFF_KSUF) + bh * 64; r.kbnd = (const float*)(a.ws + WS_KBND) + bh * 64;
    r.P0 = qb * QB; r.tok0 = (bh >> 3) * SEQ + qb * QB; r.h = bh & 7; return r;
}
__device__ __forceinline__ void phase(const Args& a, lptr lds, int nblk, int blk) {
    const EpiParams E{a.in[IN_FOXNW], (const bf16*)(a.ws + WS_SEC + SEC_FZ * SEC_BYTES), (bf16*)(a.ws + WS_Y)};
    unsigned* ctr = (unsigned*)(a.ws + WS_CTL) + 1024; LAS int* slot = (LAS int*)(lds + OFF_VOTE + 32);
    {
        const int lane = threadIdx.x & 63, w4 = (threadIdx.x >> 6) * 4; float v[4];
#pragma unroll
        for (int k = 0; k < 4; ++k) v[k] = ((const float*)(a.ws + WS_KNRM))[(w4 + k) * 64 + lane];
#pragma unroll
        for (int k = 0; k < 4; ++k) ((LAS float*)(lds + OFF_KSUF))[(w4 + k) * 64 + lane] = wave_scan_max(v[k]);
    }
    if (threadIdx.x == 0) { int item = -1;
        for (int k = 0; k < 8; ++k) { const int q = (blk + k) & 7; const unsigned i = atomicAdd(&ctr[q * 64], 1u); if (i < 64u) { item = q * 64 + (int)i; break; } }
        *slot = item; }
    __syncthreads();
    for (;;) {
        const int item = __builtin_amdgcn_readfirstlane(*slot);
        if (item < 0) break;
        const int q = item >> 6, i = item & 63, qb = 15 - (i >> 2), sl = i & 3;
        const int h = (((q & 1) ? 0x7421 : 0x6530) >> (4 * sl)) & 0xF, bh = (q >> 1) * 8 + h;
        const BlockRef cur = make_ref(a, lds, bh, qb);
        if (__builtin_amdgcn_readfirstlane(threadIdx.x >> 6) < 4) block<0>(cur, lds, E, ctr, blk, slot); else block<1>(cur, lds, E, ctr, blk, slot);
    }
    __syncthreads();
}
__device__ __forceinline__ void knorm_pass(const Args& a, int nblk, int blk) {
    const int tid = threadIdx.x, lane = tid & 63, wave = tid >> 6; const int gw = blk * NW + wave, NGW = nblk * NW;
    const bf16* FK = (const bf16*)(a.ws + WS_SEC + SEC_FK * SEC_BYTES); float* KN = (float*)(a.ws + WS_KNRM);
    for (int it = gw; it < BATCH * NH * 64; it += NGW) {
        const u32x4* kr = (const u32x4*)(FK + (size_t)it * 64 * 128) + lane;
        u32x4 w[16];
#pragma unroll
        for (int c = 0; c < 16; ++c) w[c] = __builtin_nontemporal_load(kr + 64 * c);
        float mx = 0.f;
#pragma unroll
        for (int c = 0; c < 16; ++c) { const u32x4 v = w[c];
            float ss = (bflo(v.x) * bflo(v.x) + bfhi(v.x) * bfhi(v.x)) + (bflo(v.y) * bflo(v.y) + bfhi(v.y) * bfhi(v.y)) + (bflo(v.z) * bflo(v.z) + bfhi(v.z) * bfhi(v.z)) + (bflo(v.w) * bflo(v.w) + bfhi(v.w) * bfhi(v.w));
            ss += __shfl_xor(ss, 1); ss += __shfl_xor(ss, 2); ss += __shfl_xor(ss, 8); ss += __shfl_xor(ss, 16);
            mx = fmaxf(mx, ss); }
        mx = fmaxf(mx, __shfl_xor(mx, 4)); mx = fmaxf(mx, __shfl_xor(mx, 32));
        if (lane == 0) KN[it] = sqrtf(mx) * 1.001f;
    }
}
}

namespace ml {
typedef short bf16x8 __attribute__((ext_vector_type(8)));
typedef short s16x4 __attribute__((ext_vector_type(4)));
typedef float f32x16 __attribute__((ext_vector_type(16)));
typedef unsigned u32x4 __attribute__((ext_vector_type(4)));
typedef LAS char* lptr;
constexpr int ROWP = 144;
__device__ __forceinline__ int crow(int r, int hi) { return (r & 3) + 8 * (r >> 2) + 4 * hi; }
__device__ __forceinline__ int t_st(int k, int c) { const int kk = (k & ~0xC) | ((k & 4) << 1) | ((k & 8) >> 1); return ((kk >> 3) * 4 + (c >> 5)) * 512 + ((kk & 7) * 32 + (c & 31)) * 2; }
__device__ __forceinline__ int t_rd_base(int lane) { return ((lane & 3) << 3) | (((lane >> 2) & 3) << 6) | (((lane >> 4) & 1) << 5) | (((lane >> 5) & 1) << 8); }
#define TRFRAG(dst, addr, ks) do { s16x4 l_, h_; asm volatile("ds_read_b64_tr_b16 %0, %1 offset:%2" : "=&v"(l_) : "v"(addr), "i"((ks) * 4096) : "memory"); \
        asm volatile("ds_read_b64_tr_b16 %0, %1 offset:%2" : "=&v"(h_) : "v"(addr), "i"((ks) * 4096 + 2048) : "memory"); \
        asm volatile("s_waitcnt lgkmcnt(0)" ::: "memory"); __builtin_amdgcn_sched_barrier(0); \
        dst = (bf16x8){l_[0], l_[1], l_[2], l_[3], h_[0], h_[1], h_[2], h_[3]}; } while (0)
__device__ __forceinline__ void unpack8(const u32x4 r, float* f) { f[0] = bflo(r.x); f[1] = bfhi(r.x); f[2] = bflo(r.y); f[3] = bfhi(r.y); f[4] = bflo(r.z); f[5] = bfhi(r.z); f[6] = bflo(r.w); f[7] = bfhi(r.w); }

__device__ __forceinline__ float fexp(float x) { return __builtin_amdgcn_exp2f(x * LOG2E); }
__device__ __forceinline__ float fsigmoid(float x) { return __builtin_amdgcn_rcpf(1.f + fexp(-x)); }
__device__ __forceinline__ float rdlane63(float v) { return __builtin_bit_cast(float, __builtin_amdgcn_readlane(__builtin_bit_cast(int, v), 63)); }
struct M1Pre { u32x4 raw[5]; u32x4 vr[2]; pg8::f32x4 cw[8]; pg8::f32x4 cb[2]; float lf, ig; };
__device__ __forceinline__ void m1_load(const Args& a, int g, M1Pre& P) {
    const int tid = threadIdx.x; const int bh = g >> 6, c = g & 63, b = bh >> 3, h = bh & 7; const int s0 = c * 64, tok0 = b * SEQ + s0;
    const int cgp = tid & 15, trow = tid >> 4, tA = 2 * trow; const int ch = (cgp >= 8 ? 512 : 0) + h * 64 + (cgp & 7) * 8;
    const bf16* MQK = (const bf16*)(a.ws + WS_SEC + SEC_MQK * SEC_BYTES);
#pragma unroll
    for (int j = 0; j < 5; ++j) { const int s = s0 + tA - 3 + j; P.raw[j] = *(const u32x4*)(MQK + tm_off((unsigned)(tok0 + tA - 3 + j + (s < 0 ? 3 : 0)), (unsigned)ch)); }
    const bf16* MV = (const bf16*)(a.ws + WS_SEC + SEC_MV * SEC_BYTES);
#pragma unroll
    for (int i = 0; i < 2; ++i) { const int ci = tid + 512 * i, s = ci >> 4, vc = (ci & 15) * 8; P.vr[i] = __builtin_nontemporal_load((const u32x4*)(MV + tm_off((unsigned)(tok0 + s), (unsigned)(h * 128 + vc)))); }
    const float* cw = a.in[IN_CONVW] + ch; const float* cb = a.in[IN_CONVB] + ch;
#pragma unroll
    for (int j = 0; j < 4; ++j) { P.cw[2 * j] = *(const pg8::f32x4*)(cw + j * 1024); P.cw[2 * j + 1] = *(const pg8::f32x4*)(cw + j * 1024 + 4); }
    P.cb[0] = *(const pg8::f32x4*)cb; P.cb[1] = *(const pg8::f32x4*)(cb + 4);
    if (tid < 64) { const float* G = (const float*)(a.ws + WS_GATE); P.lf = G[(size_t)(tok0 + tid) * 32 + 16 + h]; P.ig = G[(size_t)(tok0 + tid) * 32 + 8 + h]; }
}
__device__ __forceinline__ void m1_phase(const Args& a, lptr lds, int nblk, int blk) {
    const int tid = threadIdx.x, lane = tid & 63, wid = __builtin_amdgcn_readfirstlane(tid >> 6), r32 = lane & 31, hi = lane >> 5;
    constexpr int NITEM = BATCH * NH * NCHUNK;
    LAS float* wgt = (LAS float*)(lds + 49152); LAS float* npart = (LAS float*)(lds + 49408);
    int g = blk; if (g >= NITEM) return;
    M1Pre P; m1_load(a, g, P);
    const int cgp = tid & 15, trow = tid >> 4, tA = 2 * trow; const bool isk = cgp >= 8; const int d0 = (cgp & 7) * 8;
    int par = 0;
    for (;;) {
        const int bh = g >> 6, c = g & 63, b = bh >> 3, h = bh & 7; const int s0 = c * 64; (void)b; (void)h;
        const int KOFF = 16384 + par * 16384;
        if (wid == 0) {
            const float bc = wave_scan_add(P.lf);
            const float bl = rdlane63(bc), w = bl - bc + P.ig, amax = rdlane63(wave_scan_max(w));
            wgt[lane] = fexp(w - amax);
            float* MST = (float*)(a.ws + WS_MST);
            if (lane == 0) { MST[(size_t)g * 4 + 0] = amax; MST[(size_t)g * 4 + 1] = bl; }
            const float u = P.ig - bc; const float gm = wave_scan_max(u);
            float* GV = (float*)(a.ws + WS_GV) + (size_t)g * 192; GV[lane] = bc; GV[64 + lane] = gm; GV[128 + lane] = u;
        }
        float yA[8], yB[8];
        {
            float u[5][8];
#pragma unroll
            for (int j = 0; j < 5; ++j) { unpack8(P.raw[j], u[j]); if (s0 + tA - 3 + j < 0) {
#pragma unroll
                for (int e = 0; e < 8; ++e) u[j][e] = 0.f; } }
            const float osc = isk ? 0.125f : 1.f;
#pragma unroll
            for (int e = 0; e < 8; ++e) { const float w0 = P.cw[e >> 2][e & 3], w1 = P.cw[2 + (e >> 2)][e & 3], w2 = P.cw[4 + (e >> 2)][e & 3], w3 = P.cw[6 + (e >> 2)][e & 3], bb = P.cb[e >> 2][e & 3];
                float sA = u[0][e] * w0; sA += u[1][e] * w1; sA += u[2][e] * w2; sA += u[3][e] * w3; sA += bb;
                float sB = u[1][e] * w0; sB += u[2][e] * w1; sB += u[3][e] * w2; sB += u[4][e] * w3; sB += bb;
                yA[e] = sA * fsigmoid(sA) * osc; yB[e] = sB * fsigmoid(sB) * osc; }
            u32x4 oA, oB; oA.x = pk2(yA[0], yA[1]); oA.y = pk2(yA[2], yA[3]); oA.z = pk2(yA[4], yA[5]); oA.w = pk2(yA[6], yA[7]);
            oB.x = pk2(yB[0], yB[1]); oB.y = pk2(yB[2], yB[3]); oB.z = pk2(yB[4], yB[5]); oB.w = pk2(yB[6], yB[7]);
            bf16* dst = (bf16*)(a.ws + (isk ? WS_KC : WS_QC)) + ((size_t)bh * SEQ + s0 + tA) * 64 + d0;
            *(u32x4*)dst = oA; *(u32x4*)(dst + 64) = oB;
            if (isk) { *(LAS u32x4*)(lds + KOFF + t_st(tA, d0)) = oA; *(LAS u32x4*)(lds + KOFF + t_st(tA + 1, d0)) = oB;
                float fa[8], fb[8]; unpack8(oA, fa); unpack8(oB, fb);
#pragma unroll
                for (int e = 0; e < 8; ++e) { yA[e] = fa[e]; yB[e] = fb[e]; } }
        }
        const u32x4 vr0 = P.vr[0], vr1 = P.vr[1];
        const int gnext = g + nblk; const bool more = gnext < NITEM;
        m1_load(a, more ? gnext : g, P);
        __syncthreads();
        {   const float wA = wgt[tA], wB = wgt[tA + 1];
#pragma unroll
            for (int e = 0; e < 8; ++e) { float p = isk ? (wA * yA[e] + wB * yB[e]) : 0.f; p += __shfl_xor(p, 16); p += __shfl_xor(p, 32); if (lane >= 8 && lane < 16) npart[wid * 64 + d0 + e] = p; }
#pragma unroll
            for (int i = 0; i < 2; ++i) { const int ci = tid + 512 * i, s = ci >> 4, vc = (ci & 15) * 8; const float ws_ = wgt[s]; float f[8]; unpack8(i ? vr1 : vr0, f);
                u32x4 o; o.x = pk2(f[0] * ws_, f[1] * ws_); o.y = pk2(f[2] * ws_, f[3] * ws_); o.z = pk2(f[4] * ws_, f[5] * ws_); o.w = pk2(f[6] * ws_, f[7] * ws_);
                *(LAS u32x4*)(lds + t_st(s, vc)) = o; } }
        __syncthreads();
        {
            const int vb = wid & 3, db = wid >> 2;
            const int va = (int)(uintptr_t)lds + t_rd_base(lane) + vb * 512, ka = (int)(uintptr_t)lds + KOFF + t_rd_base(lane) + db * 512;
            f32x16 acc = {};
            bf16x8 A, Bf;
            TRFRAG(A, va, 0); TRFRAG(Bf, ka, 0); acc = __builtin_amdgcn_mfma_f32_32x32x16_bf16(A, Bf, acc, 0, 0, 0);
            TRFRAG(A, va, 1); TRFRAG(Bf, ka, 1); acc = __builtin_amdgcn_mfma_f32_32x32x16_bf16(A, Bf, acc, 0, 0, 0);
            TRFRAG(A, va, 2); TRFRAG(Bf, ka, 2); acc = __builtin_amdgcn_mfma_f32_32x32x16_bf16(A, Bf, acc, 0, 0, 0);
            TRFRAG(A, va, 3); TRFRAG(Bf, ka, 3); acc = __builtin_amdgcn_mfma_f32_32x32x16_bf16(A, Bf, acc, 0, 0, 0);
            bf16* KL = (bf16*)(a.ws + WS_KLOC) + (size_t)g * 8192;
#pragma unroll
            for (int r = 0; r < 16; ++r) { const float nb = __shfl_xor(acc[r], 1); if ((r32 & 1) == 0) *(unsigned*)(KL + (vb * 32 + crow(r, hi)) * 64 + db * 32 + r32) = pk2(acc[r], nb); }
        }
        if (tid < 64) { float n = 0.f;
#pragma unroll
            for (int w = 0; w < 8; ++w) n += npart[w * 64 + tid];
            ((float*)(a.ws + WS_NLOC))[(size_t)g * 64 + tid] = n; }
        if (!more) break;
        g = gnext; par ^= 1;
    }
    __syncthreads();
}

__device__ __forceinline__ float rdlane(float v, int l) { return __builtin_bit_cast(float, __builtin_amdgcn_readlane(__builtin_bit_cast(int, v), l)); }
template <bool NST> __device__ __forceinline__ void m2_item_t(const Args& a, int vb) {
    const int tid = threadIdx.x, lane = tid & 63;
    const int bh = vb >> 3, e0 = ((vb & 7) * 512 + tid) * 2;
    const unsigned* KL = (const unsigned*)((const bf16*)(a.ws + WS_KLOC) + (size_t)bh * 64 * 8192 + e0); unsigned* CP = (unsigned*)((bf16*)(a.ws + WS_CPREV) + (size_t)bh * 64 * 8192 + e0);
    float* MST = (float*)(a.ws + WS_MST) + (size_t)bh * 64 * 4;
    const float2 ab = *(const float2*)(MST + lane * 4);
    unsigned kl[64]; float nl[NST ? 64 : 1];
#pragma unroll
    for (int j = 0; j < 64; ++j) kl[j] = __builtin_nontemporal_load(KL + (size_t)j * 4096);
    if (NST) { const float* NL = (const float*)(a.ws + WS_NLOC) + (size_t)bh * 64 * 64 + lane;
#pragma unroll
        for (int j = 0; j < 64; ++j) nl[j] = NL[j * 64]; }
    float B = ab.y, A = ab.x;
#pragma unroll
    for (int o = 1; o < 64; o <<= 1) { const float Bp = __shfl_up(B, o), Ap = __shfl_up(A, o); if (lane >= o) { A = fmaxf(Ap + B, A); B = Bp + B; } }
    const float mc = fmaxf(B, A);
    float mp = __shfl_up(mc, 1); if (lane == 0) mp = 0.f;
    const float fCv = __builtin_amdgcn_exp2f((ab.y + mp - mc) * LOG2E), fKv = __builtin_amdgcn_exp2f((ab.x - mc) * LOG2E);
    if (NST) MST[lane * 4 + 2] = mp;
    float* NP = (float*)(a.ws + WS_NPREV) + (size_t)bh * 64 * 64 + lane;
    float c0 = 0.f, c1 = 0.f, n0 = 0.f;
#pragma unroll
    for (int j = 0; j < 64; ++j) {
        const float fC = rdlane(fCv, j), fK = rdlane(fKv, j);
        CP[(size_t)j * 4096] = pk2(c0, c1);
        c0 = fC * c0 + fK * bflo(kl[j]); c1 = fC * c1 + fK * bfhi(kl[j]);
        if (NST) { NP[j * 64] = n0; n0 = fC * n0 + fK * nl[j]; }
    }
}
__device__ __forceinline__ void m2_item(const Args& a, int vb) {
    if ((vb & 7) == 0 && __builtin_amdgcn_readfirstlane(threadIdx.x >> 6) == 0) m2_item_t<true>(a, vb); else m2_item_t<false>(a, vb);
}
#ifndef M2_MASK
#define M2_MASK 15
#endif
constexpr int M2_CTR_DONE = 2176;
__device__ __forceinline__ bool m2_worker_id(int nblk, int blk, int& w, int& nwk) {
    if (nblk != 256) { w = blk; nwk = nblk; return true; }
    w = ((blk >> 3) / (M2_MASK + 1)) * 8 + (blk & 7); nwk = 256 / (M2_MASK + 1);
    return ((blk >> 3) & M2_MASK) == 0;
}
__device__ __forceinline__ void m2_worker(const Args& a, int w, int nwk) {
    unsigned n = 0;
    for (int vb = w; vb < 256; vb += nwk) { m2_item(a, vb); ++n; }
    asm volatile("s_waitcnt vmcnt(0)" ::: "memory");
    __syncthreads();
    if (threadIdx.x == 0 && n) {
        __builtin_amdgcn_fence(__ATOMIC_RELEASE, "agent");
        asm volatile("s_waitcnt vmcnt(0)" ::: "memory");
        (void)__hip_atomic_fetch_add((unsigned*)(a.ws + WS_CTL) + M2_CTR_DONE, n, __ATOMIC_RELAXED, __HIP_MEMORY_SCOPE_AGENT);
    }
}
__device__ __forceinline__ void m2_wait_all(const Args& a) {
    unsigned* done = (unsigned*)(a.ws + WS_CTL) + M2_CTR_DONE; unsigned sp = 0;
    while (__hip_atomic_load(done, __ATOMIC_RELAXED, __HIP_MEMORY_SCOPE_AGENT) < 256u) { __builtin_amdgcn_s_sleep(2); if (++sp > (1u << 22)) break; }
#ifndef M2_NOACQ
    __builtin_amdgcn_fence(__ATOMIC_ACQUIRE, "agent");
    asm volatile("s_waitcnt vmcnt(0)" ::: "memory");
#endif
}

struct M3Pre { u32x4 qv, kv, vr[2], cp[2]; float gmrow, mprev, bc, gm, u, np; };
__device__ __forceinline__ void m3_load_front(const Args& a, int g, M3Pre& P) {
    const int tid = threadIdx.x; const int bh = g >> 6, c = g & 63, b = bh >> 3, h = bh & 7; const int s0 = c * 64, tok0 = b * SEQ + s0;
    const int prow = tid >> 3, pc = (tid & 7) * 8;
    P.qv = __builtin_nontemporal_load((const u32x4*)((const bf16*)(a.ws + WS_QC) + ((size_t)bh * SEQ + s0 + prow) * 64 + pc));
    P.kv = __builtin_nontemporal_load((const u32x4*)((const bf16*)(a.ws + WS_KC) + ((size_t)bh * SEQ + s0 + prow) * 64 + pc));
    const bf16* MV = (const bf16*)(a.ws + WS_SEC + SEC_MV * SEC_BYTES); const bf16* CP = (const bf16*)(a.ws + WS_CPREV) + (size_t)g * 8192;
#pragma unroll
    for (int i = 0; i < 2; ++i) { const int ci = tid + 512 * i, s = ci >> 4, vc = (ci & 15) * 8; P.vr[i] = __builtin_nontemporal_load((const u32x4*)(MV + tm_off((unsigned)(tok0 + s), (unsigned)(h * 128 + vc))));
        P.cp[i] = __builtin_nontemporal_load((const u32x4*)(CP + (size_t)ci * 8)); }
    const float* GV = (const float*)(a.ws + WS_GV) + (size_t)g * 192;
    P.gmrow = GV[64 + prow]; P.mprev = ((const float*)(a.ws + WS_MST))[(size_t)g * 4 + 2];
    if (tid < 64) { P.bc = GV[tid]; P.gm = GV[64 + tid]; P.u = GV[128 + tid]; P.np = ((const float*)(a.ws + WS_NPREV))[(size_t)g * 64 + tid]; }
}
__device__ __forceinline__ void m3_phase(const Args& a, lptr lds, int nblk, int blk) {
    const int tid = threadIdx.x, lane = tid & 63, wid = __builtin_amdgcn_readfirstlane(tid >> 6), r32 = lane & 31, hi = lane >> 5;
    constexpr int QIMG = 16384, KIMG = 25600, SIMG = 34816, QPIMG = 44032, CPIMG = 53248, FARR = 71680, GNOFF = 74240, HIMG = 78336, HP = 132;
    LAS float* fu = (LAS float*)(lds + FARR); LAS float* fMt = fu + 64; LAS float* fwi = fu + 128; LAS float* fmt = fu + 192; LAS float* fnp = fu + 256; LAS float* fqn = fu + 320; LAS float* fdsp = fu + 384;
    LAS float* gn = (LAS float*)(lds + GNOFF); LAS float* himg = (LAS float*)(lds + HIMG); LAS float* fhd = (LAS float*)(lds + 112128 + 64);
    constexpr int NITEM = BATCH * NH * NCHUNK;
    unsigned* ctr = (unsigned*)(a.ws + WS_CTL) + 2048; LAS int* qslot = (LAS int*)(lds + 112128);
    if (tid == 0) { qslot[0] = (int)atomicAdd(ctr, 1u); qslot[1] = (int)atomicAdd(ctr, 1u); m2_wait_all(a); }
    for (int i = tid; i < 1024; i += NTHREADS) gn[i] = a.in[IN_MNW][i];
    __syncthreads();
    int g = __builtin_amdgcn_readfirstlane(qslot[0]), gnext = __builtin_amdgcn_readfirstlane(qslot[1]);
    __syncthreads();
    if (g >= NITEM) return;
    M3Pre P; m3_load_front(a, g, P);
    const int prow = tid >> 3, pc = (tid & 7) * 8, seg = tid & 7; int qpar = 0;
    for (;;) {
        const int bh = g >> 6, c = g & 63, b = bh >> 3, h = bh & 7; const int tok0 = b * SEQ + c * 64;
        if (tid == 0) qslot[qpar] = (int)atomicAdd(ctr, 1u);
        { const float Mtr = fmaxf(P.mprev, P.gmrow), wi = fexp(P.mprev - Mtr);
#pragma unroll
          for (int i = 0; i < 2; ++i) { const int ci = tid + 512 * i, s = ci >> 4, vc = (ci & 15) * 8; *(LAS u32x4*)(lds + t_st(s, vc)) = P.vr[i];
              const int v = ci >> 3, dc = (ci & 7) * 8; *(LAS u32x4*)(lds + CPIMG + v * ROWP + dc * 2) = P.cp[i]; }
          *(LAS u32x4*)(lds + QIMG + prow * ROWP + pc * 2) = P.qv; *(LAS u32x4*)(lds + KIMG + prow * ROWP + pc * 2) = P.kv;
          float f[8]; unpack8(P.qv, f); u32x4 o; o.x = pk2(f[0] * wi, f[1] * wi); o.y = pk2(f[2] * wi, f[3] * wi); o.z = pk2(f[4] * wi, f[5] * wi); o.w = pk2(f[6] * wi, f[7] * wi);
          *(LAS u32x4*)(lds + QPIMG + prow * ROWP + pc * 2) = o;
          if (tid < 64) { const float Mt = fmaxf(P.mprev, P.gm); fu[tid] = P.u; fMt[tid] = Mt; fwi[tid] = fexp(P.mprev - Mt); fmt[tid] = P.bc + Mt; fnp[tid] = P.np; } }
        const bf16* MO = (const bf16*)(a.ws + WS_SEC + SEC_MO * SEC_BYTES) + tm_off((unsigned)(tok0 + prow), (unsigned)(h * 128 + seg * 8));
        const bf16* MZ = (const bf16*)(a.ws + WS_SEC + SEC_MZ * SEC_BYTES) + tm_off((unsigned)(tok0 + prow), (unsigned)(h * 128 + seg * 8));
        const u32x4 mo0 = __builtin_nontemporal_load((const u32x4*)MO), mo1 = __builtin_nontemporal_load((const u32x4*)(MO + 128)), mz0 = __builtin_nontemporal_load((const u32x4*)MZ), mz1 = __builtin_nontemporal_load((const u32x4*)(MZ + 128));
        const bool more = gnext < NITEM;
        M3Pre Pn; m3_load_front(a, more ? gnext : g, Pn);
        __syncthreads();
        if (wid < 4) {
            const int sb = wid & 1, tb = wid >> 1;
            f32x16 acc = {};
            if (sb <= tb) {
#pragma unroll
                for (int k0 = 0; k0 < 4; ++k0) { const bf16x8 Kf = *(const LAS bf16x8*)(lds + KIMG + (sb * 32 + r32) * ROWP + (k0 * 16 + hi * 8) * 2);
                    const bf16x8 Qf = *(const LAS bf16x8*)(lds + QIMG + (tb * 32 + r32) * ROWP + (k0 * 16 + hi * 8) * 2);
                    acc = __builtin_amdgcn_mfma_f32_32x32x16_bf16(Kf, Qf, acc, 0, 0, 0); }
            }
            const int t = tb * 32 + r32; const float Mt = fMt[t]; float rsum = 0.f;
#pragma unroll
            for (int gq = 0; gq < 4; ++gq) { float v[4];
#pragma unroll
                for (int e = 0; e < 4; ++e) { const int s = sb * 32 + 8 * gq + 4 * hi + e; const float d = fexp(fu[s] - Mt); v[e] = (s <= t) ? acc[4 * gq + e] * d : 0.f; rsum += v[e]; }
                v2u o; o.x = pk2(v[0], v[1]); o.y = pk2(v[2], v[3]);
                *(LAS v2u*)(lds + SIMG + t * ROWP + (sb * 32 + 8 * gq + 4 * hi) * 2) = o; }
            fdsp[t * 4 + sb * 2 + hi] = rsum;
        } else {
            const int tq = tid - 256, row = tq >> 2, part = tq & 3;
            const u32x4 q0 = *(const LAS u32x4*)(lds + QIMG + row * ROWP + part * 32), q1 = *(const LAS u32x4*)(lds + QIMG + row * ROWP + part * 32 + 16);
            float f[16]; unpack8(q0, f); unpack8(q1, f + 8); float s = 0.f;
#pragma unroll
            for (int e = 0; e < 16; ++e) s += f[e] * fnp[part * 16 + e];
            s += __shfl_xor(s, 1); s += __shfl_xor(s, 2);
            if (part == 0) fqn[row] = s;
        }
        __syncthreads();
        if (tid < 64) {
            const int t = tid; const float den = ((fdsp[t * 4 + 0] + fdsp[t * 4 + 1]) + (fdsp[t * 4 + 2] + fdsp[t * 4 + 3])) + fwi[t] * fqn[t];
            fhd[t] = __builtin_amdgcn_rcpf(fmaxf(fabsf(den), fexp(-fmt[t]))); }
        {
            const int tb = wid >> 2, vb = wid & 3;
            f32x16 acc = {};
            const int va = (int)(uintptr_t)lds + t_rd_base(lane) + vb * 512;
            bf16x8 Af, Bf;
#define M3_STEP(ks) do { Af = *(const LAS bf16x8*)(lds + SIMG + (tb * 32 + r32) * ROWP + ((ks) * 16 + hi * 8) * 2); TRFRAG(Bf, va, ks); acc = __builtin_amdgcn_mfma_f32_32x32x16_bf16(Af, Bf, acc, 0, 0, 0); } while (0)
            M3_STEP(0); M3_STEP(1); M3_STEP(2); M3_STEP(3);
#undef M3_STEP
#pragma unroll
            for (int k0 = 0; k0 < 4; ++k0) { const bf16x8 Aq = *(const LAS bf16x8*)(lds + QPIMG + (tb * 32 + r32) * ROWP + (k0 * 16 + hi * 8) * 2);
                const bf16x8 Cf = *(const LAS bf16x8*)(lds + CPIMG + (vb * 32 + r32) * ROWP + (k0 * 16 + hi * 8) * 2);
                acc = __builtin_amdgcn_mfma_f32_32x32x16_bf16(Aq, Cf, acc, 0, 0, 0); }
#pragma unroll
            for (int r = 0; r < 16; ++r) himg[(tb * 32 + crow(r, hi)) * HP + vb * 32 + r32] = acc[r];
        }
        __syncthreads();
        {
            float hv[16], of[16], zf[16];
#pragma unroll
            for (int j = 0; j < 4; ++j) { const pg8::f32x4 x = *(const LAS pg8::f32x4*)(himg + prow * HP + seg * 8 + (j >> 1) * 64 + (j & 1) * 4); hv[4 * j] = x[0]; hv[4 * j + 1] = x[1]; hv[4 * j + 2] = x[2]; hv[4 * j + 3] = x[3]; }
            unpack8(mo0, of); unpack8(mo1, of + 8); unpack8(mz0, zf); unpack8(mz1, zf + 8);
            float ss = 0.f; const float hdr = fhd[prow];
#pragma unroll
            for (int e = 0; e < 16; ++e) { hv[e] *= hdr * fsigmoid(of[e]); ss += hv[e] * hv[e]; }
            ss += __shfl_xor(ss, 1); ss += __shfl_xor(ss, 2); ss += __shfl_xor(ss, 4);
            const float rs = 1.0f / sqrtf(ss * (1.f / 128.f) + NORM_EPS);
            float y[16];
#pragma unroll
            for (int e = 0; e < 16; ++e) y[e] = hv[e] * rs * gn[h * 128 + seg * 8 + (e >> 3) * 64 + (e & 7)] * (zf[e] * fsigmoid(zf[e]));
            u32x4 o0, o1; o0.x = pk2(y[0], y[1]); o0.y = pk2(y[2], y[3]); o0.z = pk2(y[4], y[5]); o0.w = pk2(y[6], y[7]);
            o1.x = pk2(y[8], y[9]); o1.y = pk2(y[10], y[11]); o1.z = pk2(y[12], y[13]); o1.w = pk2(y[14], y[15]);
            bf16* Y = (bf16*)(a.ws + WS_Y) + (size_t)(tok0 + prow) * 2048 + 1024 + h * 128 + seg * 8;
            *(u32x4*)Y = o0; *(u32x4*)(Y + 64) = o1;
        }
        if (!more) break;
        g = gnext; P = Pn; gnext = __builtin_amdgcn_readfirstlane(qslot[qpar]); qpar ^= 1;
    }
    __syncthreads();
}
#undef TRFRAG
}

#define XB_TMO      128
#define XB_XCNT(j)  (256  + 64 * (j))
#define XB_XSUB(j)  (1280 + 64 * (j))
#define XB_XGEN(j)  (2304 + 64 * (j))
#define XB_TOP      3328
#define XB_TOPGEN   3392
#define XCD_BAR_WORDS 3456
#define XB_SPIN_CAP (1u << 18)

__device__ __forceinline__ unsigned xb_ld(unsigned* p)              { return __hip_atomic_load(p, __ATOMIC_RELAXED, __HIP_MEMORY_SCOPE_AGENT); }
__device__ __forceinline__ unsigned xb_add(unsigned* p, unsigned v) { return __hip_atomic_fetch_add(p, v, __ATOMIC_RELAXED, __HIP_MEMORY_SCOPE_AGENT); }
__device__ __forceinline__ unsigned xb_xcc_id() { return (unsigned)__builtin_amdgcn_s_getreg((3 << 11) | 20) & 0xFu; }
#define XB_SPIN(cond, bar) do { unsigned _sp = 0; while (cond) { __builtin_amdgcn_s_sleep(1); \
    if ((++_sp & 255u) == 0u) { if (xb_ld(&(bar)[XB_TMO])) break; if (_sp > XB_SPIN_CAP) { atomicAdd(&(bar)[XB_TMO], 1u); break; } } } } while (0)

struct XcdBarrier {
    unsigned* bar; unsigned x;
    volatile LAS unsigned* st;
};

__device__ __forceinline__ XcdBarrier xcd_barrier_post(unsigned* bar, volatile LAS unsigned* st) {
    XcdBarrier b; b.bar = bar; b.x = xb_xcc_id(); b.st = st;
    if (threadIdx.x == 0) (void)xb_add(&bar[XB_XCNT(b.x)], 1u);
    return b;
}
__device__ __forceinline__ void xcd_barrier_complete(unsigned* bar, unsigned x, unsigned& nloc, unsigned& nx) {
    const unsigned G = gridDim.x * gridDim.y * gridDim.z;
    unsigned sum, cnt, mine, sp = 0u;
    for (;;) {
        sum = 0u; cnt = 0u; mine = 0u;
#pragma unroll
        for (unsigned j = 0; j < 16; ++j) { const unsigned c = xb_ld(&bar[XB_XCNT(j)]); sum += c; cnt += (c > 0u) ? 1u : 0u; mine = (j == x) ? c : mine; }
        if (sum == G) break;
        __builtin_amdgcn_s_sleep(1);
        if ((++sp & 255u) == 0u) { if (xb_ld(&bar[XB_TMO])) break; if (sp > XB_SPIN_CAP) { atomicAdd(&bar[XB_TMO], 1u); break; } }
    }
    nloc = mine > 0u ? mine : 1u; nx = cnt > 0u ? cnt : 1u;
}

__device__ __forceinline__ void xcd_barrier_leader(const XcdBarrier& b) {
        unsigned* bar = b.bar;
        __builtin_amdgcn_s_waitcnt(0);
        unsigned nloc = b.st[0], nx = b.st[1];
        if (nloc == 0u) { xcd_barrier_complete(bar, b.x, nloc, nx); b.st[0] = nloc; b.st[1] = nx; }
        const unsigned old = xb_add(&bar[XB_XSUB(b.x)], 1u);
        const unsigned gen = old / nloc;
        if (old + 1u == (gen + 1u) * nloc) {
            __builtin_amdgcn_fence(__ATOMIC_RELEASE, "agent");
            asm volatile("s_waitcnt vmcnt(0)" ::: "memory");
            const unsigned og = xb_add(&bar[XB_TOP], 1u);
            const unsigned tg = og / nx;
            if (og + 1u == (tg + 1u) * nx) xb_add(&bar[XB_TOPGEN], 1u);
            else XB_SPIN(xb_ld(&bar[XB_TOPGEN]) == tg, bar);
            __builtin_amdgcn_fence(__ATOMIC_ACQUIRE, "agent");
            asm volatile("s_waitcnt vmcnt(0)" ::: "memory");
        } else {
            XB_SPIN(xb_ld(&bar[XB_TOPGEN]) == gen, bar);
            __builtin_amdgcn_fence(__ATOMIC_ACQUIRE, "agent");
            asm volatile("s_waitcnt vmcnt(0)" ::: "memory");
        }
}
__device__ __forceinline__ void xcd_barrier(const XcdBarrier& b) {
    asm volatile("s_waitcnt vmcnt(0)" ::: "memory");
    __syncthreads();
    if (threadIdx.x == 0) xcd_barrier_leader(b);
    __syncthreads();
}

constexpr int N_PHASES = 7;
__global__ void __launch_bounds__(NTHREADS, 2) mega_fwd(Args a) {
    extern __shared__ __attribute__((aligned(16))) unsigned char lds_raw[];
    LAS unsigned char* lds = (LAS unsigned char*)lds_raw;
    const int blk = blockIdx.x, nblk = gridDim.x;
    const int lo = a.ph_lo, hi = a.ph_hi;
    volatile LAS unsigned* MISC = (volatile LAS unsigned*)(lds + LDS_BYTES - 64);
    if (threadIdx.x < 16) MISC[threadIdx.x] = 0u;
    __syncthreads();
    XcdBarrier bar = xcd_barrier_post((unsigned*)(a.ws + WS_CTL) + 4096, MISC + 8);
#ifndef PROBE_REPEAT
#define PROBE_REPEAT -1
#endif
#ifndef PROBE_FLAGS
#define PROBE_FLAGS 0
#endif
#define REP(k)
#define IN(k) (lo <= (k) && (k) < hi)
#define SEAM(k) do { if (IN(k) && IN((k) + 1)) xcd_barrier(bar); } while (0)
    if (IN(0)) { REP(0) phase_prep(a, lds, nblk, blk); }
    SEAM(0);
    if (IN(1)) REP(1) {
        for (int c = blk; c < M_TOK / 64; c += nblk) gate_unit(a, lds, c);
        pg8::Gemm g{(const pg8::bf16_t*)(a.ws + WS_XN), (const pg8::bf16_t*)(a.ws + WS_WIN), M_TOK, NMAIN, DM};
        pg8::EpiProj E{a.ws + WS_SEC, QSCALE};
        if (nblk == 256) { pg8::XcdColOrder S; S.init(M_TOK, NMAIN, nblk, blk); pg8::gemm_phase<pg8::EpiProj, pg8::XcdColOrder, true, true>(lds, g, S, E); }
        else { pg8::StaticOrder S; S.init(M_TOK, NMAIN, nblk, blk); pg8::gemm_phase<pg8::EpiProj, pg8::StaticOrder, true, true>(lds, g, S, E); }
    }
    SEAM(1);
    if (IN(2)) {
        for (int it = blk; it < BATCH * NCHUNK; it += nblk) fox_cumsum_item(a, it);
        fox::knorm_pass(a, nblk, blk);
        ml::m1_phase(a, (ml::lptr)lds, nblk, blk);
    }
    SEAM(2);
    if (IN(4)) {
        { int w, nwk; if (ml::m2_worker_id(nblk, blk, w, nwk)) { ml::m2_worker(a, w, nwk); transpose_tiles(a, lds, T_MAIN + w, nwk, NTILES); } }
        REP(4) fox::phase(a, (fox::lptr)lds, nblk, blk);
        REP(41) ml::m3_phase(a, (ml::lptr)lds, nblk, blk);
    }
    SEAM(4);
    if (IN(5)) REP(5) {
        pg8::Gemm g{(const pg8::bf16_t*)(a.ws + WS_Y), (const pg8::bf16_t*)(a.ws + WS_WOUT), M_TOK, DM, DM};
        pg8::StaticOrder S; S.init(M_TOK, DM, nblk, blk);
        pg8::EpiOut E{(pg8::bf16_t*)(a.ws + WS_DELTA)};
        pg8::gemm_phase<pg8::EpiOut, pg8::StaticOrder, true, true>(lds, g, S, E);
    }
    if (IN(6)) {
        ORow RA; pg8::f32x4 gfin[8];
        const bool w0 = __builtin_amdgcn_readfirstlane(threadIdx.x >> 6) == 0;
        if (IN(5)) {
            asm volatile("s_waitcnt vmcnt(0)" ::: "memory");
            __syncthreads();
            if (!w0) { __builtin_amdgcn_s_sleep(4); final_prefetch(a, nblk, blk, RA, gfin); }
            if (threadIdx.x == 0) xcd_barrier_leader(bar);
            __syncthreads();
            if (w0) final_prefetch(a, nblk, blk, RA, gfin);
        } else final_prefetch(a, nblk, blk, RA, gfin);
        REP(6) phase_final(a, nblk, blk, RA, gfin);
    }
#undef IN
#undef SEAM
}

#ifndef MK_N_LAUNCHES
#define MK_N_LAUNCHES 1
#endif
extern "C" void kernel_launch(void* const* d_in, const int* in_sizes, int n_in, void* d_out, int out_size, void* d_ws, size_t ws_size, hipStream_t stream) {
    static int grid = 0;
    if (grid == 0) {
        if (n_in != 12 || in_sizes[0] != M_TOK * DM || in_sizes[2] != DM * IN_COLS || out_size != M_TOK * DM || ws_size < WS_END) {
            fprintf(stderr, "kernel_launch: shape mismatch n_in %d in0 %d in2 %d out %d ws %zu\n", n_in, n_in > 0 ? in_sizes[0] : -1, n_in > 2 ? in_sizes[2] : -1, out_size, ws_size); grid = -1; return; }
        int dev = 0, cus = 0, per_cu = 0;
        if (hipGetDevice(&dev) != hipSuccess || hipDeviceGetAttribute(&cus, hipDeviceAttributeMultiprocessorCount, dev) != hipSuccess) { grid = -1; return; }
        if (hipFuncSetAttribute((const void*)mega_fwd, hipFuncAttributeMaxDynamicSharedMemorySize, LDS_BYTES) != hipSuccess) { fprintf(stderr, "kernel_launch: hipFuncSetAttribute failed\n"); grid = -1; return; }
        if (hipOccupancyMaxActiveBlocksPerMultiprocessor(&per_cu, (const void*)mega_fwd, NTHREADS, LDS_BYTES) != hipSuccess || per_cu < 1) { fprintf(stderr, "kernel_launch: occupancy query says %d blocks per CU\n", per_cu); per_cu = 1; }
        (void)hipGetLastError();
        grid = cus;
    }
    if (grid < 0) return;
    Args a{};
    for (int i = 0; i < 12; ++i) a.in[i] = (const float*)d_in[i];
    a.out = (float*)d_out; a.ws = (unsigned char*)d_ws;
    if (hipMemsetAsync((char*)d_ws + WS_CTL, 0, 65536, stream) != hipSuccess) { fprintf(stderr, "kernel_launch: hipMemsetAsync failed\n"); return; }
    if (MK_N_LAUNCHES == 1) {
        a.ph_lo = 0; a.ph_hi = N_PHASES;
        void* args[] = {&a};
        hipError_t e = hipLaunchCooperativeKernel((const void*)mega_fwd, dim3(grid), dim3(NTHREADS), args, LDS_BYTES, stream);
        if (e != hipSuccess) fprintf(stderr, "kernel_launch: cooperative launch failed: %s (grid %d)\n", hipGetErrorString(e), grid);
    } else {
        for (int p = 0; p < N_PHASES; ++p) { a.ph_lo = p; a.ph_hi = p + 1; for (int r = 0; r < (p == PROBE_REPEAT ? 2 : 1); ++r) { a.flags = r ? PROBE_FLAGS : 0; hipLaunchKernelGGL(mega_fwd, dim3(grid), dim3(NTHREADS), LDS_BYTES, stream, a); } }
        if (PROBE_REPEAT == 56) for (int p = 5; p < 7; ++p) { a.ph_lo = p; a.ph_hi = p + 1; hipLaunchKernelGGL(mega_fwd, dim3(grid), dim3(NTHREADS), LDS_BYTES, stream, a); }
    }
}
```
